# Optimizing an MI355X kernel written in HIP

```python
import jax, jax.numpy as jnp
from jax import lax
import numpy as np


D_MODEL = 1024
BATCH = 8
SEQ = 2048
DEPTH = 2

N_EVEN = (DEPTH + 1) // 2
N_ODD = DEPTH // 2
D_FF = 2816
EPS = 1e-6

RWKV_HEADS = 8
RWKV_HD = 64
RWKV_DIM = RWKV_HEADS * RWKV_HD
LORA_W = 64
LORA_A = 64
LORA_G = 128
RWKV_COLS = 3 * RWKV_DIM + LORA_W + LORA_A + LORA_G
RWKV_SPLITS = (RWKV_DIM, 2 * RWKV_DIM, 3 * RWKV_DIM, 3 * RWKV_DIM + LORA_W, 3 * RWKV_DIM + LORA_W + LORA_A)
LNX_EPS = 64e-5

MOBA_HEADS = 8
MOBA_HD = 64
MOBA_DIM = MOBA_HEADS * MOBA_HD
MOBA_BLOCK = 256
MOBA_TOPK = 3
Q_CHUNK = 16
MOBA_COLS = 3 * MOBA_DIM

EVEN_IN = RWKV_COLS + MOBA_COLS
EVEN_MIX = RWKV_DIM + MOBA_DIM

HG_HEADS = 8
HG_DK = 128
HG_DV = 128
HG_FDIM = HG_HEADS * HG_DK
HG_VDIM = HG_HEADS * HG_DV
HG_CHUNK = 64
ODD_IN = 2 * HG_FDIM + 2 * HG_VDIM

kernel_name = 'hybrid_rwkv7_moba_hgrn2_macaron'


def rmsnorm(x, g):
    xf = x.astype(jnp.float32)
    y = xf * lax.rsqrt(jnp.mean(xf * xf, axis=-1, keepdims=True) + EPS)
    return (y * g).astype(x.dtype)


def swiglu(h, w_gate, w_up, w_down):
    return (jax.nn.silu(h @ w_gate) * (h @ w_up)) @ w_down


def _shift_prev(t):
    return jnp.pad(t, ((0, 0), (1, 0), (0, 0)))[:, :-1]


def _heads(t, n_heads):
    return t.reshape(t.shape[0], t.shape[1], n_heads, -1)


def rwkv7_mix(p, mu, w0, w2, a0, a2, g2, k_k, k_a, r_k, lnx_w, lnx_b):
    bsz, seq, _ = p.shape
    f32 = jnp.float32
    p = p + (_shift_prev(p) - p) * mu
    r, k, v, w_lr, a_lr, g_lr = jnp.split(p, RWKV_SPLITS, axis=-1)
    w_raw = -jax.nn.softplus(-(w0 + jnp.tanh(w_lr) @ w2)) - 0.5
    decay = jnp.exp(-jnp.exp(w_raw.astype(f32)))
    a = jax.nn.sigmoid(a0 + a_lr @ a2)
    g = jax.nn.sigmoid(g_lr) @ g2
    kk = _heads(k * k_k, RWKV_HEADS).astype(f32)
    kk = kk * lax.rsqrt(jnp.maximum(jnp.sum(kk * kk, axis=-1, keepdims=True), 1e-24))
    k = k * (1.0 + (a - 1.0) * k_a)
    rh, kh, vh, ah, wh = [_heads(t, RWKV_HEADS).astype(f32) for t in (r, k, v, a, decay)]

    def step(state, inp):
        r_t, w_t, k_t, v_t, kk_t, a_t = inp
        sa = jnp.einsum('bhvk,bhk->bhv', state, -kk_t)
        state = (state * w_t[:, :, None, :]
                 + jnp.einsum('bhv,bhk->bhvk', sa, kk_t * a_t)
                 + jnp.einsum('bhv,bhk->bhvk', v_t, k_t))
        return state, jnp.einsum('bhvk,bhk->bhv', state, r_t)

    tm = lambda t: jnp.moveaxis(t, 1, 0)
    s0 = jnp.zeros((bsz, RWKV_HEADS, RWKV_HD, RWKV_HD), f32)
    _, y = lax.scan(step, s0, (tm(rh), tm(wh), tm(kh), tm(vh), tm(kk), tm(ah)))
    y = jnp.moveaxis(y, 0, 1)
    mean = jnp.mean(y, axis=-1, keepdims=True)
    var = jnp.mean(jnp.square(y - mean), axis=-1, keepdims=True)
    y = ((y - mean) * lax.rsqrt(var + LNX_EPS)).reshape(bsz, seq, RWKV_DIM) * lnx_w + lnx_b
    bonus = jnp.sum(rh * kh * r_k, axis=-1, keepdims=True) * vh
    y = y + bonus.reshape(bsz, seq, RWKV_DIM)
    return (y * g).astype(p.dtype)


def moba_mix(p, slopes):
    bsz, seq, _ = p.shape
    f32 = jnp.float32
    q, k, v = [jnp.moveaxis(_heads(t, MOBA_HEADS), 2, 1) for t in jnp.split(p, 3, axis=-1)]
    q = q * (MOBA_HD ** -0.5)
    n_blk = -(-seq // MOBA_BLOCK)
    pad = n_blk * MOBA_BLOCK - seq
    padding = ((0, 0), (0, 0), (0, pad), (0, 0))
    kb = jnp.pad(k, padding).reshape(bsz, MOBA_HEADS, n_blk, MOBA_BLOCK, MOBA_HD)
    vb = jnp.pad(v, padding).reshape(bsz, MOBA_HEADS, n_blk, MOBA_BLOCK, MOBA_HD)
    pos = jnp.arange(seq, dtype=jnp.int32)
    own = pos // MOBA_BLOCK
    own_idx = jnp.broadcast_to(own[:, None], (bsz, MOBA_HEADS, seq, 1))
    n_sel = min(MOBA_TOPK, n_blk - 1)
    if n_sel > 0:
        k_mean = jnp.mean(kb, axis=3)
        gate = jnp.einsum('bhsd,bhnd->bhsn', q, k_mean).astype(f32)
        fully_past = jnp.arange(n_blk, dtype=jnp.int32)[None, :] < own[:, None]
        gate = jnp.where(fully_past, gate, -jnp.inf)
        _, top_idx = lax.top_k(gate, n_sel)
        top_idx = top_idx.astype(jnp.int32)
        idx = jnp.concatenate([top_idx, own_idx], axis=-1)
        valid = jnp.concatenate([top_idx < own[:, None], jnp.ones(own_idx.shape, bool)], axis=-1)
    else:
        idx = own_idx
        valid = jnp.ones(own_idx.shape, bool)

    n_chunk = seq // Q_CHUNK

    def to_chunks(t):
        return jnp.moveaxis(t.reshape(t.shape[:2] + (n_chunk, Q_CHUNK) + t.shape[3:]), 2, 0)

    b_i = jnp.arange(bsz)[:, None, None, None]
    h_i = jnp.arange(MOBA_HEADS)[None, :, None, None]
    offs = jnp.arange(MOBA_BLOCK, dtype=jnp.int32)

    def attend(args):
        q_c, idx_c, valid_c, pos_c = args
        k_g = kb[b_i, h_i, idx_c]
        v_g = vb[b_i, h_i, idx_c]
        s = jnp.einsum('bhqd,bhqnkd->bhqnk', q_c, k_g).astype(f32)
        dist = pos_c[:, None, None] - (idx_c[..., None] * MOBA_BLOCK + offs)
        s = s - slopes[:, None, None, None] * dist.astype(f32)
        s = jnp.where(valid_c[..., None] & (dist >= 0), s, -jnp.inf)
        pr = jax.nn.softmax(s.reshape(s.shape[:3] + (-1,)), axis=-1).reshape(s.shape)
        return jnp.einsum('bhqnk,bhqnkd->bhqd', pr.astype(v_g.dtype), v_g)

    o = lax.map(attend, (to_chunks(q), to_chunks(idx), to_chunks(valid), pos.reshape(n_chunk, Q_CHUNK)))
    o = jnp.moveaxis(o, 0, 2).reshape(bsz, MOBA_HEADS, seq, MOBA_HD)
    return jnp.moveaxis(o, 1, 2).reshape(bsz, seq, MOBA_DIM).astype(p.dtype)


def hgrn2_mix(p, lb, norm_w):
    bsz, seq, _ = p.shape
    f32 = jnp.float32
    q, f_raw, i, g = jnp.split(p, 4, axis=-1)
    f_raw = f_raw.astype(f32)
    log_f = jnp.log(lb + (1.0 - lb) * jax.nn.sigmoid(f_raw))
    k = (1.0 - lb) * jax.nn.sigmoid(-f_raw)
    n_chunk = seq // HG_CHUNK

    def chunks(t):
        t = t.astype(f32).reshape(bsz, n_chunk, HG_CHUNK, HG_HEADS, -1)
        return jnp.transpose(t, (1, 0, 3, 2, 4))

    causal = jnp.tril(jnp.ones((HG_CHUNK, HG_CHUNK), bool))[:, :, None]

    def step(state, inp):
        q_c, k_c, v_c, lf_c = inp
        b = jnp.cumsum(lf_c, axis=2)
        decay = jnp.exp(jnp.where(causal, b[:, :, :, None, :] - b[:, :, None, :, :], -jnp.inf))
        scores = jnp.einsum('bhtk,bhtsk,bhsk->bhts', q_c, decay, k_c)
        o = (jnp.einsum('bhts,bhsv->bhtv', scores, v_c)
             + jnp.einsum('bhtk,bhkv->bhtv', q_c * jnp.exp(b), state))
        b_last = b[:, :, -1:, :]
        state = (jnp.exp(b_last[:, :, 0, :])[..., None] * state
                 + jnp.einsum('bhsk,bhsv->bhkv', k_c * jnp.exp(b_last - b), v_c))
        return state, o

    s0 = jnp.zeros((bsz, HG_HEADS, HG_DK, HG_DV), f32)
    _, o = lax.scan(step, s0, (chunks(q), chunks(k), chunks(i), chunks(log_f)))
    o = jnp.transpose(o, (1, 0, 3, 2, 4)).reshape(bsz, seq, HG_HEADS, HG_DV)
    o = o * lax.rsqrt(jnp.mean(o * o, axis=-1, keepdims=True) + EPS)
    o = o.reshape(bsz, seq, HG_VDIM) * norm_w * jax.nn.sigmoid(g.astype(f32))
    return o.astype(p.dtype)


def setup_inputs(seed: int = 0) -> dict:
    key = jax.random.key(seed)
    ks = jax.random.split(key, 32)
    f32 = jnp.float32
    nrm = lambda k, shape, scale: scale * jax.random.normal(k, shape, f32)
    D, F = D_MODEL, D_FF
    return {
        'x': jax.random.normal(ks[0], (BATCH, SEQ, D), f32),
        'norm_g': 1.0 + nrm(ks[1], (DEPTH, 3, D), 0.02),
        'ffn1_wg': nrm(ks[2], (DEPTH, D, F), D ** -0.5),
        'ffn1_wu': nrm(ks[3], (DEPTH, D, F), D ** -0.5),
        'ffn1_wd': nrm(ks[4], (DEPTH, F, D), F ** -0.5),
        'ffn2_wg': nrm(ks[5], (DEPTH, D, F), D ** -0.5),
        'ffn2_wu': nrm(ks[6], (DEPTH, D, F), D ** -0.5),
        'ffn2_wd': nrm(ks[7], (DEPTH, F, D), F ** -0.5),
        'ev_w_in': nrm(ks[8], (N_EVEN, D, EVEN_IN), D ** -0.5),
        'ev_w_out': nrm(ks[9], (N_EVEN, EVEN_MIX, D), EVEN_MIX ** -0.5),
        'rw_mu': jax.random.uniform(ks[10], (N_EVEN, RWKV_COLS), f32),
        'rw_w0': jax.random.uniform(ks[11], (N_EVEN, RWKV_DIM), f32, -5.0, 1.0),
        'rw_w2': nrm(ks[12], (N_EVEN, LORA_W, RWKV_DIM), 0.1),
        'rw_a0': nrm(ks[13], (N_EVEN, RWKV_DIM), 0.1),
        'rw_a2': nrm(ks[14], (N_EVEN, LORA_A, RWKV_DIM), LORA_A ** -0.5),
        'rw_g2': nrm(ks[15], (N_EVEN, LORA_G, RWKV_DIM), LORA_G ** -0.5),
        'rw_k_k': 0.85 + nrm(ks[16], (N_EVEN, RWKV_DIM), 0.05),
        'rw_k_a': 1.0 + nrm(ks[17], (N_EVEN, RWKV_DIM), 0.05),
        'rw_r_k': nrm(ks[18], (N_EVEN, RWKV_HEADS, RWKV_HD), 0.1),
        'rw_lnx_w': 1.0 + nrm(ks[19], (N_EVEN, RWKV_DIM), 0.02),
        'rw_lnx_b': nrm(ks[20], (N_EVEN, RWKV_DIM), 0.02),
        'od_w_in': nrm(ks[21], (N_ODD, D, ODD_IN), D ** -0.5),
        'od_w_out': nrm(ks[22], (N_ODD, HG_VDIM, D), HG_VDIM ** -0.5),
        'hg_norm_w': 1.0 + nrm(ks[23], (N_ODD, HG_VDIM), 0.02),
        'hg_lb_logits': nrm(ks[24], (DEPTH, HG_FDIM), 0.1),
        'final_g': 1.0 + nrm(ks[25], (D,), 0.02),
    }


def reference(x, norm_g, ffn1_wg, ffn1_wu, ffn1_wd, ffn2_wg, ffn2_wu, ffn2_wd,
              ev_w_in, ev_w_out, rw_mu, rw_w0, rw_w2, rw_a0, rw_a2, rw_g2, rw_k_k, rw_k_a,
              rw_r_k, rw_lnx_w, rw_lnx_b, od_w_in, od_w_out, hg_norm_w, hg_lb_logits, final_g):
    f32 = jnp.float32
    slopes = jnp.exp2(-8.0 * jnp.arange(1, MOBA_HEADS + 1, dtype=f32) / MOBA_HEADS)
    lb_sm = jax.nn.softmax(hg_lb_logits.astype(f32), axis=0)
    lb_table = jnp.cumsum(lb_sm, axis=0) - lb_sm[0]
    for l in range(DEPTH):
        x = x + 0.5 * swiglu(rmsnorm(x, norm_g[l, 0]), ffn1_wg[l], ffn1_wu[l], ffn1_wd[l])
        h = rmsnorm(x, norm_g[l, 1])
        if l % 2 == 0:
            e = l // 2
            p = h @ ev_w_in[e]
            y_a = rwkv7_mix(p[..., :RWKV_COLS], rw_mu[e], rw_w0[e], rw_w2[e], rw_a0[e], rw_a2[e],
                            rw_g2[e], rw_k_k[e], rw_k_a[e], rw_r_k[e], rw_lnx_w[e], rw_lnx_b[e])
            y_b = moba_mix(p[..., RWKV_COLS:], slopes)
            y = jnp.concatenate([y_a, y_b], axis=-1) @ ev_w_out[e]
        else:
            o = l // 2
            p = h @ od_w_in[o]
            y = hgrn2_mix(p, lb_table[l], hg_norm_w[o]) @ od_w_out[o]
        x = x + y.astype(x.dtype)
        x = x + 0.5 * swiglu(rmsnorm(x, norm_g[l, 2]), ffn2_wg[l], ffn2_wu[l], ffn2_wd[l])
    return rmsnorm(x, final_g)
```

```cpp
#include <hip/hip_runtime.h>
#include <cstdio>
#include <cstdint>
namespace pg8 {
#define PG8_LAS __attribute__((address_space(3)))
typedef unsigned short bf16_t;
typedef short bf16x8 __attribute__((ext_vector_type(8)));
typedef float f32x4 __attribute__((ext_vector_type(4)));
typedef unsigned u32x4 __attribute__((ext_vector_type(4)));
constexpr int BM = 256, BK = 64, HALF = 128, HTB = HALF * BK * 2  , STAGE_BYTES = 8 * HTB, NXCD = 8, WGM = 8;

__host__ __device__ __forceinline__ int lds_byte(int r, int c) { const int st = (r >> 4) * 2 + (c >> 5), rr = r & 15, cc = c & 31, ob = rr * 64 + cc * 2; return st * 1024 + (ob ^ (((ob >> 9) & 1) << 5)); }
__host__ __device__ __forceinline__ void stage_rc(int b, int& R, int& C) { const int st = b / 1024, sb = b % 1024, swz = sb ^ (((sb >> 9) & 1) << 5); R = (st >> 1) * 16 + swz / 64; C = (st & 1) * 32 + (swz % 64) / 2; }
__host__ __device__ __forceinline__ int perm32(int rho) { const int n = rho >> 4, i = rho & 15; return 8 * (i >> 2) + 4 * n + (i & 3); }

struct Unit { int pm, pn; };
struct Gemm { const bf16_t* A; const bf16_t* Bt; int M, N, K; };

struct StaticOrder {
    int nM, nN, nwg, G, c;
    __host__ __device__ void init(int M, int N, int G_, int c_) { nM = M / BM; nN = N / BM; nwg = nM * nN; G = G_; c = c_; }
    __host__ __device__ bool next(int i, Unit& u) const {
        const long L = (long)i * G + c; if (L >= nwg) return false;
        int wgid = (int)L; { const int q = nwg / NXCD, r = nwg % NXCD, xcd = wgid % NXCD, off = wgid / NXCD; wgid = (xcd < r ? xcd * (q + 1) : r * (q + 1) + (xcd - r) * q) + off; }
        const int nig = WGM * nN, gid = wgid / nig, fm = gid * WGM, gsz = (nM - fm) < WGM ? (nM - fm) : WGM;
        u.pm = fm + ((wgid % nig) % gsz); u.pn = (wgid % nig) / gsz; return true;
    }
    __device__ __forceinline__ void a_ready(const Unit&) const {}
    __device__ __forceinline__ void done(const Unit&) const {}
};

__device__ __forceinline__ unsigned cvt_pk_bf16(float lo, float hi) { unsigned r; asm volatile("v_cvt_pk_bf16_f32 %0, %1, %2" : "=v"(r) : "v"(lo), "v"(hi)); return r; }
typedef float f32x2 __attribute__((ext_vector_type(2)));
__device__ __forceinline__ float row_rstd(const float* ssq, int row) {
    const f32x4* p = (const f32x4*)(ssq + (size_t)row * 16);
    const f32x4 a = p[0], b = p[1], c = p[2], d = p[3];
    const float s = ((a[0] + a[1]) + (a[2] + a[3])) + ((b[0] + b[1]) + (b[2] + b[3])) + ((c[0] + c[1]) + (c[2] + c[3])) + ((d[0] + d[1]) + (d[2] + d[3]));
    return __builtin_amdgcn_rsqf(s * (1.0f / 1024.0f) + 1e-6f);
}
__device__ __forceinline__ float silu_f(float x) { return x * __builtin_amdgcn_rcpf(1.0f + __builtin_amdgcn_exp2f(-1.4426950408889634f * x)); }
struct EpiSwiglu {
    static constexpr bool PERM = true, AFTER_DRAIN = false;
    bf16_t* H; int ldh; const float* ssq;
    __device__ __forceinline__ void operator()(const f32x4 (&acc)[2][2][4][2], const Unit& u, int wr, int wc, int fr, int fq) const {
        const int row0 = u.pm * BM + wr * 64 + fr, col0 = u.pn * HALF + wc * 32 + 8 * fq;
#pragma unroll
        for (int ai = 0; ai < 2; ++ai)
#pragma unroll
            for (int m = 0; m < 4; ++m) { const int row = row0 + ai * HALF + m * 16; const float rs = row_rstd(ssq, row);
                const f32x4 g0 = acc[ai][0][m][0] * rs, g1 = acc[ai][0][m][1] * rs, u0 = acc[ai][1][m][0] * rs, u1 = acc[ai][1][m][1] * rs;
                u32x4 w; w.x = cvt_pk_bf16(silu_f(g0[0]) * u0[0], silu_f(g0[1]) * u0[1]); w.y = cvt_pk_bf16(silu_f(g0[2]) * u0[2], silu_f(g0[3]) * u0[3]);
                w.z = cvt_pk_bf16(silu_f(g1[0]) * u1[0], silu_f(g1[1]) * u1[1]); w.w = cvt_pk_bf16(silu_f(g1[2]) * u1[2], silu_f(g1[3]) * u1[3]);
                *(u32x4*)(H + (size_t)row * ldh + col0) = w; }
    }
};
struct EpiProj {
    static constexpr bool PERM = true, AFTER_DRAIN = false;
    bf16_t* OA; int ldA; int ntA; bf16_t* OB; int ldB; int tpB; size_t strideB; const float* ssq;
    __device__ __forceinline__ void operator()(const f32x4 (&acc)[2][2][4][2], const Unit& u, int wr, int wc, int fr, int fq) const {
        const int row0 = u.pm * BM + wr * 64 + fr; bf16_t* base; int ld, colt;
        if (u.pn < ntA) { base = OA; ld = ldA; colt = u.pn * BM; } else { const int q = u.pn - ntA, t = q / tpB; base = OB + (size_t)t * strideB; ld = ldB; colt = (q - t * tpB) * BM; }
        const int col0 = colt + wc * 32 + 8 * fq;
#pragma unroll
        for (int ai = 0; ai < 2; ++ai)
#pragma unroll
            for (int m = 0; m < 4; ++m) { const int row = row0 + ai * HALF + m * 16; const float rs = row_rstd(ssq, row); bf16_t* rowp = base + (size_t)row * ld + col0;
#pragma unroll
                for (int bj = 0; bj < 2; ++bj) { const f32x4 v0 = acc[ai][bj][m][0] * rs, v1 = acc[ai][bj][m][1] * rs;
                    u32x4 w; w.x = cvt_pk_bf16(v0[0], v0[1]); w.y = cvt_pk_bf16(v0[2], v0[3]); w.z = cvt_pk_bf16(v1[0], v1[1]); w.w = cvt_pk_bf16(v1[2], v1[3]);
                    *(u32x4*)(rowp + bj * HALF) = w; } }
    }
};
struct EpiResid {
    static constexpr bool PERM = false, AFTER_DRAIN = false;
    const float* base; float* X; bf16_t* XB; float* ssq; float alpha;
    __device__ __forceinline__ void operator()(const f32x4 (&acc)[2][2][4][2], const Unit& u, int wr, int wc, int fr, int fq) const {
        typedef unsigned u32x2v __attribute__((ext_vector_type(2)));
        const int row0 = u.pm * BM + wr * 64 + fr, col0 = u.pn * BM + wc * 32 + 4 * fq;
#pragma unroll
        for (int ai = 0; ai < 2; ++ai)
#pragma unroll
            for (int m = 0; m < 4; ++m) { const int row = row0 + ai * HALF + m * 16; const size_t off = (size_t)row * 1024 + col0; float ss = 0.f;
#pragma unroll
                for (int bj = 0; bj < 2; ++bj)
#pragma unroll
                    for (int n = 0; n < 2; ++n) { const f32x4 b = *(const f32x4*)(base + off + bj * HALF + n * 16); const f32x4 o = b + acc[ai][bj][m][n] * alpha;
                        *(f32x4*)(X + off + bj * HALF + n * 16) = o; u32x2v w; w.x = cvt_pk_bf16(o[0], o[1]); w.y = cvt_pk_bf16(o[2], o[3]); *(u32x2v*)(XB + off + bj * HALF + n * 16) = w;
                        ss += (o[0] * o[0] + o[1] * o[1]) + (o[2] * o[2] + o[3] * o[3]); }
                ss += __shfl_xor(ss, 16); ss += __shfl_xor(ss, 32);
                if (fq == 0) ssq[(size_t)row * 16 + u.pn * 4 + wc] = ss;
                asm volatile("" ::: "memory"); }
    }
};
template <class Epi, class Sched, bool ALIGN_EPI = false, bool SP2 = false>
__device__ __forceinline__ void gemm_phase(PG8_LAS unsigned char* lds, const Gemm g, const Sched& S, const Epi& E) {
    int tid_l = threadIdx.x; asm volatile("" : "+v"(tid_l));
    const int tid = tid_l, wid = __builtin_amdgcn_readfirstlane(tid >> 6), lane = tid & 63, wr = wid >> 2, wc = wid & 3, fr = lane & 15, fq = lane >> 4;
    const int K = g.K, nt = K / BK;
    unsigned voffA[2], voffB[2];
#pragma unroll
    for (int i = 0; i < 2; ++i) { int R, C; stage_rc(tid * 16 + i * 8192, R, C); const int Rb = Epi::PERM ? ((R & ~31) + perm32(R & 31)) : R;
        voffA[i] = (unsigned)(R * K + C) * 2u; voffB[i] = (unsigned)(Rb * K + C) * 2u; }
    const size_t kstep = (size_t)(BK * 2);
    const size_t hstep = (size_t)HALF * K * 2;
    const size_t tstep = 2 * hstep;
    const unsigned ldsw = (unsigned)wid * 1024u;
    const int aoff = lds_byte(wr * 64 + fr, fq * 8), boff = lds_byte(wc * 32 + fr, fq * 8);
#define PG8_SA(b, h) (((b) * 2 + (h)) * HTB)
#define PG8_SB(b, h) ((4 + (b) * 2 + (h)) * HTB)
#define PG8_STAGE(bufoff, gbase, voff) do { _Pragma("unroll") for (int _i = 0; _i < 2; ++_i) \
        __builtin_amdgcn_global_load_lds((const unsigned*)((const char*)(gbase) + (voff)[_i]), (PG8_LAS unsigned*)(lds + (bufoff) + ldsw + _i * 8192), 16, 0, 0); } while (0)
#define PG8_LDA(dst, b, h) do { _Pragma("unroll") for (int m = 0; m < 4; ++m) _Pragma("unroll") for (int k = 0; k < 2; ++k) dst[m][k] = *(const PG8_LAS bf16x8*)(lds + PG8_SA(b, h) + aoff + m * 2048 + k * 1024); } while (0)
#define PG8_LDB(dst, b, h) do { _Pragma("unroll") for (int n = 0; n < 2; ++n) _Pragma("unroll") for (int k = 0; k < 2; ++k) dst[n][k] = *(const PG8_LAS bf16x8*)(lds + PG8_SB(b, h) + boff + n * 2048 + k * 1024); } while (0)
#define PG8_MMA(ai, bj, At, Bt) do { __builtin_amdgcn_s_setprio(1); _Pragma("unroll") for (int m = 0; m < 4; ++m) _Pragma("unroll") for (int n = 0; n < 2; ++n) _Pragma("unroll") for (int k = 0; k < 2; ++k) \
        acc[ai][bj][m][n] = __builtin_amdgcn_mfma_f32_16x16x32_bf16(Bt[n][k], At[m][k], acc[ai][bj][m][n], 0, 0, 0); __builtin_amdgcn_s_setprio(0); } while (0)
#define PG8_WAIT_V(n) asm volatile("s_waitcnt vmcnt(" #n ")" ::: "memory")
#define PG8_WAIT_L(n) asm volatile("s_waitcnt lgkmcnt(" #n ")" ::: "memory")
#define PG8_BAR __builtin_amdgcn_s_barrier()
#define PG8_SCHED __builtin_amdgcn_sched_barrier(0)
    Unit cur, nxt; int ui = 0;
    if (!S.next(0, cur)) return;
    f32x4 acc[2][2][4][2];
#pragma unroll
    for (int a = 0; a < 2; ++a)
#pragma unroll
        for (int b = 0; b < 2; ++b)
#pragma unroll
            for (int m = 0; m < 4; ++m)
#pragma unroll
                for (int n = 0; n < 2; ++n) acc[a][b][m][n] = (f32x4){0.f, 0.f, 0.f, 0.f};
    bf16x8 At[4][2], B0[2][2], B1[2][2];
    const char* cA = (const char*)g.A + (size_t)cur.pm * tstep; const char* cB = (const char*)g.Bt + (size_t)cur.pn * tstep;
    S.a_ready(cur);
    if constexpr (SP2) {
        PG8_STAGE(PG8_SB(0, 0), cB, voffB); PG8_STAGE(PG8_SB(0, 1), cB + hstep, voffB); PG8_STAGE(PG8_SA(0, 0), cA, voffA); PG8_STAGE(PG8_SA(0, 1), cA + hstep, voffA);
        if (wr == 1) PG8_BAR;
        PG8_WAIT_V(2); PG8_BAR;
        PG8_STAGE(PG8_SB(1, 0), cB + kstep, voffB); PG8_STAGE(PG8_SA(1, 0), cA + kstep, voffA); PG8_STAGE(PG8_SB(1, 1), cB + hstep + kstep, voffB);
        PG8_WAIT_V(6); PG8_BAR;
    } else {
        PG8_STAGE(PG8_SB(0, 0), cB, voffB); PG8_STAGE(PG8_SA(0, 0), cA, voffA); PG8_STAGE(PG8_SB(0, 1), cB + hstep, voffB); PG8_STAGE(PG8_SA(0, 1), cA + hstep, voffA);
        if (wr == 1) PG8_BAR;
        PG8_WAIT_V(4); PG8_BAR;
        PG8_STAGE(PG8_SB(1, 0), cB + kstep, voffB); PG8_STAGE(PG8_SA(1, 0), cA + kstep, voffA); PG8_STAGE(PG8_SB(1, 1), cB + hstep + kstep, voffB);
        PG8_WAIT_V(6); PG8_BAR;
    }
    for (;;) {
        const bool has_next = S.next(ui + 1, nxt);
        const char* nA = has_next ? (const char*)g.A + (size_t)nxt.pm * tstep : cA; const char* nB = has_next ? (const char*)g.Bt + (size_t)nxt.pn * tstep : cB;
        for (int t = 0; t < nt; t += 2) {
            const bool last = (t == nt - 2);
            const char* a1 = cA + (size_t)(t + 1) * kstep;
            const char* a2 = last ? nA : cA + (size_t)(t + 2) * kstep; const char* b2 = last ? nB : cB + (size_t)(t + 2) * kstep;
            const char* a3 = a2 + kstep; const char* b3 = b2 + kstep;
            if (last && has_next) S.a_ready(nxt);
            if constexpr (SP2) {
            PG8_LDB(B0, 0, 0); PG8_LDB(B1, 0, 1); PG8_SCHED; PG8_LDA(At, 0, 0); PG8_STAGE(PG8_SA(1, 1), a1 + hstep, voffA);
            PG8_WAIT_V(8); PG8_WAIT_L(0); PG8_BAR; PG8_MMA(0, 0, At, B0); PG8_MMA(0, 1, At, B1); PG8_BAR; PG8_SCHED;
            PG8_LDA(At, 0, 1); PG8_STAGE(PG8_SB(0, 0), b2, voffB); PG8_STAGE(PG8_SB(0, 1), b2 + hstep, voffB); PG8_STAGE(PG8_SA(0, 0), a2, voffA);
            PG8_WAIT_V(8); PG8_WAIT_L(0); PG8_BAR; PG8_MMA(1, 0, At, B0); PG8_MMA(1, 1, At, B1); PG8_BAR; PG8_SCHED;
            PG8_LDB(B0, 1, 0); PG8_LDB(B1, 1, 1); PG8_SCHED; PG8_LDA(At, 1, 0); PG8_STAGE(PG8_SA(0, 1), a2 + hstep, voffA);
            PG8_WAIT_V(8); PG8_WAIT_L(0); PG8_BAR; PG8_MMA(0, 0, At, B0); PG8_MMA(0, 1, At, B1); PG8_BAR; PG8_SCHED;
            PG8_LDA(At, 1, 1); PG8_STAGE(PG8_SB(1, 0), b3, voffB); PG8_STAGE(PG8_SB(1, 1), b3 + hstep, voffB); PG8_STAGE(PG8_SA(1, 0), a3, voffA);
            PG8_WAIT_V(8); PG8_WAIT_L(0); PG8_BAR; PG8_MMA(1, 0, At, B0); PG8_MMA(1, 1, At, B1); PG8_BAR; PG8_SCHED;
            } else {
            PG8_LDB(B0, 0, 0); PG8_SCHED; PG8_LDA(At, 0, 0); PG8_STAGE(PG8_SA(1, 1), a1 + hstep, voffA);
            PG8_WAIT_L(8); PG8_BAR; PG8_WAIT_L(0); PG8_MMA(0, 0, At, B0); PG8_BAR; PG8_SCHED;
            PG8_LDB(B1, 0, 1); PG8_STAGE(PG8_SB(0, 0), b2, voffB);
            PG8_BAR; PG8_WAIT_L(0); PG8_MMA(0, 1, At, B1); PG8_BAR;
            PG8_LDA(At, 0, 1); PG8_STAGE(PG8_SA(0, 0), a2, voffA);
            PG8_BAR; PG8_WAIT_L(0); PG8_MMA(1, 0, At, B0); PG8_BAR; PG8_SCHED;
            PG8_STAGE(PG8_SB(0, 1), b2 + hstep, voffB);
            PG8_WAIT_V(6); PG8_BAR; PG8_MMA(1, 1, At, B1); PG8_BAR;
            PG8_LDB(B0, 1, 0); PG8_SCHED; PG8_LDA(At, 1, 0); PG8_STAGE(PG8_SA(0, 1), a2 + hstep, voffA);
            PG8_WAIT_L(8); PG8_BAR; PG8_WAIT_L(0); PG8_MMA(0, 0, At, B0); PG8_BAR; PG8_SCHED;
            PG8_LDB(B1, 1, 1); PG8_STAGE(PG8_SB(1, 0), b3, voffB);
            PG8_BAR; PG8_WAIT_L(0); PG8_MMA(0, 1, At, B1); PG8_BAR;
            PG8_LDA(At, 1, 1); PG8_STAGE(PG8_SA(1, 0), a3, voffA);
            PG8_BAR; PG8_WAIT_L(0); PG8_MMA(1, 0, At, B0); PG8_BAR; PG8_SCHED;
            PG8_STAGE(PG8_SB(1, 1), b3 + hstep, voffB);
            PG8_WAIT_V(6); PG8_BAR; PG8_MMA(1, 1, At, B1); PG8_BAR;
            }
        }
        if constexpr (ALIGN_EPI) { if (wr == 0) PG8_BAR; }
        if constexpr (!Epi::AFTER_DRAIN) { E(acc, cur, wr, wc, fr, fq); S.done(cur); }
        if (!has_next) break;
#pragma unroll
        for (int a = 0; a < 2; ++a)
#pragma unroll
            for (int b = 0; b < 2; ++b)
#pragma unroll
                for (int m = 0; m < 4; ++m)
#pragma unroll
                    for (int n = 0; n < 2; ++n) acc[a][b][m][n] = (f32x4){0.f, 0.f, 0.f, 0.f};
        cur = nxt; cA = nA; cB = nB; ++ui;
        if constexpr (ALIGN_EPI) { if (wr == 1) PG8_BAR; }
    }
    PG8_WAIT_V(0);
    if constexpr (!ALIGN_EPI) { if (wr == 0) PG8_BAR; }
    PG8_BAR;
    if constexpr (Epi::AFTER_DRAIN) { E.fused(acc, cur, wr, wc, fr, fq, lds, wid, lane); S.done(cur); }
#undef PG8_SA
#undef PG8_SB
#undef PG8_STAGE
#undef PG8_LDA
#undef PG8_LDB
#undef PG8_MMA
#undef PG8_WAIT_V
#undef PG8_WAIT_L
#undef PG8_BAR
#undef PG8_SCHED
}
}

#define GAS __attribute__((address_space(1)))
#define LAS __attribute__((address_space(3)))
typedef unsigned short bf16;
typedef unsigned v4u __attribute__((ext_vector_type(4)));
typedef float f32x4 __attribute__((ext_vector_type(4)));
typedef short bf16x8 __attribute__((ext_vector_type(8)));
typedef GAS unsigned gu32;
typedef GAS unsigned long long gu64;
#define RLX_AGENT __ATOMIC_RELAXED, __HIP_MEMORY_SCOPE_AGENT
#define LDS_WAIT() asm volatile("s_waitcnt lgkmcnt(0)" ::: "memory")
#define VM_WAIT() asm volatile("s_waitcnt vmcnt(0)" ::: "memory")
__device__ __forceinline__ unsigned long long rt() { return __builtin_amdgcn_s_memrealtime(); }
__device__ __forceinline__ unsigned f2bf(float f) { unsigned u = __builtin_bit_cast(unsigned, f); return (u + 0x7fffu + ((u >> 16) & 1u)) >> 16; }
__device__ __forceinline__ unsigned pk2(float lo, float hi) { return f2bf(lo) | (f2bf(hi) << 16); }
#define XB_TMO      128
#define XB_XCNT(j)  (256  + 64 * (j))
#define XB_XSUB(j)  (1280 + 64 * (j))
#define XB_XGEN(j)  (2304 + 64 * (j))
#define XB_TOP      3328
#define XB_TOPGEN   3392
#define XCD_BAR_WORDS 3456
#define XB_SPIN_CAP (1u << 18)

__device__ __forceinline__ unsigned xb_ld(unsigned* p)              { return __hip_atomic_load(p, __ATOMIC_RELAXED, __HIP_MEMORY_SCOPE_AGENT); }
__device__ __forceinline__ unsigned xb_add(unsigned* p, unsigned v) { return __hip_atomic_fetch_add(p, v, __ATOMIC_RELAXED, __HIP_MEMORY_SCOPE_AGENT); }
__device__ __forceinline__ unsigned xb_xcc_id() { return (unsigned)__builtin_amdgcn_s_getreg((3 << 11) | 20) & 0xFu; }
#define XB_SPIN(cond, bar) do { unsigned _sp = 0; while (cond) { __builtin_amdgcn_s_sleep(1); \
    if ((++_sp & 255u) == 0u) { if (xb_ld(&(bar)[XB_TMO])) break; if (_sp > XB_SPIN_CAP) { atomicAdd(&(bar)[XB_TMO], 1u); break; } } } } while (0)

struct XcdBarrier {
    unsigned* bar; unsigned x;
    volatile LAS unsigned* st;
};

__device__ __forceinline__ XcdBarrier xcd_barrier_post(unsigned* bar, volatile LAS unsigned* st) {
    XcdBarrier b; b.bar = bar; b.x = xb_xcc_id(); b.st = st;
    if (threadIdx.x == 0) (void)xb_add(&bar[XB_XCNT(b.x)], 1u);
    return b;
}
__device__ __forceinline__ void xcd_barrier_complete(unsigned* bar, unsigned x, unsigned& nloc, unsigned& nx) {
    const unsigned G = gridDim.x * gridDim.y * gridDim.z;
    unsigned sum, cnt, mine, sp = 0u;
    for (;;) {
        sum = 0u; cnt = 0u; mine = 0u;
#pragma unroll 1
        for (unsigned j = 0; j < 16; ++j) { const unsigned c = xb_ld(&bar[XB_XCNT(j)]); sum += c; cnt += (c > 0u) ? 1u : 0u; mine = (j == x) ? c : mine; }
        if (sum == G) break;
        __builtin_amdgcn_s_sleep(1);
        if ((++sp & 255u) == 0u) { if (xb_ld(&bar[XB_TMO])) break; if (sp > XB_SPIN_CAP) { atomicAdd(&bar[XB_TMO], 1u); break; } }
    }
    nloc = mine > 0u ? mine : 1u; nx = cnt > 0u ? cnt : 1u;
}

__device__ __forceinline__ void xcd_barrier(const XcdBarrier& b) {
    asm volatile("s_waitcnt vmcnt(0)" ::: "memory");
    __syncthreads();
    if (threadIdx.x == 0) {
        unsigned* bar = b.bar;
        __builtin_amdgcn_s_waitcnt(0);
        unsigned nloc = b.st[0], nx = b.st[1];
        if (nloc == 0u) { xcd_barrier_complete(bar, b.x, nloc, nx); b.st[0] = nloc; b.st[1] = nx; }
        const unsigned old = xb_add(&bar[XB_XSUB(b.x)], 1u);
        const unsigned gen = old / nloc;
        if (old + 1u == (gen + 1u) * nloc) {
            __builtin_amdgcn_fence(__ATOMIC_RELEASE, "agent");
            asm volatile("s_waitcnt vmcnt(0)" ::: "memory");
            const unsigned og = xb_add(&bar[XB_TOP], 1u);
            const unsigned tg = og / nx;
            if (og + 1u == (tg + 1u) * nx) xb_add(&bar[XB_TOPGEN], 1u);
            else XB_SPIN(xb_ld(&bar[XB_TOPGEN]) == tg, bar);
            __builtin_amdgcn_fence(__ATOMIC_ACQUIRE, "agent");
            xb_add(&bar[XB_XGEN(b.x)], 1u);
            asm volatile("s_waitcnt vmcnt(0)" ::: "memory");
        } else {
            XB_SPIN(xb_ld(&bar[XB_XGEN(b.x)]) == gen, bar);
            __builtin_amdgcn_fence(__ATOMIC_ACQUIRE, "agent");
            asm volatile("s_waitcnt vmcnt(0)" ::: "memory");
        }
    }
    __syncthreads();
}
constexpr int BATCH = 8, SEQ = 2048, D = 1024, M = BATCH * SEQ, FF = 2816;
constexpr int RW_COLS = 1792, EV_IN = 3328, OD_IN = 4096;
constexpr int NWAVES = 8, NTHREADS = NWAVES * 64;
constexpr int N_IN = 26;
constexpr size_t MiB = 1u << 20;
constexpr size_t WS_CTL = 0, CTL_ZERO_BYTES = 1 * MiB;
constexpr size_t WS_SSQ = 1 * MiB;
constexpr size_t WS_KMEAN = 2 * MiB;
constexpr size_t WS_W = 3 * MiB;
constexpr size_t W_UP_BYTES = (size_t)2 * FF * D * 2, W_DN_BYTES = (size_t)D * FF * 2;
constexpr size_t WS_WUP = WS_W, WS_WDN = WS_WUP + 4 * W_UP_BYTES, WS_WEVIN = WS_WDN + 4 * W_DN_BYTES, WS_WEVOUT = WS_WEVIN + (size_t)EV_IN * D * 2,
                 WS_WODIN = WS_WEVOUT + (size_t)D * D * 2, WS_WODOUT = WS_WODIN + (size_t)OD_IN * D * 2, WS_WEND = WS_WODOUT + (size_t)D * D * 2;
constexpr size_t WS_XB = 88 * MiB;
constexpr size_t WS_H = 120 * MiB;
constexpr size_t WS_PR = 120 * MiB, WS_QB = 176 * MiB, WS_KB = 192 * MiB, WS_VB = 208 * MiB, WS_Y = 224 * MiB;
constexpr size_t WS_HQ = 120 * MiB, WS_HF = 152 * MiB, WS_HI = 184 * MiB, WS_HG = 216 * MiB;
constexpr size_t WS_END = 256 * MiB;
static_assert(WS_WEND <= WS_XB && WS_H + (size_t)M * FF * 2 <= WS_Y + 0 * MiB + 32 * MiB && WS_PR + (size_t)M * RW_COLS * 2 <= WS_QB && WS_Y + (size_t)M * D * 2 <= WS_END && WS_HG + (size_t)M * D * 2 <= WS_END, "d_ws map");
constexpr int CW_BAR = 4096;
constexpr int RING_BYTES = 131072, LDSCTL_OFF = RING_BYTES, MISC_OFF = LDSCTL_OFF + 320, LDS_BYTES = 147456;

__device__ __forceinline__ float bf2f(bf16 v) { return __builtin_bit_cast(float, (unsigned)v << 16); }
__device__ __forceinline__ float sigm(float x) { return 1.0f / (1.0f + __expf(-x)); }
__device__ __forceinline__ float wave_sum(float v) {
#pragma unroll
    for (int o = 1; o < 64; o <<= 1) v += __shfl_xor(v, o);
    return v;
}
__device__ __forceinline__ float wave_max(float v) {
#pragma unroll
    for (int o = 1; o < 64; o <<= 1) v = fmaxf(v, __shfl_xor(v, o));
    return v;
}

struct Frame {
    LAS unsigned char* lds; volatile LAS unsigned* MISC; gu32* ctl;
    int tid, lane, wave, vcu, G;
    float* out; unsigned char* ws;
};
#define WSP(T, off) ((T*)(F.ws + (off)))
constexpr int PTAB_OFF = LDSCTL_OFF + 1024;
__device__ __forceinline__ const float* inp(const Frame& F, int i) {
    const unsigned long long v = ((const LAS unsigned long long*)(F.lds + PTAB_OFF))[i];
    const unsigned lo = __builtin_amdgcn_readfirstlane((unsigned)v), hi = __builtin_amdgcn_readfirstlane((unsigned)(v >> 32));
    return (const float*)(((unsigned long long)hi << 32) | lo);
}
__device__ __forceinline__ bool in_range(int k, int lo, int hi) { asm volatile("" : "+s"(lo), "+s"(hi)); return lo <= k && k < hi; }
#define PHASE_FRAME(FP) Frame FP = F0; asm volatile("" : "+v"(FP.tid), "+v"(FP.lane)); asm volatile("" : "+s"(FP.wave), "+s"(FP.vcu), "+s"(FP.G), "+s"(FP.ws), "+s"(FP.out))
struct Args { const float* in[N_IN]; float* out; unsigned char* ws; int ph_lo, ph_hi, li, pad; };

__device__ __forceinline__ void transpose_item(const float* W, int K, int N, const float* gain, bf16* WT, int mode, LAS float* scr, int item, int lane) {
    const int nblk = N / 32, kb = item / nblk, nb = item % nblk, k0 = 64 * kb, n0 = 32 * nb;
#pragma unroll 8
    for (int i = 0; i < 32; ++i) { const int kk = 2 * i + (lane >> 5); const float g = gain ? gain[k0 + kk] : 1.0f; scr[kk * 33 + (lane & 31)] = W[(size_t)(k0 + kk) * N + n0 + (lane & 31)] * g; }
    LDS_WAIT(); asm volatile("" ::: "memory");
    const int c = lane & 7; const int rbase = (mode == 0) ? n0 : (n0 + 128 * (n0 >> 7) + (mode == 2 ? 128 : 0));
#pragma unroll
    for (int j = 0; j < 4; ++j) { const int n = (lane >> 3) + 8 * j; const LAS float* s = scr + (8 * c) * 33 + n;
        v4u o; o.x = pk2(s[0 * 33], s[1 * 33]); o.y = pk2(s[2 * 33], s[3 * 33]); o.z = pk2(s[4 * 33], s[5 * 33]); o.w = pk2(s[6 * 33], s[7 * 33]);
        *(GAS v4u*)(WT + (size_t)(rbase + n) * K + k0 + 8 * c) = o; }
    LDS_WAIT(); asm volatile("" ::: "memory");
}
__device__ __forceinline__ void prologue_phase(Frame& F) {
    LAS float* scr = (LAS float*)(F.lds + F.wave * 16384);
    const int gw = F.vcu * NWAVES + F.wave, NGW = F.G * NWAVES;
    constexpr int I_FF = (D / 64) * (FF / 32);
    constexpr int I_EVIN = (D / 64) * (EV_IN / 32), I_OUT = (D / 64) * (D / 32), I_ODIN = (D / 64) * (OD_IN / 32);
    constexpr int NITEMS = 12 * I_FF + I_EVIN + I_OUT + I_ODIN + I_OUT;
    const float* ng = inp(F, 1);
    for (int it = gw; it < NITEMS; it += NGW) {
        int r = it;
        if (r < 12 * I_FF) { const int f = r / (3 * I_FF); r -= f * 3 * I_FF; const int which = r / I_FF; r -= which * I_FF; const int l = f >> 1, second = f & 1;
            const float* gain = ng + (size_t)(l * 3 + (second ? 2 : 0)) * D;
            if (which == 0) transpose_item((second ? inp(F, 5) : inp(F, 2)) + (size_t)l * D * FF, D, FF, gain, WSP(bf16, WS_WUP + f * W_UP_BYTES), 1, scr, r, F.lane);
            else if (which == 1) transpose_item((second ? inp(F, 6) : inp(F, 3)) + (size_t)l * D * FF, D, FF, gain, WSP(bf16, WS_WUP + f * W_UP_BYTES), 2, scr, r, F.lane);
            else transpose_item((second ? inp(F, 7) : inp(F, 4)) + (size_t)l * FF * D, FF, D, nullptr, WSP(bf16, WS_WDN + f * W_DN_BYTES), 0, scr, r, F.lane);
            continue; }
        r -= 12 * I_FF;
        if (r < I_EVIN) { transpose_item(inp(F, 8), D, EV_IN, ng + 1 * D, WSP(bf16, WS_WEVIN), 0, scr, r, F.lane); continue; } r -= I_EVIN;
        if (r < I_OUT) { transpose_item(inp(F, 9), D, D, nullptr, WSP(bf16, WS_WEVOUT), 0, scr, r, F.lane); continue; } r -= I_OUT;
        if (r < I_ODIN) { transpose_item(inp(F, 21), D, OD_IN, ng + 4 * D, WSP(bf16, WS_WODIN), 0, scr, r, F.lane); continue; } r -= I_ODIN;
        transpose_item(inp(F, 22), D, D, nullptr, WSP(bf16, WS_WODOUT), 0, scr, r, F.lane);
    }
    const float* x = inp(F, 0); bf16* XB = WSP(bf16, WS_XB); float* ssq = WSP(float, WS_SSQ);
    for (int m = gw; m < M; m += NGW) {
        const GAS f32x4* xr = (const GAS f32x4*)(x + (size_t)m * D) + F.lane; f32x4 v[4]; float s = 0.f;
#pragma unroll
        for (int j = 0; j < 4; ++j) { v[j] = xr[64 * j]; s += (v[j].x * v[j].x + v[j].y * v[j].y) + (v[j].z * v[j].z + v[j].w * v[j].w); }
        s = wave_sum(s);
        GAS unsigned long long* o8 = (GAS unsigned long long*)(XB + (size_t)m * D) + F.lane;
#pragma unroll
        for (int j = 0; j < 4; ++j) o8[64 * j] = (unsigned long long)pk2(v[j].x, v[j].y) | ((unsigned long long)pk2(v[j].z, v[j].w) << 32);
        if (F.lane < 16) ssq[(size_t)m * 16 + F.lane] = (F.lane == 0) ? s : 0.f;
    }
}

__device__ __forceinline__ float softplus_f(float x) { return fmaxf(x, 0.f) + log1pf(__expf(-fabsf(x))); }
__device__ __forceinline__ void rwkv_chain(Frame& F, int ch) {
    constexpr int T = 16;
    LAS float* L = (LAS float*)F.lds;
    LAS float* W2s = L; LAS float* A2s = L + 4096; LAS float* G2s = L + 8192; LAS float* lora = L + 16384;
    LAS float* sR = L + 20480; LAS float* sW = sR + 1024; LAS float* sK = sW + 1024; LAS float* sV = sK + 1024; LAS float* sKK = sV + 1024; LAS float* sKA = sKK + 1024; LAS float* sG = sKA + 1024;
    LAS float* sY = sG + 1024; LAS float* sBon = sY + 1024;
    const bf16* PR = WSP(bf16, WS_PR); bf16* Y = WSP(bf16, WS_Y);
    const float* mu = inp(F, 10); const float* w0 = inp(F, 11); const float* w2 = inp(F, 12); const float* a0 = inp(F, 13); const float* a2 = inp(F, 14); const float* g2 = inp(F, 15);
    const float* k_k = inp(F, 16); const float* k_a = inp(F, 17); const float* r_k = inp(F, 18); const float* lnw = inp(F, 19); const float* lnb = inp(F, 20);
    const int b = ch >> 3, h = ch & 7, tid = F.tid, lane = F.lane;
    __syncthreads();
    for (int idx = tid; idx < 4096; idx += NTHREADS) { const int j = idx >> 6, c = idx & 63; W2s[idx] = w2[j * 512 + h * 64 + c]; A2s[idx] = a2[j * 512 + h * 64 + c]; }
    for (int idx = tid; idx < 8192; idx += NTHREADS) { const int j = idx >> 6, c = idx & 63; G2s[idx] = g2[j * 512 + h * 64 + c]; }
    float S[8];
#pragma unroll
    for (int j = 0; j < 8; ++j) S[j] = 0.f;
    const int tt = tid >> 5, c0 = (tid & 31) * 2;
    const int srow = F.wave * 8 + (lane >> 3), ks = lane & 7;
    for (int t0 = 0; t0 < SEQ; t0 += T) {
        __syncthreads();
        for (int idx = tid; idx < T * 256; idx += NTHREADS) { const int tl = idx >> 8, j = idx & 255, col = 1536 + j; const size_t row = (size_t)b * SEQ + t0 + tl;
            const float cur = bf2f(PR[row * RW_COLS + col]); const float prev = (t0 + tl > 0) ? bf2f(PR[(row - 1) * RW_COLS + col]) : 0.f;
            float v = cur + (prev - cur) * mu[col]; v = (j < 64) ? tanhf(v) : ((j < 128) ? v : sigm(v)); lora[idx] = v; }
        __syncthreads();
        {   const size_t row = (size_t)b * SEQ + t0 + tt; const bool hp = (t0 + tt > 0);
            float kkv[2], av[2], rv[2], kv[2], vv[2], gv[2], wv[2]; float ssk = 0.f, bon = 0.f;
#pragma unroll
            for (int e = 0; e < 2; ++e) { const int c = c0 + e, gc = h * 64 + c;
                float cur = bf2f(PR[row * RW_COLS + gc]), prev = hp ? bf2f(PR[(row - 1) * RW_COLS + gc]) : 0.f; const float r = cur + (prev - cur) * mu[gc];
                cur = bf2f(PR[row * RW_COLS + 512 + gc]); prev = hp ? bf2f(PR[(row - 1) * RW_COLS + 512 + gc]) : 0.f; const float k = cur + (prev - cur) * mu[512 + gc];
                cur = bf2f(PR[row * RW_COLS + 1024 + gc]); prev = hp ? bf2f(PR[(row - 1) * RW_COLS + 1024 + gc]) : 0.f; const float v = cur + (prev - cur) * mu[1024 + gc];
                float wd = 0.f, ad = 0.f, gd = 0.f;
                for (int j = 0; j < 64; ++j) { wd += lora[tt * 256 + j] * W2s[j * 64 + c]; ad += lora[tt * 256 + 64 + j] * A2s[j * 64 + c]; }
                for (int j = 0; j < 128; ++j) gd += lora[tt * 256 + 128 + j] * G2s[j * 64 + c];
                const float wraw = -softplus_f(-(w0[gc] + wd)) - 0.5f; wv[e] = __expf(-__expf(wraw));
                av[e] = sigm(a0[gc] + ad); gv[e] = gd; kkv[e] = k * k_k[gc]; ssk += kkv[e] * kkv[e];
                kv[e] = k * (1.0f + (av[e] - 1.0f) * k_a[gc]); rv[e] = r; vv[e] = v; bon += r * kv[e] * r_k[gc]; }
#pragma unroll
            for (int o = 1; o < 32; o <<= 1) { ssk += __shfl_xor(ssk, o); bon += __shfl_xor(bon, o); }
            const float rn = 1.0f / sqrtf(fmaxf(ssk, 1e-24f));
#pragma unroll
            for (int e = 0; e < 2; ++e) { const int i = tt * 64 + c0 + e; const float kk = kkv[e] * rn;
                sR[i] = rv[e]; sW[i] = wv[e]; sK[i] = kv[e]; sV[i] = vv[e]; sKK[i] = kk; sKA[i] = kk * av[e]; sG[i] = gv[e]; }
            if ((tid & 31) == 0) sBon[tt] = bon;
        }
        __syncthreads();
        for (int tl = 0; tl < T; ++tl) { const int o = tl * 64 + ks * 8; float sa = 0.f;
#pragma unroll
            for (int j = 0; j < 8; ++j) sa += S[j] * sKK[o + j];
            sa += __shfl_xor(sa, 1); sa += __shfl_xor(sa, 2); sa += __shfl_xor(sa, 4); sa = -sa;
            const float vv = sV[tl * 64 + srow]; float y = 0.f;
#pragma unroll
            for (int j = 0; j < 8; ++j) { S[j] = S[j] * sW[o + j] + sa * sKA[o + j] + vv * sK[o + j]; y += S[j] * sR[o + j]; }
            y += __shfl_xor(y, 1); y += __shfl_xor(y, 2); y += __shfl_xor(y, 4);
            if (ks == 0) sY[tl * 64 + srow] = y; }
        __syncthreads();
        {   const size_t row = (size_t)b * SEQ + t0 + tt; const float y0 = sY[tt * 64 + c0], y1 = sY[tt * 64 + c0 + 1]; float s = y0 + y1;
#pragma unroll
            for (int o = 1; o < 32; o <<= 1) s += __shfl_xor(s, o);
            const float mean = s * (1.0f / 64.0f); const float d0 = y0 - mean, d1 = y1 - mean; float q = d0 * d0 + d1 * d1;
#pragma unroll
            for (int o = 1; o < 32; o <<= 1) q += __shfl_xor(q, o);
            const float rs = 1.0f / sqrtf(q * (1.0f / 64.0f) + 64e-5f); const float bon = sBon[tt]; const int gc = h * 64 + c0;
            const float o0 = (d0 * rs * lnw[gc] + lnb[gc] + bon * sV[tt * 64 + c0]) * sG[tt * 64 + c0];
            const float o1 = (d1 * rs * lnw[gc + 1] + lnb[gc + 1] + bon * sV[tt * 64 + c0 + 1]) * sG[tt * 64 + c0 + 1];
            *(unsigned*)(Y + row * 1024 + gc) = pk2(o0, o1);
        }
    }
}
__device__ __forceinline__ void kmean_item(Frame& F, int it) {
    const bf16* KB = WSP(bf16, WS_KB); float* km = WSP(float, WS_KMEAN);
    const int b = it >> 3, n = it & 7, c = F.tid; float s = 0.f;
    for (int j = 0; j < 256; ++j) s += bf2f(KB[((size_t)b * SEQ + n * 256 + j) * 512 + c]);
    km[((size_t)(b * 8 + (c >> 6)) * 8 + n) * 64 + (c & 63)] = s * (1.0f / 256.0f);
}
__device__ __forceinline__ void rwkv_kmean_phase(Frame& F) {
    for (int it = F.vcu; it < 128; it += F.G) { if (it < 64) rwkv_chain(F, it); else kmean_item(F, it - 64); }
}

__device__ __forceinline__ void moba_naive_phase(Frame& F) {
    LAS float* qs = (LAS float*)F.lds + F.wave * 1152; LAS float* ps = qs + 64;
    const bf16* QB = WSP(bf16, WS_QB); const bf16* KB = WSP(bf16, WS_KB); const bf16* VB = WSP(bf16, WS_VB); bf16* Y = WSP(bf16, WS_Y); const float* km = WSP(float, WS_KMEAN);
    const int gw = F.vcu * NWAVES + F.wave, NGW = F.G * NWAVES, lane = F.lane; const float NEG = -INFINITY;
    for (int it = gw; it < 8 * 8 * SEQ; it += NGW) {
        const int bh = it >> 11, t = it & 2047, b = bh >> 3, h = bh & 7, own = t >> 8; const size_t row = (size_t)b * SEQ + t;
        const float qv = bf2f(QB[row * 512 + h * 64 + lane]) * 0.125f;
        qs[lane] = qv;
        float gate[7];
#pragma unroll
        for (int n = 0; n < 7; ++n) { const float pr = qv * km[((size_t)bh * 8 + n) * 64 + lane]; const float sm = wave_sum(pr); gate[n] = (n < own) ? sm : NEG; }
        const int nsel = own < 3 ? own : 3; unsigned used = 0u; int blk[4];
#pragma unroll
        for (int s = 0; s < 3; ++s) { int best = 0; float bv = NEG; bool have = false;
#pragma unroll
            for (int n = 0; n < 7; ++n) { const bool ok = (n < own) && !((used >> n) & 1u) && (!have || gate[n] > bv); if (ok) { best = n; bv = gate[n]; have = true; } }
            if (s < nsel) { used |= 1u << best; blk[s] = best; } else blk[s] = (s == nsel) ? own : -1; }
        blk[3] = (nsel == 3) ? own : -1;
        const float slope = exp2f(-(float)(h + 1));
        const int b0 = blk[0], b1 = blk[1], b2 = blk[2], b3 = blk[3];
        float mx = NEG;
#pragma unroll 1
        for (int bi = 0; bi < 4; ++bi) { const int nb = (bi == 0) ? b0 : (bi == 1) ? b1 : (bi == 2) ? b2 : b3;
#pragma unroll 1
            for (int i = 0; i < 4; ++i) { float s = NEG;
                if (nb >= 0) { const int kpos = nb * 256 + i * 64 + lane; const uint4* kp = (const uint4*)(KB + ((size_t)b * SEQ + kpos) * 512 + h * 64); float dot = 0.f;
#pragma unroll
                    for (int d8 = 0; d8 < 8; ++d8) { const uint4 kq = kp[d8];
                        dot += qs[d8 * 8 + 0] * __builtin_bit_cast(float, kq.x << 16); dot += qs[d8 * 8 + 1] * __builtin_bit_cast(float, kq.x & 0xffff0000u);
                        dot += qs[d8 * 8 + 2] * __builtin_bit_cast(float, kq.y << 16); dot += qs[d8 * 8 + 3] * __builtin_bit_cast(float, kq.y & 0xffff0000u);
                        dot += qs[d8 * 8 + 4] * __builtin_bit_cast(float, kq.z << 16); dot += qs[d8 * 8 + 5] * __builtin_bit_cast(float, kq.z & 0xffff0000u);
                        dot += qs[d8 * 8 + 6] * __builtin_bit_cast(float, kq.w << 16); dot += qs[d8 * 8 + 7] * __builtin_bit_cast(float, kq.w & 0xffff0000u); }
                    s = dot - slope * (float)(t - kpos); if (kpos > t) s = NEG; }
                ps[bi * 256 + i * 64 + lane] = s; mx = fmaxf(mx, s); } }
        mx = wave_max(mx); float sum = 0.f;
#pragma unroll 4
        for (int i = 0; i < 16; ++i) { const float p = __expf(ps[i * 64 + lane] - mx); ps[i * 64 + lane] = p; sum += p; }
        sum = wave_sum(sum);
        float o = 0.f;
#pragma unroll 1
        for (int bi = 0; bi < 4; ++bi) { const int nb = (bi == 0) ? b0 : (bi == 1) ? b1 : (bi == 2) ? b2 : b3;
            if (nb >= 0) { const int jmax = (nb == own) ? (t & 255) + 1 : 256; const bf16* vp = VB + ((size_t)b * SEQ + nb * 256) * 512 + h * 64 + lane;
#pragma unroll 4
                for (int j = 0; j < jmax; ++j) o += ps[bi * 256 + j] * bf2f(vp[(size_t)j * 512]); } }
        Y[row * 1024 + 512 + h * 64 + lane] = (bf16)f2bf(o / sum);
    }
}

__device__ __forceinline__ void hgrn_naive_phase(Frame& F) {
    constexpr int T = 16;
    LAS float* L = (LAS float*)F.lds; LAS float* sQ = L; LAS float* sF = L + 2048; LAS float* sKd = L + 4096; LAS float* sI = L + 6144; LAS float* sO = L + 8192;
    const bf16* HQ = WSP(bf16, WS_HQ); const bf16* HF = WSP(bf16, WS_HF); bf16* HI = WSP(bf16, WS_HI); const bf16* HG = WSP(bf16, WS_HG);
    const float* nw = inp(F, 23); const float* lbl = inp(F, 24); const int tid = F.tid;
    for (int ch = F.vcu; ch < 64; ch += F.G) {
        const int b = ch >> 3, h = ch & 7; const int v = tid & 127, kq = tid >> 7;
        float S[32];
#pragma unroll
        for (int j = 0; j < 32; ++j) S[j] = 0.f;
        for (int t0 = 0; t0 < SEQ; t0 += T) {
            __syncthreads();
            for (int idx = tid; idx < T * 128; idx += NTHREADS) { const int tl = idx >> 7, k = idx & 127, gc = h * 128 + k; const size_t row = (size_t)b * SEQ + t0 + tl;
                const float l0 = lbl[gc], l1 = lbl[1024 + gc]; const float lb = 1.0f / (1.0f + __expf(l0 - l1));
                const float sg = sigm(bf2f(HF[row * 1024 + gc]));
                sF[idx] = lb + (1.0f - lb) * sg; sKd[idx] = (1.0f - lb) * (1.0f - sg); sQ[idx] = bf2f(HQ[row * 1024 + gc]); sI[idx] = bf2f(HI[row * 1024 + gc]); }
            __syncthreads();
            for (int tl = 0; tl < T; ++tl) { const float iv = sI[tl * 128 + v]; float o = 0.f; const int kb = tl * 128 + kq * 32;
#pragma unroll
                for (int j = 0; j < 32; ++j) { S[j] = S[j] * sF[kb + j] + sKd[kb + j] * iv; o += sQ[kb + j] * S[j]; }
                sO[(tl * 4 + kq) * 128 + v] = o; }
            __syncthreads();
            {   const int tl = tid >> 5, vp = (tid & 31) * 4; const size_t row = (size_t)b * SEQ + t0 + tl; float o[4]; float ss = 0.f;
#pragma unroll
                for (int e = 0; e < 4; ++e) { o[e] = (sO[(tl * 4 + 0) * 128 + vp + e] + sO[(tl * 4 + 1) * 128 + vp + e]) + (sO[(tl * 4 + 2) * 128 + vp + e] + sO[(tl * 4 + 3) * 128 + vp + e]); ss += o[e] * o[e]; }
#pragma unroll
                for (int of = 1; of < 32; of <<= 1) ss += __shfl_xor(ss, of);
                const float rs = 1.0f / sqrtf(ss * (1.0f / 128.0f) + 1e-6f); float r[4];
#pragma unroll
                for (int e = 0; e < 4; ++e) { const int gc = h * 128 + vp + e; r[e] = o[e] * rs * nw[gc] * sigm(bf2f(HG[row * 1024 + gc])); }
                *(uint2*)(HI + row * 1024 + h * 128 + vp) = make_uint2(pk2(r[0], r[1]), pk2(r[2], r[3]));
            }
        }
    }
}

__device__ __forceinline__ void final_phase(Frame& F) {
    const int gw = F.vcu * NWAVES + F.wave, NGW = F.G * NWAVES; const float* fg = inp(F, 25); const float* ssq = WSP(float, WS_SSQ);
    for (int m = gw; m < M; m += NGW) { const float rs = pg8::row_rstd(ssq, m); GAS f32x4* xr = (GAS f32x4*)(F.out + (size_t)m * D) + F.lane; const f32x4* g4 = (const f32x4*)fg + F.lane;
#pragma unroll
        for (int j = 0; j < 4; ++j) xr[64 * j] = xr[64 * j] * rs * g4[64 * j]; }
}

#ifndef MK_N_LAUNCHES
#define MK_N_LAUNCHES 1
#endif
constexpr int NPHASE = 17;
__global__ void __launch_bounds__(NTHREADS, 2) hyb_fwd(Args args) {
    extern __shared__ __attribute__((aligned(16))) unsigned char lds[];
    Frame F0;
    F0.lds = (LAS unsigned char*)lds; F0.MISC = (volatile LAS unsigned*)(F0.lds + MISC_OFF);
    F0.tid = threadIdx.x; F0.lane = F0.tid & 63; F0.wave = __builtin_amdgcn_readfirstlane(F0.tid >> 6);
    F0.G = gridDim.x; { const int bx = blockIdx.x; F0.vcu = (F0.G % 8 == 0) ? (bx % 8) * (F0.G / 8) + bx / 8 : bx; }
    F0.out = args.out; F0.ws = args.ws; F0.ctl = (gu32*)(args.ws + WS_CTL);
    for (int u = F0.tid; u < (LDS_BYTES - LDSCTL_OFF) / 4; u += NTHREADS) ((LAS unsigned*)(F0.lds + LDSCTL_OFF))[u] = 0u;
    __syncthreads();
    if (F0.tid == 0) {
#pragma unroll
        for (int i = 0; i < N_IN; ++i) ((LAS unsigned long long*)(F0.lds + PTAB_OFF))[i] = (unsigned long long)args.in[i]; }
    __syncthreads();
    XcdBarrier bar; bar.bar = (unsigned*)(F0.ctl + CW_BAR); bar.x = 0; bar.st = nullptr;
    if (MK_N_LAUNCHES == 1) bar = xcd_barrier_post((unsigned*)(F0.ctl + CW_BAR), F0.MISC + 8);
    const int lo = args.ph_lo, hi = args.ph_hi;
#define IN(k) (MK_N_LAUNCHES == 1 || in_range((k), lo, hi))
#define SEAM(k) do { if (MK_N_LAUNCHES == 1) xcd_barrier(bar); } while (0)
    if (IN(0)) { PHASE_FRAME(F); prologue_phase(F); SEAM(0); }
#pragma unroll
    for (int f = 0; f < 4; ++f) {
        const int pu = (f == 0) ? 1 : (f == 1) ? 7 : (f == 2) ? 9 : 14;
        if (IN(pu)) { PHASE_FRAME(F);
            pg8::Gemm g{WSP(bf16, WS_XB), WSP(bf16, WS_WUP + f * W_UP_BYTES), M, 2 * FF, D}; pg8::StaticOrder S; S.init(M, 2 * FF, F.G, (int)blockIdx.x);
            pg8::EpiSwiglu E{WSP(bf16, WS_H), FF, WSP(float, WS_SSQ)};
            pg8::gemm_phase<pg8::EpiSwiglu, pg8::StaticOrder, true, true>(F.lds, g, S, E);
            SEAM(pu);
        }
        if (IN(pu + 1)) { PHASE_FRAME(F);
            pg8::Gemm g{WSP(bf16, WS_H), WSP(bf16, WS_WDN + f * W_DN_BYTES), M, D, FF}; pg8::StaticOrder S; S.init(M, D, F.G, (int)blockIdx.x);
            pg8::EpiResid E{(f == 0) ? inp(F, 0) : F.out, F.out, WSP(bf16, WS_XB), WSP(float, WS_SSQ), 0.5f};
            pg8::gemm_phase<pg8::EpiResid, pg8::StaticOrder, true, true>(F.lds, g, S, E);
            SEAM(pu + 1);
        }
        if (f == 0) {
            if (IN(3)) { PHASE_FRAME(F);
                pg8::Gemm g{WSP(bf16, WS_XB), WSP(bf16, WS_WEVIN), M, EV_IN, D}; pg8::StaticOrder S; S.init(M, EV_IN, F.G, (int)blockIdx.x);
                pg8::EpiProj E{WSP(bf16, WS_PR), RW_COLS, RW_COLS / 256, WSP(bf16, WS_QB), 512, 2, (size_t)M * 512, WSP(float, WS_SSQ)};
                pg8::gemm_phase<pg8::EpiProj, pg8::StaticOrder, true, true>(F.lds, g, S, E);
                SEAM(3);
            }
            if (IN(4)) { PHASE_FRAME(F); rwkv_kmean_phase(F); SEAM(4); }
            if (IN(5)) { PHASE_FRAME(F); moba_naive_phase(F); SEAM(5); }
            if (IN(6)) { PHASE_FRAME(F);
                pg8::Gemm g{WSP(bf16, WS_Y), WSP(bf16, WS_WEVOUT), M, D, D}; pg8::StaticOrder S; S.init(M, D, F.G, (int)blockIdx.x);
                pg8::EpiResid E{F.out, F.out, WSP(bf16, WS_XB), WSP(float, WS_SSQ), 1.0f};
                pg8::gemm_phase<pg8::EpiResid, pg8::StaticOrder, true, true>(F.lds, g, S, E);
                SEAM(6);
            }
        }
        if (f == 2) {
            if (IN(11)) { PHASE_FRAME(F);
                pg8::Gemm g{WSP(bf16, WS_XB), WSP(bf16, WS_WODIN), M, OD_IN, D}; pg8::StaticOrder S; S.init(M, OD_IN, F.G, (int)blockIdx.x);
                pg8::EpiProj E{nullptr, 0, 0, WSP(bf16, WS_HQ), 1024, 4, (size_t)M * 1024, WSP(float, WS_SSQ)};
                pg8::gemm_phase<pg8::EpiProj, pg8::StaticOrder, true, true>(F.lds, g, S, E);
                SEAM(11);
            }
            if (IN(12)) { PHASE_FRAME(F); hgrn_naive_phase(F); SEAM(12); }
            if (IN(13)) { PHASE_FRAME(F);
                pg8::Gemm g{WSP(bf16, WS_HI), WSP(bf16, WS_WODOUT), M, D, D}; pg8::StaticOrder S; S.init(M, D, F.G, (int)blockIdx.x);
                pg8::EpiResid E{F.out, F.out, WSP(bf16, WS_XB), WSP(float, WS_SSQ), 1.0f};
                pg8::gemm_phase<pg8::EpiResid, pg8::StaticOrder, true, true>(F.lds, g, S, E);
                SEAM(13);
            }
        }
    }
    if (IN(16)) { PHASE_FRAME(F); final_phase(F); }
#undef IN
#undef SEAM
}

extern "C" void kernel_launch(void* const* d_in, const int* in_sizes, int n_in, void* d_out, int out_size, void* d_ws, size_t ws_size, hipStream_t stream) {
    static int grid = 0;
    if (grid == 0) {
        if (n_in != N_IN || in_sizes[0] != M * D || out_size != M * D || ws_size < WS_END) { fprintf(stderr, "kernel_launch: unexpected shapes (n_in %d in0 %d out %d ws %zu); nothing launched\n", n_in, n_in > 0 ? in_sizes[0] : -1, out_size, ws_size); grid = -1; return; }
        int dev = 0, cus = 0, per_cu = 0;
        if (hipGetDevice(&dev) != hipSuccess || hipDeviceGetAttribute(&cus, hipDeviceAttributeMultiprocessorCount, dev) != hipSuccess) { grid = -1; return; }
        if (hipFuncSetAttribute((const void*)hyb_fwd, hipFuncAttributeMaxDynamicSharedMemorySize, LDS_BYTES) != hipSuccess) { fprintf(stderr, "kernel_launch: hipFuncSetAttribute failed\n"); grid = -1; return; }
        if (hipOccupancyMaxActiveBlocksPerMultiprocessor(&per_cu, (const void*)hyb_fwd, NTHREADS, LDS_BYTES) != hipSuccess || per_cu < 1) { fprintf(stderr, "kernel_launch: occupancy query says %d\n", per_cu); }
        (void)hipGetLastError();
        grid = cus;
    }
    if (grid < 0) return;
    if (hipMemsetAsync((char*)d_ws + WS_CTL, 0, CTL_ZERO_BYTES, stream) != hipSuccess) return;
    Args a{};
    for (int i = 0; i < N_IN; ++i) a.in[i] = (const float*)d_in[i];
    a.out = (float*)d_out; a.ws = (unsigned char*)d_ws;
    if (MK_N_LAUNCHES == 1) { a.ph_lo = 0; a.ph_hi = NPHASE; a.li = 0; hipLaunchKernelGGL(hyb_fwd, dim3(grid), dim3(NTHREADS), LDS_BYTES, stream, a); }
    else for (int li = 0; li < NPHASE; ++li) { a.ph_lo = li; a.ph_hi = li + 1; a.li = 0; hipLaunchKernelGGL(hyb_fwd, dim3(grid), dim3(NTHREADS), LDS_BYTES, stream, a); }
}
```

```cpp
#include <hip/hip_runtime.h>
#include <cstdio>
#include <cstdint>
namespace pg8 {
#define PG8_LAS __attribute__((address_space(3)))
typedef unsigned short bf16_t;
typedef short bf16x8 __attribute__((ext_vector_type(8)));
typedef float f32x4 __attribute__((ext_vector_type(4)));
typedef unsigned u32x4 __attribute__((ext_vector_type(4)));
constexpr int BM = 256, BK = 64, HALF = 128, HTB = HALF * BK * 2  , STAGE_BYTES = 8 * HTB, NXCD = 8, WGM = 8;

__host__ __device__ __forceinline__ int lds_byte(int r, int c) { const int st = (r >> 4) * 2 + (c >> 5), rr = r & 15, cc = c & 31, ob = rr * 64 + cc * 2; return st * 1024 + (ob ^ (((ob >> 9) & 1) << 5)); }
__host__ __device__ __forceinline__ void stage_rc(int b, int& R, int& C) { const int st = b / 1024, sb = b % 1024, swz = sb ^ (((sb >> 9) & 1) << 5); R = (st >> 1) * 16 + swz / 64; C = (st & 1) * 32 + (swz % 64) / 2; }
__host__ __device__ __forceinline__ int perm32(int rho) { const int n = rho >> 4, i = rho & 15; return 8 * (i >> 2) + 4 * n + (i & 3); }

struct Unit { int pm, pn; };
struct Gemm { const bf16_t* A; const bf16_t* Bt; int M, N, K; };

struct StaticOrder {
    int nM, nN, nwg, G, c;
    __host__ __device__ void init(int M, int N, int G_, int c_) { nM = M / BM; nN = N / BM; nwg = nM * nN; G = G_; c = c_; }
    __host__ __device__ bool next(int i, Unit& u) const {
        const long L = (long)i * G + c; if (L >= nwg) return false;
        int wgid = (int)L; { const int q = nwg / NXCD, r = nwg % NXCD, xcd = wgid % NXCD, off = wgid / NXCD; wgid = (xcd < r ? xcd * (q + 1) : r * (q + 1) + (xcd - r) * q) + off; }
        const int nig = WGM * nN, gid = wgid / nig, fm = gid * WGM, gsz = (nM - fm) < WGM ? (nM - fm) : WGM;
        u.pm = fm + ((wgid % nig) % gsz); u.pn = (wgid % nig) / gsz; return true;
    }
    __device__ __forceinline__ void a_ready(const Unit&) const {}
    __device__ __forceinline__ void done(const Unit&) const {}
};

__device__ __forceinline__ unsigned cvt_pk_bf16(float lo, float hi) { unsigned r; asm volatile("v_cvt_pk_bf16_f32 %0, %1, %2" : "=v"(r) : "v"(lo), "v"(hi)); return r; }
typedef float f32x2 __attribute__((ext_vector_type(2)));
#define PG8_GAS __attribute__((address_space(1)))
typedef unsigned long long ssq_t;
__device__ __forceinline__ float ssq_to_rstd(ssq_t v) { return __builtin_amdgcn_rsqf((float)v * (1.0f / (16777216.0f * 1024.0f)) + 1e-6f); }
__device__ __forceinline__ ssq_t ssq_fix(float s) { return (ssq_t)(s * 16777216.0f + 0.5f); }
__device__ __forceinline__ float row_rstd(const PG8_GAS ssq_t* ssq, int row) { return ssq_to_rstd(ssq[row]); }
__device__ __forceinline__ float silu_f(float x) { return x * __builtin_amdgcn_rcpf(1.0f + __builtin_amdgcn_exp2f(-1.4426950408889634f * x)); }
struct EpiSwiglu {
    static constexpr bool PERM = true, AFTER_DRAIN = false;
    PG8_GAS bf16_t* H; int ldh; const PG8_GAS ssq_t* ssq;
    __device__ __forceinline__ void operator()(const f32x4 (&acc)[2][2][4][2], const Unit& u, int wr, int wc, int fr, int fq) const {
        const int row0 = u.pm * BM + wr * 64 + fr, col0 = u.pn * HALF + wc * 32 + 8 * fq; ssq_t rsv[2][4];
#pragma unroll
        for (int ai = 0; ai < 2; ++ai)
#pragma unroll
            for (int m = 0; m < 4; ++m) rsv[ai][m] = ssq[row0 + ai * HALF + m * 16];
#pragma unroll
        for (int ai = 0; ai < 2; ++ai)
#pragma unroll
            for (int m = 0; m < 4; ++m) { const int row = row0 + ai * HALF + m * 16; const float rs = ssq_to_rstd(rsv[ai][m]);
                const f32x4 g0 = acc[ai][0][m][0] * rs, g1 = acc[ai][0][m][1] * rs, u0 = acc[ai][1][m][0] * rs, u1 = acc[ai][1][m][1] * rs;
                u32x4 w; w.x = cvt_pk_bf16(silu_f(g0[0]) * u0[0], silu_f(g0[1]) * u0[1]); w.y = cvt_pk_bf16(silu_f(g0[2]) * u0[2], silu_f(g0[3]) * u0[3]);
                w.z = cvt_pk_bf16(silu_f(g1[0]) * u1[0], silu_f(g1[1]) * u1[1]); w.w = cvt_pk_bf16(silu_f(g1[2]) * u1[2], silu_f(g1[3]) * u1[3]);
                *(PG8_GAS u32x4*)(H + (size_t)row * ldh + col0) = w; }
    }
};
struct EpiProj {
    static constexpr bool PERM = true, AFTER_DRAIN = false;
    PG8_GAS bf16_t* OA; int ldA; int ntA; PG8_GAS bf16_t* OB; int ldB; int tpB; size_t strideB; const PG8_GAS ssq_t* ssq; PG8_GAS float* kmean; int kt0;
    __device__ __forceinline__ void operator()(const f32x4 (&acc)[2][2][4][2], const Unit& u, int wr, int wc, int fr, int fq) const {
        const int row0 = u.pm * BM + wr * 64 + fr; PG8_GAS bf16_t* base; int ld, colt; f32x4 cs[2][2]; const bool km = kmean != nullptr && (unsigned)(u.pn - kt0) < 2u;
#pragma unroll
        for (int bj = 0; bj < 2; ++bj) { cs[bj][0] = (f32x4){0.f, 0.f, 0.f, 0.f}; cs[bj][1] = cs[bj][0]; }
        if (u.pn < ntA) { base = OA; ld = ldA; colt = u.pn * BM; } else { const int q = u.pn - ntA, t = q / tpB; base = OB + (size_t)t * strideB; ld = ldB; colt = (q - t * tpB) * BM; }
        const int col0 = colt + wc * 32 + 8 * fq; ssq_t rsv[2][4];
#pragma unroll
        for (int ai = 0; ai < 2; ++ai)
#pragma unroll
            for (int m = 0; m < 4; ++m) rsv[ai][m] = ssq[row0 + ai * HALF + m * 16];
#pragma unroll
        for (int ai = 0; ai < 2; ++ai)
#pragma unroll
            for (int m = 0; m < 4; ++m) { const int row = row0 + ai * HALF + m * 16; const float rs = ssq_to_rstd(rsv[ai][m]); PG8_GAS bf16_t* rowp = base + (size_t)row * ld + col0;
#pragma unroll
                for (int bj = 0; bj < 2; ++bj) { const f32x4 v0 = acc[ai][bj][m][0] * rs, v1 = acc[ai][bj][m][1] * rs; cs[bj][0] += v0; cs[bj][1] += v1;
                    u32x4 w; w.x = cvt_pk_bf16(v0[0], v0[1]); w.y = cvt_pk_bf16(v0[2], v0[3]); w.z = cvt_pk_bf16(v1[0], v1[1]); w.w = cvt_pk_bf16(v1[2], v1[3]);
                    *(PG8_GAS u32x4*)(rowp + bj * HALF) = w; } }
        if (km) {
            const int ck0 = (u.pn - kt0) * BM + wc * 32 + 8 * fq; PG8_GAS float* kb = kmean + (size_t)((u.pm >> 3) * 8) * 8 * 64 + (size_t)(u.pm & 7) * 64;
#pragma unroll
            for (int bj = 0; bj < 2; ++bj)
#pragma unroll
                for (int n = 0; n < 2; ++n)
#pragma unroll
                    for (int e = 0; e < 4; ++e) { float v = cs[bj][n][e]; v += __shfl_xor(v, 1); v += __shfl_xor(v, 2); v += __shfl_xor(v, 4); v += __shfl_xor(v, 8);
                        if (fr == 0) { const int ck = ck0 + bj * HALF + 4 * n + e; __builtin_amdgcn_global_atomic_fadd_f32(kb + (size_t)(ck >> 6) * 8 * 64 + (ck & 63), v * (1.0f / 256.0f)); } } }
    }
};
struct EpiResid {
    static constexpr bool PERM = false, AFTER_DRAIN = false;
    PG8_GAS bf16_t* XB; PG8_GAS ssq_t* ssq; float alpha;
    __device__ __forceinline__ void operator()(const f32x4 (&acc)[2][2][4][2], const Unit& u, int wr, int wc, int fr, int fq) const {
        typedef unsigned u32x2v __attribute__((ext_vector_type(2)));
        const int row0 = u.pm * BM + wr * 64 + fr, col0 = u.pn * BM + wc * 32 + 4 * fq;
        u32x2v bcur[2][2], bnxt[2][2];
#pragma unroll
        for (int bj = 0; bj < 2; ++bj)
#pragma unroll
            for (int n = 0; n < 2; ++n) bcur[bj][n] = *(const PG8_GAS u32x2v*)(XB + (size_t)row0 * 1024 + col0 + bj * HALF + n * 16);
#pragma unroll
        for (int g = 0; g < 8; ++g) { const int ai = g >> 2, m = g & 3; const int row = row0 + ai * HALF + m * 16; const size_t off = (size_t)row * 1024 + col0; float ss = 0.f;
            if (g < 7) { const int rown = row0 + ((g + 1) >> 2) * HALF + ((g + 1) & 3) * 16;
#pragma unroll
                for (int bj = 0; bj < 2; ++bj)
#pragma unroll
                    for (int n = 0; n < 2; ++n) bnxt[bj][n] = *(const PG8_GAS u32x2v*)(XB + (size_t)rown * 1024 + col0 + bj * HALF + n * 16); }
#pragma unroll
            for (int bj = 0; bj < 2; ++bj)
#pragma unroll
                for (int n = 0; n < 2; ++n) { const u32x2v bw = bcur[bj][n];
                    const f32x4 b = (f32x4){__builtin_bit_cast(float, bw.x << 16), __builtin_bit_cast(float, bw.x & 0xffff0000u), __builtin_bit_cast(float, bw.y << 16), __builtin_bit_cast(float, bw.y & 0xffff0000u)};
                    const f32x4 o = b + acc[ai][bj][m][n] * alpha; u32x2v w; w.x = cvt_pk_bf16(o[0], o[1]); w.y = cvt_pk_bf16(o[2], o[3]); *(PG8_GAS u32x2v*)(XB + off + bj * HALF + n * 16) = w;
                    const float r0 = __builtin_bit_cast(float, w.x << 16), r1 = __builtin_bit_cast(float, w.x & 0xffff0000u), r2 = __builtin_bit_cast(float, w.y << 16), r3 = __builtin_bit_cast(float, w.y & 0xffff0000u);
                    ss += (r0 * r0 + r1 * r1) + (r2 * r2 + r3 * r3); }
            ss += __shfl_xor(ss, 16); ss += __shfl_xor(ss, 32);
            if (fq == 0 && alpha != 0.f) __hip_atomic_fetch_add(ssq + row, ssq_fix(ss), __ATOMIC_RELAXED, __HIP_MEMORY_SCOPE_AGENT);
#pragma unroll
            for (int bj = 0; bj < 2; ++bj)
#pragma unroll
                for (int n = 0; n < 2; ++n) bcur[bj][n] = bnxt[bj][n];
            asm volatile("" ::: "memory"); }
    }
};

template <class Epi, class Sched, bool ALIGN_EPI = false, bool SP2 = false>
__device__ __forceinline__ void gemm_phase(PG8_LAS unsigned char* lds, const Gemm g, const Sched& S, const Epi& E) {
    int tid_l = threadIdx.x; asm volatile("" : "+v"(tid_l));
    const int tid = tid_l, wid = __builtin_amdgcn_readfirstlane(tid >> 6), lane = tid & 63, wr = wid >> 2, wc = wid & 3, fr = lane & 15, fq = lane >> 4;
    const int K = g.K, nt = K / BK;
    unsigned voffA[2], voffB[2];
#pragma unroll
    for (int i = 0; i < 2; ++i) { int R, C; stage_rc(tid * 16 + i * 8192, R, C); const int Rb = Epi::PERM ? ((R & ~31) + perm32(R & 31)) : R;
        voffA[i] = (unsigned)(R * K + C) * 2u; voffB[i] = (unsigned)(Rb * K + C) * 2u; }
    const size_t kstep = (size_t)(BK * 2);
    const size_t hstep = (size_t)HALF * K * 2;
    const size_t tstep = 2 * hstep;
    const unsigned ldsw = (unsigned)wid * 1024u;
    const int aoff = lds_byte(wr * 64 + fr, fq * 8), boff = lds_byte(wc * 32 + fr, fq * 8);
#define PG8_SA(b, h) (((b) * 2 + (h)) * HTB)
#define PG8_SB(b, h) ((4 + (b) * 2 + (h)) * HTB)
#define PG8_STAGE(bufoff, gbase, voff) do { _Pragma("unroll") for (int _i = 0; _i < 2; ++_i) \
        __builtin_amdgcn_global_load_lds((const unsigned*)((const char*)(gbase) + (voff)[_i]), (PG8_LAS unsigned*)(lds + (bufoff) + ldsw + _i * 8192), 16, 0, 0); } while (0)
#define PG8_LDA(dst, b, h) do { _Pragma("unroll") for (int m = 0; m < 4; ++m) _Pragma("unroll") for (int k = 0; k < 2; ++k) dst[m][k] = *(const PG8_LAS bf16x8*)(lds + PG8_SA(b, h) + aoff + m * 2048 + k * 1024); } while (0)
#define PG8_LDB(dst, b, h) do { _Pragma("unroll") for (int n = 0; n < 2; ++n) _Pragma("unroll") for (int k = 0; k < 2; ++k) dst[n][k] = *(const PG8_LAS bf16x8*)(lds + PG8_SB(b, h) + boff + n * 2048 + k * 1024); } while (0)
#define PG8_MMA(ai, bj, At, Bt) do { __builtin_amdgcn_s_setprio(1); _Pragma("unroll") for (int m = 0; m < 4; ++m) _Pragma("unroll") for (int n = 0; n < 2; ++n) _Pragma("unroll") for (int k = 0; k < 2; ++k) \
        acc[ai][bj][m][n] = __builtin_amdgcn_mfma_f32_16x16x32_bf16(Bt[n][k], At[m][k], acc[ai][bj][m][n], 0, 0, 0); __builtin_amdgcn_s_setprio(0); } while (0)
#define PG8_WAIT_V(n) asm volatile("s_waitcnt vmcnt(" #n ")" ::: "memory")
#define PG8_WAIT_L(n) asm volatile("s_waitcnt lgkmcnt(" #n ")" ::: "memory")
#define PG8_BAR __builtin_amdgcn_s_barrier()
#define PG8_SCHED __builtin_amdgcn_sched_barrier(0)
    Unit cur, nxt; int ui = 0;
    if (!S.next(0, cur)) return;
    f32x4 acc[2][2][4][2];
#pragma unroll
    for (int a = 0; a < 2; ++a)
#pragma unroll
        for (int b = 0; b < 2; ++b)
#pragma unroll
            for (int m = 0; m < 4; ++m)
#pragma unroll
                for (int n = 0; n < 2; ++n) acc[a][b][m][n] = (f32x4){0.f, 0.f, 0.f, 0.f};
    bf16x8 At[4][2], B0[2][2], B1[2][2];
    const char* cA = (const char*)g.A + (size_t)cur.pm * tstep; const char* cB = (const char*)g.Bt + (size_t)cur.pn * tstep;
    S.a_ready(cur);
    if constexpr (SP2) {
        PG8_STAGE(PG8_SB(0, 0), cB, voffB); PG8_STAGE(PG8_SB(0, 1), cB + hstep, voffB); PG8_STAGE(PG8_SA(0, 0), cA, voffA); PG8_STAGE(PG8_SA(0, 1), cA + hstep, voffA);
        if (wr == 1) PG8_BAR;
        PG8_WAIT_V(2); PG8_BAR;
        PG8_STAGE(PG8_SB(1, 0), cB + kstep, voffB); PG8_STAGE(PG8_SA(1, 0), cA + kstep, voffA); PG8_STAGE(PG8_SB(1, 1), cB + hstep + kstep, voffB);
        PG8_WAIT_V(6); PG8_BAR;
    } else {
        PG8_STAGE(PG8_SB(0, 0), cB, voffB); PG8_STAGE(PG8_SA(0, 0), cA, voffA); PG8_STAGE(PG8_SB(0, 1), cB + hstep, voffB); PG8_STAGE(PG8_SA(0, 1), cA + hstep, voffA);
        if (wr == 1) PG8_BAR;
        PG8_WAIT_V(4); PG8_BAR;
        PG8_STAGE(PG8_SB(1, 0), cB + kstep, voffB); PG8_STAGE(PG8_SA(1, 0), cA + kstep, voffA); PG8_STAGE(PG8_SB(1, 1), cB + hstep + kstep, voffB);
        PG8_WAIT_V(6); PG8_BAR;
    }
    for (;;) {
        const bool has_next = S.next(ui + 1, nxt);
        const char* nA = has_next ? (const char*)g.A + (size_t)nxt.pm * tstep : cA; const char* nB = has_next ? (const char*)g.Bt + (size_t)nxt.pn * tstep : cB;
        for (int t = 0; t < nt; t += 2) {
            const bool last = (t == nt - 2);
            const char* a1 = cA + (size_t)(t + 1) * kstep;
            const char* a2 = last ? nA : cA + (size_t)(t + 2) * kstep; const char* b2 = last ? nB : cB + (size_t)(t + 2) * kstep;
            const char* a3 = a2 + kstep; const char* b3 = b2 + kstep;
            if (last && has_next) S.a_ready(nxt);
            if constexpr (SP2) {
            PG8_LDB(B0, 0, 0); PG8_LDB(B1, 0, 1); PG8_SCHED; PG8_LDA(At, 0, 0); PG8_STAGE(PG8_SA(1, 1), a1 + hstep, voffA);
            PG8_WAIT_V(8); PG8_WAIT_L(0); PG8_BAR; PG8_MMA(0, 0, At, B0); PG8_MMA(0, 1, At, B1); PG8_BAR; PG8_SCHED;
            PG8_LDA(At, 0, 1); PG8_STAGE(PG8_SB(0, 0), b2, voffB); PG8_STAGE(PG8_SB(0, 1), b2 + hstep, voffB); PG8_STAGE(PG8_SA(0, 0), a2, voffA);
            PG8_WAIT_V(8); PG8_WAIT_L(0); PG8_BAR; PG8_MMA(1, 0, At, B0); PG8_MMA(1, 1, At, B1); PG8_BAR; PG8_SCHED;
            PG8_LDB(B0, 1, 0); PG8_LDB(B1, 1, 1); PG8_SCHED; PG8_LDA(At, 1, 0); PG8_STAGE(PG8_SA(0, 1), a2 + hstep, voffA);
            PG8_WAIT_V(8); PG8_WAIT_L(0); PG8_BAR; PG8_MMA(0, 0, At, B0); PG8_MMA(0, 1, At, B1); PG8_BAR; PG8_SCHED;
            PG8_LDA(At, 1, 1); PG8_STAGE(PG8_SB(1, 0), b3, voffB); PG8_STAGE(PG8_SB(1, 1), b3 + hstep, voffB); PG8_STAGE(PG8_SA(1, 0), a3, voffA);
            PG8_WAIT_V(8); PG8_WAIT_L(0); PG8_BAR; PG8_MMA(1, 0, At, B0); PG8_MMA(1, 1, At, B1); PG8_BAR; PG8_SCHED;
            } else {
            PG8_LDB(B0, 0, 0); PG8_SCHED; PG8_LDA(At, 0, 0); PG8_STAGE(PG8_SA(1, 1), a1 + hstep, voffA);
            PG8_WAIT_L(8); PG8_BAR; PG8_WAIT_L(0); PG8_MMA(0, 0, At, B0); PG8_BAR; PG8_SCHED;
            PG8_LDB(B1, 0, 1); PG8_STAGE(PG8_SB(0, 0), b2, voffB);
            PG8_BAR; PG8_WAIT_L(0); PG8_MMA(0, 1, At, B1); PG8_BAR;
            PG8_LDA(At, 0, 1); PG8_STAGE(PG8_SA(0, 0), a2, voffA);
            PG8_BAR; PG8_WAIT_L(0); PG8_MMA(1, 0, At, B0); PG8_BAR; PG8_SCHED;
            PG8_STAGE(PG8_SB(0, 1), b2 + hstep, voffB);
            PG8_WAIT_V(6); PG8_BAR; PG8_MMA(1, 1, At, B1); PG8_BAR;
            PG8_LDB(B0, 1, 0); PG8_SCHED; PG8_LDA(At, 1, 0); PG8_STAGE(PG8_SA(0, 1), a2 + hstep, voffA);
            PG8_WAIT_L(8); PG8_BAR; PG8_WAIT_L(0); PG8_MMA(0, 0, At, B0); PG8_BAR; PG8_SCHED;
            PG8_LDB(B1, 1, 1); PG8_STAGE(PG8_SB(1, 0), b3, voffB);
            PG8_BAR; PG8_WAIT_L(0); PG8_MMA(0, 1, At, B1); PG8_BAR;
            PG8_LDA(At, 1, 1); PG8_STAGE(PG8_SA(1, 0), a3, voffA);
            PG8_BAR; PG8_WAIT_L(0); PG8_MMA(1, 0, At, B0); PG8_BAR; PG8_SCHED;
            PG8_STAGE(PG8_SB(1, 1), b3 + hstep, voffB);
            PG8_WAIT_V(6); PG8_BAR; PG8_MMA(1, 1, At, B1); PG8_BAR;
            }
        }
        if constexpr (ALIGN_EPI) { if (wr == 0) PG8_BAR; }
        if constexpr (!Epi::AFTER_DRAIN) { E(acc, cur, wr, wc, fr, fq); S.done(cur); }
        if (!has_next) break;
#pragma unroll
        for (int a = 0; a < 2; ++a)
#pragma unroll
            for (int b = 0; b < 2; ++b)
#pragma unroll
                for (int m = 0; m < 4; ++m)
#pragma unroll
                    for (int n = 0; n < 2; ++n) acc[a][b][m][n] = (f32x4){0.f, 0.f, 0.f, 0.f};
        cur = nxt; cA = nA; cB = nB; ++ui;
        if constexpr (ALIGN_EPI) { if (wr == 1) PG8_BAR; }
    }
    PG8_WAIT_V(0);
    if constexpr (!ALIGN_EPI) { if (wr == 0) PG8_BAR; }
    PG8_BAR;
    if constexpr (Epi::AFTER_DRAIN) { E.fused(acc, cur, wr, wc, fr, fq, lds, wid, lane); S.done(cur); }
#undef PG8_SA
#undef PG8_SB
#undef PG8_STAGE
#undef PG8_LDA
#undef PG8_LDB
#undef PG8_MMA
#undef PG8_WAIT_V
#undef PG8_WAIT_L
#undef PG8_BAR
#undef PG8_SCHED
}
}

#define GAS __attribute__((address_space(1)))
#define LAS __attribute__((address_space(3)))
typedef unsigned short bf16;
typedef unsigned v4u __attribute__((ext_vector_type(4)));
typedef float f32x4 __attribute__((ext_vector_type(4)));
typedef short bf16x8 __attribute__((ext_vector_type(8)));
typedef GAS unsigned gu32;
typedef GAS unsigned long long gu64;
#define RLX_AGENT __ATOMIC_RELAXED, __HIP_MEMORY_SCOPE_AGENT
#define LDS_WAIT() asm volatile("s_waitcnt lgkmcnt(0)" ::: "memory")
#define VM_WAIT() asm volatile("s_waitcnt vmcnt(0)" ::: "memory")
__device__ __forceinline__ unsigned long long rt() { return __builtin_amdgcn_s_memrealtime(); }
typedef float f32x2_t __attribute__((ext_vector_type(2))); typedef __bf16 bf16x2_t __attribute__((ext_vector_type(2)));
__device__ __forceinline__ unsigned pk2(float lo, float hi) { const f32x2_t v = {lo, hi}; return __builtin_bit_cast(unsigned, __builtin_convertvector(v, bf16x2_t)); }
__device__ __forceinline__ unsigned f2bf(float f) { return pk2(f, f) & 0xffffu; }
#define XB_TMO      128
#define XB_XCNT(j)  (256  + 64 * (j))
#define XB_XSUB(j)  (1280 + 64 * (j))
#define XB_XGEN(j)  (2304 + 64 * (j))
#define XB_TOP      3328
#define XB_TOPGEN   3392
#define XCD_BAR_WORDS 3456
#define XB_SPIN_CAP (1u << 18)

__device__ __forceinline__ unsigned xb_ld(unsigned* p)              { return __hip_atomic_load(p, __ATOMIC_RELAXED, __HIP_MEMORY_SCOPE_AGENT); }
__device__ __forceinline__ unsigned xb_add(unsigned* p, unsigned v) { return __hip_atomic_fetch_add(p, v, __ATOMIC_RELAXED, __HIP_MEMORY_SCOPE_AGENT); }
__device__ __forceinline__ unsigned xb_xcc_id() { return (unsigned)__builtin_amdgcn_s_getreg((3 << 11) | 20) & 0xFu; }
#define XB_SPIN(cond, bar) do { unsigned _sp = 0; while (cond) { __builtin_amdgcn_s_sleep(1); \
    if ((++_sp & 255u) == 0u) { if (xb_ld(&(bar)[XB_TMO])) break; if (_sp > XB_SPIN_CAP) { atomicAdd(&(bar)[XB_TMO], 1u); break; } } } } while (0)

struct XcdBarrier {
    unsigned* bar; unsigned x;
    volatile LAS unsigned* st;
};

__device__ __forceinline__ XcdBarrier xcd_barrier_post(unsigned* bar, volatile LAS unsigned* st) {
    XcdBarrier b; b.bar = bar; b.x = xb_xcc_id(); b.st = st;
    if (threadIdx.x == 0) (void)xb_add(&bar[XB_XCNT(b.x)], 1u);
    return b;
}
__device__ __forceinline__ void xcd_barrier_complete(unsigned* bar, unsigned x, unsigned& nloc, unsigned& nx) {
    const unsigned G = gridDim.x * gridDim.y * gridDim.z;
    unsigned sum, cnt, mine, sp = 0u;
    for (;;) {
        sum = 0u; cnt = 0u; mine = 0u;
#pragma unroll 1
        for (unsigned j = 0; j < 16; ++j) { const unsigned c = xb_ld(&bar[XB_XCNT(j)]); sum += c; cnt += (c > 0u) ? 1u : 0u; mine = (j == x) ? c : mine; }
        if (sum == G) break;
        __builtin_amdgcn_s_sleep(1);
        if ((++sp & 255u) == 0u) { if (xb_ld(&bar[XB_TMO])) break; if (sp > XB_SPIN_CAP) { atomicAdd(&bar[XB_TMO], 1u); break; } }
    }
    nloc = mine > 0u ? mine : 1u; nx = cnt > 0u ? cnt : 1u;
}

__device__ __forceinline__ void xcd_barrier(const XcdBarrier& b) {
    asm volatile("s_waitcnt vmcnt(0)" ::: "memory");
    __syncthreads();
    if (threadIdx.x == 0) {
        unsigned* bar = b.bar;
        __builtin_amdgcn_s_waitcnt(0);
        unsigned nloc = b.st[0], nx = b.st[1];
        if (nloc == 0u) { xcd_barrier_complete(bar, b.x, nloc, nx); b.st[0] = nloc; b.st[1] = nx; }
        const unsigned old = xb_add(&bar[XB_XSUB(b.x)], 1u);
        const unsigned gen = old / nloc;
        if (old + 1u == (gen + 1u) * nloc) {
            __builtin_amdgcn_fence(__ATOMIC_RELEASE, "agent");
            asm volatile("s_waitcnt vmcnt(0)" ::: "memory");
            const unsigned og = xb_add(&bar[XB_TOP], 1u);
            const unsigned tg = og / nx;
            if (og + 1u == (tg + 1u) * nx) xb_add(&bar[XB_TOPGEN], 1u);
            else XB_SPIN(xb_ld(&bar[XB_TOPGEN]) == tg, bar);
            __builtin_amdgcn_fence(__ATOMIC_ACQUIRE, "agent");
            xb_add(&bar[XB_XGEN(b.x)], 1u);
            asm volatile("s_waitcnt vmcnt(0)" ::: "memory");
        } else {
            XB_SPIN(xb_ld(&bar[XB_XGEN(b.x)]) == gen, bar);
            __builtin_amdgcn_fence(__ATOMIC_ACQUIRE, "agent");
            asm volatile("s_waitcnt vmcnt(0)" ::: "memory");
        }
    }
    __syncthreads();
}
constexpr int BATCH = 8, SEQ = 2048, D = 1024, M = BATCH * SEQ, FF = 2816;
constexpr int RW_COLS = 1792, EV_IN = 3328, OD_IN = 4096;
constexpr int NWAVES = 8, NTHREADS = NWAVES * 64;
constexpr int N_IN = 26;
constexpr size_t MiB = 1u << 20;
constexpr size_t WS_CTL = 0, CTL_ZERO_BYTES = 3 * MiB;
constexpr size_t OS_HSS = 32 * MiB;
constexpr size_t OS_WC = 56 * MiB;
constexpr size_t OS_IKH = 0, OS_IRH = 40 * MiB, WS_IAH = 36 * MiB, WS_IKT_LO = 3 * MiB, WS_IKT_HI = 48 * MiB;
constexpr size_t OS_RN = 36 * MiB;
constexpr size_t OS_RST = 33 * MiB, OS_ZERO_BEGIN = 32 * MiB, OS_ZERO_BYTES = 3 * MiB;
constexpr size_t WS_SSQ = 2 * MiB;
#define SSQ_SLOT(k) WSP(pg8::ssq_t, WS_SSQ + (size_t)(k) * M * 8)
constexpr size_t WS_W = 3 * MiB;
constexpr size_t W_UP_BYTES = (size_t)2 * FF * D * 2, W_DN_BYTES = (size_t)D * FF * 2;
constexpr size_t WS_WUP = WS_W, WS_WDN = WS_WUP + 4 * W_UP_BYTES, WS_WEVIN = WS_WDN + 4 * W_DN_BYTES, WS_WEVOUT = WS_WEVIN + (size_t)EV_IN * D * 2,
                 WS_WODIN = WS_WEVOUT + (size_t)D * D * 2, WS_WODOUT = WS_WODIN + (size_t)OD_IN * D * 2, WS_WEND = WS_WODOUT + (size_t)D * D * 2;
constexpr size_t WS_KMEAN = 128 * 1024;
constexpr size_t WS_LW2 = 88 * MiB - 512 * 1024, WS_LA2 = WS_LW2 + 64 * 1024, WS_LG2 = WS_LA2 + 64 * 1024;
constexpr size_t WS_XB = 88 * MiB;
constexpr size_t WS_H = 120 * MiB;
constexpr size_t WS_PR = 120 * MiB, WS_QB = 176 * MiB, WS_KB = 192 * MiB, WS_VB = 208 * MiB, WS_Y = 224 * MiB;
constexpr size_t OS_RE = 0, OS_RA = 16 * MiB, WS_YRAW = WS_QB;
constexpr size_t WS_GM = WS_KB;
constexpr size_t WS_HQ = 120 * MiB, WS_HF = 152 * MiB, WS_HI = 184 * MiB, WS_HG = 216 * MiB;
constexpr size_t OS_KT2 = 0;
constexpr size_t WS_RB = 248 * MiB;
constexpr size_t WS_DRY = 250 * MiB;
constexpr size_t WS_END = 256 * MiB;
static_assert(WS_WEND <= WS_LW2 && WS_LG2 + 128 * 1024 <= WS_XB && WS_H + (size_t)M * FF * 2 <= WS_Y + 0 * MiB + 32 * MiB && WS_PR + (size_t)M * RW_COLS * 2 <= WS_QB && WS_Y + (size_t)M * D * 2 <= WS_END && WS_HG + (size_t)M * D * 2 <= WS_END, "d_ws map");
constexpr int CW_BAR = 4096;
constexpr int RING_BYTES = 131072, LDSCTL_OFF = RING_BYTES, MISC_OFF = LDSCTL_OFF + 320, LDS_BYTES = 147456;

__device__ __forceinline__ float bf2f(bf16 v) { return __builtin_bit_cast(float, (unsigned)v << 16); }
__device__ __forceinline__ float sigm(float x) { return 1.0f / (1.0f + __expf(-x)); }
__device__ __forceinline__ float sigmf(float x) { return __builtin_amdgcn_rcpf(1.0f + __builtin_amdgcn_exp2f(-1.4426950408889634f * x)); }
__device__ __forceinline__ float wave_sum(float v) {
#pragma unroll
    for (int o = 1; o < 64; o <<= 1) v += __shfl_xor(v, o);
    return v;
}
__device__ __forceinline__ float wave_max(float v) {
#pragma unroll
    for (int o = 1; o < 64; o <<= 1) v = fmaxf(v, __shfl_xor(v, o));
    return v;
}

typedef float f32x4v __attribute__((ext_vector_type(4)));
typedef float f32x16 __attribute__((ext_vector_type(16)));
typedef unsigned v2u __attribute__((ext_vector_type(2)));
typedef float v2f __attribute__((ext_vector_type(2)));
#define LDS_BARRIER() do { asm volatile("s_waitcnt lgkmcnt(0)" ::: "memory"); __builtin_amdgcn_s_barrier(); asm volatile("" ::: "memory"); } while (0)
__device__ __forceinline__ long long fx20(float v) { return (long long)llrintf(v * 1073741824.0f); }
__device__ __forceinline__ float unfx20(long long v) { return (float)v * (1.0f / 1073741824.0f); }
struct Frame {
    LAS unsigned char* lds; volatile LAS unsigned* MISC; gu32* ctl;
    int tid, lane, wave, vcu, G;
    GAS float* out; GAS unsigned char* ws;
};
#define WSP(T, off) ((GAS T*)(F.ws + (off)))
#define OSP(T, off) ((GAS T*)((GAS unsigned char*)F.out + (off)))
constexpr int PTAB_OFF = LDSCTL_OFF + 1024;
__device__ __forceinline__ const GAS float* inp(const Frame& F, int i) {
    const unsigned long long v = ((const LAS unsigned long long*)(F.lds + PTAB_OFF))[i];
    const unsigned lo = __builtin_amdgcn_readfirstlane((unsigned)v), hi = __builtin_amdgcn_readfirstlane((unsigned)(v >> 32));
    return (const GAS float*)(((unsigned long long)hi << 32) | lo);
}
__device__ __forceinline__ bool in_range(int k, int lo, int hi) { asm volatile("" : "+s"(lo), "+s"(hi)); return lo <= k && k < hi; }
#define PHASE_FRAME(FP) Frame FP = F0; asm volatile("" : "+v"(FP.tid), "+v"(FP.lane)); asm volatile("" : "+s"(FP.wave), "+s"(FP.vcu), "+s"(FP.G), "+s"(FP.ws), "+s"(FP.out))
struct Args { const float* in[N_IN]; float* out; unsigned char* ws; int ph_lo, ph_hi, li, pad; };

__device__ __forceinline__ void transpose_item(const GAS float* W, int K, int N, const GAS float* gain, GAS bf16* WT, int mode, LAS float* scr, int item, int lane) {
    const int nblk = N / 32, kb = item / nblk, nb = item % nblk, k0 = 64 * kb, n0 = 32 * nb;
    float wv[32];
#pragma unroll
    for (int i = 0; i < 32; ++i) wv[i] = W[(size_t)(k0 + 2 * i + (lane >> 5)) * N + n0 + (lane & 31)];
    if (gain) { const float g0 = gain[k0 + lane];
#pragma unroll
        for (int i = 0; i < 32; ++i) wv[i] *= __shfl(g0, 2 * i + (lane >> 5)); }
#pragma unroll
    for (int i = 0; i < 32; ++i) scr[(2 * i + (lane >> 5)) * 33 + (lane & 31)] = wv[i];
    LDS_WAIT(); asm volatile("" ::: "memory");
    const int c = lane & 7; const int rbase = (mode == 0) ? n0 : (n0 + 128 * (n0 >> 7) + (mode == 2 ? 128 : 0));
#pragma unroll
    for (int j = 0; j < 4; ++j) { const int n = (lane >> 3) + 8 * j; const LAS float* s = scr + (8 * c) * 33 + n;
        v4u o; o.x = pk2(s[0 * 33], s[1 * 33]); o.y = pk2(s[2 * 33], s[3 * 33]); o.z = pk2(s[4 * 33], s[5 * 33]); o.w = pk2(s[6 * 33], s[7 * 33]);
        *(GAS v4u*)(WT + (size_t)(rbase + n) * K + k0 + 8 * c) = o; }
    LDS_WAIT(); asm volatile("" ::: "memory");
}
constexpr int I_FF = (D / 64) * (FF / 32), I_EVIN = (D / 64) * (EV_IN / 32), I_OUT = (D / 64) * (D / 32), I_ODIN = (D / 64) * (OD_IN / 32);
constexpr int CV_G1 = 2 * I_FF, CV_G2 = CV_G1 + I_FF + I_EVIN + I_OUT, CV_G3 = CV_G2 + 4 * I_FF, CV_G4 = CV_G3 + 2 * I_FF + I_OUT + I_ODIN / 2, CV_G5 = CV_G4 + I_ODIN / 2 + 2 * I_FF, CV_END = CV_G5 + I_FF;
static_assert(CV_END == 12 * I_FF + I_EVIN + 2 * I_OUT + I_ODIN, "conversion item count");
__device__ __forceinline__ void convert_ffn(Frame& F, int f, int which  , int item, LAS float* scr) {
    const int l = f >> 1, second = f & 1; const GAS float* gain = inp(F, 1) + (size_t)(l * 3 + (second ? 2 : 0)) * D;
    if (which == 0) transpose_item((second ? inp(F, 5) : inp(F, 2)) + (size_t)l * D * FF, D, FF, gain, WSP(bf16, WS_WUP + f * W_UP_BYTES), 1, scr, item, F.lane);
    else if (which == 1) transpose_item((second ? inp(F, 6) : inp(F, 3)) + (size_t)l * D * FF, D, FF, gain, WSP(bf16, WS_WUP + f * W_UP_BYTES), 2, scr, item, F.lane);
    else transpose_item((second ? inp(F, 7) : inp(F, 4)) + (size_t)l * FF * D, FF, D, nullptr, WSP(bf16, WS_WDN + f * W_DN_BYTES), 0, scr, item, F.lane);
}
__device__ __forceinline__ void convert_items(Frame& F, int first, int last, int rank, int nranks) {
    LAS float* scr = (LAS float*)(F.lds + F.wave * 16384);
    for (int it = first + rank; it < last; it += nranks) {
        int r = it;
        if (r < CV_G1) { convert_ffn(F, 0, r / I_FF, r % I_FF, scr); continue; } r -= CV_G1;
        if (r < I_FF) { convert_ffn(F, 0, 2, r, scr); continue; } r -= I_FF;
        if (r < I_EVIN) { transpose_item(inp(F, 8), D, EV_IN, inp(F, 1) + 1 * D, WSP(bf16, WS_WEVIN), 0, scr, r, F.lane); continue; } r -= I_EVIN;
        if (r < I_OUT) { transpose_item(inp(F, 9), D, D, nullptr, WSP(bf16, WS_WEVOUT), 0, scr, r, F.lane); continue; } r -= I_OUT;
        if (r < 3 * I_FF) { convert_ffn(F, 1, r / I_FF, r % I_FF, scr); continue; } r -= 3 * I_FF;
        if (r < 2 * I_FF) { convert_ffn(F, 2, r / I_FF, r % I_FF, scr); continue; } r -= 2 * I_FF;
        if (r < I_FF) { convert_ffn(F, 2, 2, r, scr); continue; } r -= I_FF;
        if (r < I_OUT) { transpose_item(inp(F, 22), D, D, nullptr, WSP(bf16, WS_WODOUT), 0, scr, r, F.lane); continue; } r -= I_OUT;
        if (r < I_ODIN) { transpose_item(inp(F, 21), D, OD_IN, inp(F, 1) + 4 * D, WSP(bf16, WS_WODIN), 0, scr, r, F.lane); continue; } r -= I_ODIN;
        convert_ffn(F, 3, r / I_FF, r % I_FF, scr);
    }
}
__device__ __forceinline__ void prologue_phase(Frame& F) {
    const int gw = F.vcu * NWAVES + F.wave, NGW = F.G * NWAVES;
    convert_items(F, 0, CV_G1, gw, NGW);
    {
        const GAS float* w2 = inp(F, 12); const GAS float* a2 = inp(F, 14); const GAS float* g2 = inp(F, 15); GAS bf16* lw = WSP(bf16, WS_LW2); GAS bf16* la = WSP(bf16, WS_LA2); GAS bf16* lg = WSP(bf16, WS_LG2);
        for (int i = gw * 64 + F.lane; i < 512 * 64; i += NGW * 64) { const int n = i >> 6, k = i & 63; lw[i] = (bf16)f2bf(w2[k * 512 + n]); la[i] = (bf16)f2bf(a2[k * 512 + n]); }
        for (int i = gw * 64 + F.lane; i < 512 * 128; i += NGW * 64) { const int n = i >> 7, k = i & 127; lg[i] = (bf16)f2bf(g2[k * 512 + n]); } }
    const GAS float* x = inp(F, 0); GAS bf16* XB = WSP(bf16, WS_XB); GAS pg8::ssq_t* ssq = SSQ_SLOT(0);
    for (int m = gw; m < M; m += NGW) {
        const GAS f32x4* xr = (const GAS f32x4*)(x + (size_t)m * D) + F.lane; f32x4 v[4]; float s = 0.f;
#pragma unroll
        for (int j = 0; j < 4; ++j) { v[j] = xr[64 * j]; s += (v[j].x * v[j].x + v[j].y * v[j].y) + (v[j].z * v[j].z + v[j].w * v[j].w); }
        s = wave_sum(s);
        GAS unsigned long long* o8 = (GAS unsigned long long*)(XB + (size_t)m * D) + F.lane;
#pragma unroll
        for (int j = 0; j < 4; ++j) o8[64 * j] = (unsigned long long)pk2(v[j].x, v[j].y) | ((unsigned long long)pk2(v[j].z, v[j].w) << 32);
        if (F.lane == 0) ssq[m] = pg8::ssq_fix(s);
    }
}

__device__ __forceinline__ float dpp_add16(float v) {
    v += __builtin_bit_cast(float, __builtin_amdgcn_mov_dpp(__builtin_bit_cast(int, v), 0xB1, 0xF, 0xF, true));
    v += __builtin_bit_cast(float, __builtin_amdgcn_mov_dpp(__builtin_bit_cast(int, v), 0x4E, 0xF, 0xF, true));
    v += __builtin_bit_cast(float, __builtin_amdgcn_mov_dpp(__builtin_bit_cast(int, v), 0x141, 0xF, 0xF, true));
    v += __builtin_bit_cast(float, __builtin_amdgcn_mov_dpp(__builtin_bit_cast(int, v), 0x140, 0xF, 0xF, true));
    return v;
}
__device__ __forceinline__ float bflo(unsigned w) { return __builtin_bit_cast(float, w << 16); }
__device__ __forceinline__ float bfhi(unsigned w) { return __builtin_bit_cast(float, w & 0xffff0000u); }
__device__ __forceinline__ float bfel(const v4u v, int e) { const unsigned w = (e >> 1) == 0 ? v.x : (e >> 1) == 1 ? v.y : (e >> 1) == 2 ? v.z : v.w; return (e & 1) ? bfhi(w) : bflo(w); }
__device__ __forceinline__ void unpack8(const v4u v, float (&o)[8]) { o[0] = bflo(v.x); o[1] = bfhi(v.x); o[2] = bflo(v.y); o[3] = bfhi(v.y); o[4] = bflo(v.z); o[5] = bfhi(v.z); o[6] = bflo(v.w); o[7] = bfhi(v.w); }
constexpr int LO_PITCH = 528;
template <int MODE = 0> __device__ __forceinline__ void rwkv_lora_unit(Frame& F, int u) {
    const int tid = F.tid, lane = F.lane, w = F.wave, r16 = lane & 15, g4 = lane >> 4; LAS unsigned char* L = F.lds;
    const GAS bf16* PR = WSP(bf16, WS_PR); GAS bf16* RE = OSP(bf16, OS_RE); GAS bf16* RA = OSP(bf16, OS_RA); GAS bf16* Y = WSP(bf16, WS_Y);
    const GAS bf16* LW = WSP(bf16, WS_LW2); const GAS bf16* LA = WSP(bf16, WS_LA2); const GAS bf16* LG = WSP(bf16, WS_LG2);
    const GAS float* mu = inp(F, 10); const GAS float* w0 = inp(F, 11); const GAS float* a0 = inp(F, 13);
    const int m0 = u * 64;
    const int t = tid >> 3; const size_t row = (size_t)m0 + t; const bool hp = ((m0 + t) & (SEQ - 1)) != 0; const size_t rowp = hp ? row - 1 : row;
    __syncthreads();
    {
        const int c0 = (tid & 7) * 32; v4u cur[4], prv[4]; f32x4v mv[8];
#pragma unroll
        for (int q = 0; q < 4; ++q) { cur[q] = *(const GAS v4u*)(PR + row * RW_COLS + 1536 + c0 + 8 * q); prv[q] = *(const GAS v4u*)(PR + rowp * RW_COLS + 1536 + c0 + 8 * q); }
#pragma unroll
        for (int q = 0; q < 8; ++q) mv[q] = *(const GAS f32x4v*)(mu + 1536 + c0 + 4 * q);
        const bool isT = c0 < 64, isI = (c0 >= 64) && (c0 < 128); const float ka = isT ? 2.8853900817779268f : -1.4426950408889634f, aa = isT ? 1.0f : 0.f, bb = isT ? -2.0f : 1.0f;
#pragma unroll
        for (int q = 0; q < 4; ++q) { const int c = c0 + 8 * q; float cf[8], pf[8]; unpack8(cur[q], cf); unpack8(hp ? prv[q] : v4u{0u, 0u, 0u, 0u}, pf); float o[8];
#pragma unroll
            for (int e = 0; e < 8; ++e) { const float v = cf[e] + (pf[e] - cf[e]) * mv[2 * q + (e >> 2)][e & 3]; const float y = aa + bb * __builtin_amdgcn_rcpf(1.0f + __builtin_amdgcn_exp2f(ka * v)); o[e] = isI ? v : y; }
            *(LAS v4u*)(L + t * LO_PITCH + c * 2) = v4u{pk2(o[0], o[1]), pk2(o[2], o[3]), pk2(o[4], o[5]), pk2(o[6], o[7])}; } }
    {
        const int hh = tid & 7; const GAS float* k_k = inp(F, 16); GAS float* RN = OSP(float, OS_RN); float ss = 0.f;
#pragma unroll
        for (int hf = 0; hf < 2; ++hf) { v4u cur[4], prv[4]; f32x4v mk[8], kv[8]; const int cb = hh * 64 + 32 * hf;
#pragma unroll
            for (int q = 0; q < 4; ++q) { cur[q] = *(const GAS v4u*)(PR + row * RW_COLS + 512 + cb + 8 * q); prv[q] = *(const GAS v4u*)(PR + rowp * RW_COLS + 512 + cb + 8 * q); }
#pragma unroll
            for (int q = 0; q < 8; ++q) { mk[q] = *(const GAS f32x4v*)(mu + 512 + cb + 4 * q); kv[q] = *(const GAS f32x4v*)(k_k + cb + 4 * q); }
#pragma unroll
            for (int q = 0; q < 4; ++q)
#pragma unroll
                for (int e = 0; e < 8; ++e) { const float kc = bfel(cur[q], e), kp = hp ? bfel(prv[q], e) : 0.f; const float kk = (kc + (kp - kc) * mk[2 * q + (e >> 2)][e & 3]) * kv[2 * q + (e >> 2)][e & 3]; ss += kk * kk; } }
        RN[row * 8 + hh] = 1.0f / sqrtf(fmaxf(ss, 1e-24f)); }
    asm volatile("" ::: "memory");
    bf16x8 bw[4][2], ba[4][2], bg[4][4]; f32x4v biw[4], bia[4];
#pragma unroll
    for (int ntl = 0; ntl < 4; ++ntl) { const int n = 16 * (4 * w + ntl) + r16, n4 = 16 * (4 * w + ntl) + 4 * g4;
#pragma unroll
        for (int kk = 0; kk < 2; ++kk) { bw[ntl][kk] = *(const GAS bf16x8*)(LW + (size_t)n * 64 + 32 * kk + 8 * g4); ba[ntl][kk] = *(const GAS bf16x8*)(LA + (size_t)n * 64 + 32 * kk + 8 * g4); }
        biw[ntl] = *(const GAS f32x4v*)(w0 + n4); bia[ntl] = *(const GAS f32x4v*)(a0 + n4); }
    __syncthreads();
    if (MODE == 1) return;
#define LO_PROD(KK, KOFF, BF, ...) do { _Pragma("unroll") for (int ntl = 0; ntl < 4; ++ntl) { const int n4 = 16 * (4 * w + ntl) + 4 * g4; _Pragma("unroll") for (int mt = 0; mt < 4; ++mt) { f32x4v acc = f32x4v{0.f, 0.f, 0.f, 0.f}; \
        _Pragma("unroll") for (int kk = 0; kk < (KK); ++kk) { const bf16x8 af = *(const LAS bf16x8*)(L + (16 * mt + r16) * LO_PITCH + ((KOFF) + 32 * kk + 8 * g4) * 2); acc = __builtin_amdgcn_mfma_f32_16x16x32_bf16(BF[ntl][kk], af, acc, 0, 0, 0); } \
        const size_t orow = (size_t)m0 + 16 * mt + r16; __VA_ARGS__; } } } while (0)
    LO_PROD(2, 0, bw, { const f32x4v x = acc + biw[ntl]; *(GAS v2u*)(RE + orow * 512 + n4) = v2u{pk2(0.6065306597126334f * sigmf(x[0]), 0.6065306597126334f * sigmf(x[1])), pk2(0.6065306597126334f * sigmf(x[2]), 0.6065306597126334f * sigmf(x[3]))}; });
#pragma unroll
    for (int ntl = 0; ntl < 2; ++ntl) { const int n = 16 * (4 * w + ntl) + r16;
#pragma unroll
        for (int kk = 0; kk < 4; ++kk) bg[ntl][kk] = *(const GAS bf16x8*)(LG + (size_t)n * 128 + 32 * kk + 8 * g4); }
    LO_PROD(2, 64, ba, { const f32x4v x = acc + bia[ntl]; *(GAS v2u*)(RA + orow * 512 + n4) = v2u{pk2(sigmf(x[0]), sigmf(x[1])), pk2(sigmf(x[2]), sigmf(x[3]))}; });
#pragma unroll
    for (int ntl = 2; ntl < 4; ++ntl) { const int n = 16 * (4 * w + ntl) + r16;
#pragma unroll
        for (int kk = 0; kk < 4; ++kk) bg[ntl][kk] = *(const GAS bf16x8*)(LG + (size_t)n * 128 + 32 * kk + 8 * g4); }
    LO_PROD(4, 128, bg, { *(GAS v2u*)(Y + orow * 1024 + n4) = v2u{pk2(acc[0], acc[1]), pk2(acc[2], acc[3])}; });
#undef LO_PROD
}
constexpr int GR_P = 128, GR_BUF = 32 * GR_P, GR_AF = 0, GR_WAVE = 4 * GR_BUF;
static_assert(8 * GR_WAVE <= RING_BYTES && 32 * 33 * 4 + 3 * 2560 <= GR_WAVE, "gram LDS");
__device__ __forceinline__ void rwkv_gram_phase(Frame& F) {
    const int lane = F.lane, r16 = lane & 15, g4 = lane >> 4; LAS unsigned char* Lw = F.lds + F.wave * GR_WAVE; LAS float* Af = (LAS float*)(Lw + GR_AF);
    const GAS bf16* PR = WSP(bf16, WS_PR); const GAS bf16* RE = OSP(bf16, OS_RE); const GAS bf16* RA = OSP(bf16, OS_RA); const GAS float* RN = OSP(float, OS_RN); GAS v4u* GM = WSP(v4u, WS_GM); GAS float* WCg = OSP(float, OS_WC);
    GAS bf16* IKH = OSP(bf16, OS_IKH); GAS bf16* IRH = OSP(bf16, OS_IRH); GAS bf16* IAH = WSP(bf16, WS_IAH);
    const GAS float* mu = inp(F, 10); const GAS float* k_k = inp(F, 16); const GAS float* k_a = inp(F, 17);
    const int gw = F.vcu * NWAVES + F.wave, NGW = F.G * NWAVES;
    for (int u = gw; u < 64 * 64; u += NGW) { const int bh = u >> 6, c = u & 63, b = bh >> 3, h = bh & 7, gc = h * 64 + lane; const size_t row0 = (size_t)b * SEQ + c * 32;
        const float mr = mu[gc], mk = mu[512 + gc], ckk = k_k[gc], cka = k_a[gc];
        bf16x8 fKh[2][2], fAh[2][2], fKt[2][2], fRh[2][2];
        {   float cs = 0.f, rprev = 0.f, kprev = 0.f; if (c > 0) { rprev = bf2f(PR[(row0 - 1) * RW_COLS + gc]); kprev = bf2f(PR[(row0 - 1) * RW_COLS + 512 + gc]); }
            unsigned short lr[8], lk[8], le[8], la[8], nr[8], nk[8], ne[8], na[8];
#pragma unroll
            for (int i = 0; i < 8; ++i) { const size_t row = row0 + i; lr[i] = PR[row * RW_COLS + gc]; lk[i] = PR[row * RW_COLS + 512 + gc]; le[i] = RE[row * 512 + gc]; la[i] = RA[row * 512 + gc]; }
#pragma unroll 1
            for (int tb = 0; tb < 32; tb += 8) {
                if (tb + 8 < 32) {
#pragma unroll
                    for (int i = 0; i < 8; ++i) { const size_t row = row0 + tb + 8 + i; nr[i] = PR[row * RW_COLS + gc]; nk[i] = PR[row * RW_COLS + 512 + gc]; ne[i] = RE[row * 512 + gc]; na[i] = RA[row * 512 + gc]; } }
#pragma unroll
                for (int i = 0; i < 8; ++i) { const int t = tb + i; const size_t row = row0 + t; const float rc = bf2f(lr[i]), kc = bf2f(lk[i]), e = bf2f(le[i]), a = bf2f(la[i]);
                    const float r = rc + (rprev - rc) * mr, kx = kc + (kprev - kc) * mk; rprev = rc; kprev = kc;
                    const float kk = kx * ckk * RN[row * 8 + h];
                    const float wm = __expf(-cs); cs += e; const float wt = __expf(-cs), iw = __builtin_amdgcn_rcpf(wt);
                    if (t == 31) WCg[(size_t)u * 64 + lane] = wt;
                    LAS unsigned char* im = Lw + t * GR_P + lane * 2;
                    *(LAS unsigned short*)(im) = (unsigned short)f2bf(kk * wm); *(LAS unsigned short*)(im + GR_BUF) = (unsigned short)f2bf(kk * a * iw);
                    *(LAS unsigned short*)(im + 2 * GR_BUF) = (unsigned short)f2bf(kx * (1.0f + (a - 1.0f) * cka) * iw); *(LAS unsigned short*)(im + 3 * GR_BUF) = (unsigned short)f2bf(r * wt); }
#pragma unroll
                for (int i = 0; i < 8; ++i) { lr[i] = nr[i]; lk[i] = nk[i]; le[i] = ne[i]; la[i] = na[i]; }
            }
            asm volatile("s_waitcnt lgkmcnt(0)" ::: "memory");
#pragma unroll
            for (int mt = 0; mt < 2; ++mt)
#pragma unroll
                for (int kk2 = 0; kk2 < 2; ++kk2) { const LAS unsigned char* fp = Lw + (16 * mt + r16) * GR_P + (32 * kk2 + 8 * g4) * 2;
                    fKh[mt][kk2] = *(const LAS bf16x8*)(fp); fAh[mt][kk2] = *(const LAS bf16x8*)(fp + GR_BUF); fKt[mt][kk2] = *(const LAS bf16x8*)(fp + 2 * GR_BUF); fRh[mt][kk2] = *(const LAS bf16x8*)(fp + 3 * GR_BUF); }
            asm volatile("s_waitcnt lgkmcnt(0)" ::: "memory");
            {
                GAS bf16* IKT = (b < 5) ? WSP(bf16, WS_IKT_LO) : WSP(bf16, WS_IKT_HI); const int tq = lane >> 3, k8 = (lane & 7) * 8;
#pragma unroll 1
                for (int q = 0; q < 4; ++q) { const int t = q * 8 + tq; const LAS unsigned char* ip = Lw + t * GR_P + k8 * 2; const size_t go = (row0 + t) * 512 + h * 64 + k8;
                    const v4u i0 = *(const LAS v4u*)(ip), i1 = *(const LAS v4u*)(ip + GR_BUF), i2 = *(const LAS v4u*)(ip + 2 * GR_BUF), i3 = *(const LAS v4u*)(ip + 3 * GR_BUF);
                    *(GAS v4u*)(IKH + go) = i0; *(GAS v4u*)(IAH + go) = i1; *(GAS v4u*)(IKT + go) = i2; *(GAS v4u*)(IRH + go) = i3; }
                asm volatile("s_waitcnt lgkmcnt(0)" ::: "memory"); }
        }
        f32x4v gA[2][2], gB[2][2], gRA[2][2], gRK[2][2];
#pragma unroll
        for (int mt = 0; mt < 2; ++mt)
#pragma unroll
            for (int st = 0; st < 2; ++st) { f32x4v z = f32x4v{0.f, 0.f, 0.f, 0.f}; gA[mt][st] = z; gB[mt][st] = z; gRA[mt][st] = z; gRK[mt][st] = z;
#pragma unroll
                for (int kk = 0; kk < 2; ++kk) { gA[mt][st] = __builtin_amdgcn_mfma_f32_16x16x32_bf16(fKh[mt][kk], fAh[st][kk], gA[mt][st], 0, 0, 0); gB[mt][st] = __builtin_amdgcn_mfma_f32_16x16x32_bf16(fKh[mt][kk], fKt[st][kk], gB[mt][st], 0, 0, 0);
                    gRA[mt][st] = __builtin_amdgcn_mfma_f32_16x16x32_bf16(fRh[mt][kk], fAh[st][kk], gRA[mt][st], 0, 0, 0); gRK[mt][st] = __builtin_amdgcn_mfma_f32_16x16x32_bf16(fRh[mt][kk], fKt[st][kk], gRK[mt][st], 0, 0, 0); } }
#pragma unroll
        for (int mt = 0; mt < 2; ++mt)
#pragma unroll
            for (int st = 0; st < 2; ++st)
#pragma unroll
                for (int rg = 0; rg < 4; ++rg) { const int t = 16 * mt + 4 * g4 + rg, s_ = 16 * st + r16; Af[t * 33 + s_] = (s_ < t) ? gA[mt][st][rg] : 0.f; }
        asm volatile("s_waitcnt lgkmcnt(0)" ::: "memory");
        float Tc[32]; const int j = lane & 31;
#pragma unroll
        for (int t = 0; t < 32; ++t) { float acc[4] = {(t == j) ? 1.0f : 0.f, 0.f, 0.f, 0.f};
#pragma unroll
            for (int s_ = 0; s_ < t; ++s_) acc[s_ & 3] -= Af[t * 33 + s_] * Tc[s_];
            Tc[t] = (acc[0] + acc[1]) + (acc[2] + acc[3]); }
        LAS unsigned char* I0 = Lw, * I1 = Lw + 2560, * I2 = Lw + 5120;
        if (lane < 32) {
#pragma unroll
            for (int t = 0; t < 32; ++t) *(LAS unsigned short*)(I0 + t * 80 + j * 2) = (unsigned short)f2bf(Tc[t]); }
#define GR_CW(IMG, G, STRICT) do { _Pragma("unroll") for (int mt = 0; mt < 2; ++mt) _Pragma("unroll") for (int st = 0; st < 2; ++st) _Pragma("unroll") for (int rg = 0; rg < 4; ++rg) { const int t = 16 * mt + 4 * g4 + rg, s_ = 16 * st + r16; \
            *(LAS unsigned short*)(IMG + t * 80 + s_ * 2) = (unsigned short)f2bf(((STRICT) ? (s_ < t) : (s_ <= t)) ? G[mt][st][rg] : 0.f); } } while (0)
        GR_CW(I1, gB, true); GR_CW(I2, gRA, false);
        asm volatile("s_waitcnt lgkmcnt(0)" ::: "memory");
        GAS v4u* gm = GM + (size_t)u * 512 + lane;
#pragma unroll
        for (int mt = 0; mt < 2; ++mt) { const LAS unsigned char* rT = I0 + (16 * mt + r16) * 80, * rB = I1 + (16 * mt + r16) * 80, * rR = I2 + (16 * mt + r16) * 80;
            const v2u t0 = *(const LAS v2u*)(rT + (4 * g4) * 2), t1 = *(const LAS v2u*)(rT + (16 + 4 * g4) * 2); gm[(0 * 2 + mt) * 64] = v4u{t0.x, t0.y, t1.x, t1.y};
            gm[(1 * 2 + mt) * 64] = *(const LAS v4u*)(rB + (8 * g4) * 2);
            const v2u a0 = *(const LAS v2u*)(rR + (4 * g4) * 2), a1 = *(const LAS v2u*)(rR + (16 + 4 * g4) * 2); gm[(2 * 2 + mt) * 64] = v4u{a0.x, a0.y, a1.x, a1.y}; }
        asm volatile("s_waitcnt lgkmcnt(0)" ::: "memory");
        GR_CW(I0, gRK, false);
        asm volatile("s_waitcnt lgkmcnt(0)" ::: "memory");
#pragma unroll
        for (int mt = 0; mt < 2; ++mt) gm[(3 * 2 + mt) * 64] = *(const LAS v4u*)(I0 + (16 * mt + r16) * 80 + (8 * g4) * 2);
        asm volatile("s_waitcnt lgkmcnt(0)" ::: "memory");
#undef GR_CW
    }
}
constexpr int CS_KH = 0, CS_RH = CS_KH + 32 * 144, CS_AT = CS_RH + 32 * 144, CS_KT = CS_AT + 64 * 80, CS_VT = CS_KT + 64 * 80, CS_WC = CS_VT + 16 * 80, CS_YR = CS_WC + 256, CS_BUF = CS_YR + 32 * 16 * 4;
static_assert(2 * CS_BUF <= RING_BYTES && CS_AT % 16 == 0 && CS_VT % 16 == 0 && CS_WC % 16 == 0 && CS_YR % 16 == 0 && CS_BUF % 16 == 0, "chunk scan LDS");
__device__ __forceinline__ bf16x8 pack8(const f32x4v a, const f32x4v b) { const v4u w = v4u{pk2(a[0], a[1]), pk2(a[2], a[3]), pk2(b[0], b[1]), pk2(b[2], b[3])}; return __builtin_bit_cast(bf16x8, w); }
__device__ __forceinline__ bf16x8 cat8(const v2u a, const v2u b) { const v4u w = v4u{a.x, a.y, b.x, b.y}; return __builtin_bit_cast(bf16x8, w); }
template <bool DRY = false, bool NOPROD = false> __device__ __forceinline__ void rwkv_cscan_unit(Frame& F, int u) {
    const int tid = F.tid, lane = F.lane, w = F.wave, r16 = lane & 15, g4 = lane >> 4; LAS unsigned char* L = F.lds;
    const int ch = u >> 2, rg = u & 3, b = ch >> 3, h = ch & 7; const size_t rowbase = (size_t)b * SEQ;
    const GAS bf16* PR = WSP(bf16, WS_PR); const GAS v4u* GM = WSP(v4u, WS_GM); GAS bf16* YRAW = WSP(bf16, WS_YRAW); GAS long long* RST = OSP(long long, OS_RST);
    const GAS float* WCg = OSP(float, OS_WC); const GAS bf16* IKH = OSP(bf16, OS_IKH); const GAS bf16* IRH = OSP(bf16, OS_IRH); const GAS bf16* IAH = WSP(bf16, WS_IAH);
    const GAS bf16* IKT = (b < 5) ? WSP(bf16, WS_IKT_LO) : WSP(bf16, WS_IKT_HI);
#define CS_T16(DST, V, C8, T_) do { _Pragma("unroll") for (int e = 0; e < 8; ++e) *(LAS unsigned short*)((DST) + ((C8) + e) * 80 + (T_) * 2) = (unsigned short)(((V)[e >> 1]) >> (16 * (e & 1))); } while (0)
#define CS_CL(CC) ((CC) < 63 ? (CC) : 63)
#define CS_FLUSH(CC) do { const int t0f_ = (CC) * 32; const LAS float* yr_ = (const LAS float*)(L + ((CC) & 1) * CS_BUF + CS_YR); \
        { const int t_ = lane >> 1, hf_ = lane & 1; const LAS float* p_ = yr_ + t_ * 16 + hf_ * 8; const f32x4v a_ = *(const LAS f32x4v*)p_, b_ = *(const LAS f32x4v*)(p_ + 4); \
            *(GAS v4u*)(YRAW + (rowbase + t0f_ + t_) * 512 + h * 64 + rg * 16 + hf_ * 8) = v4u{pk2(a_[0], a_[1]), pk2(a_[2], a_[3]), pk2(b_[0], b_[1]), pk2(b_[2], b_[3])}; \
            float s1_ = (a_[0] + a_[1]) + (a_[2] + a_[3]) + (b_[0] + b_[1]) + (b_[2] + b_[3]); float s2_ = (a_[0] * a_[0] + a_[1] * a_[1]) + (a_[2] * a_[2] + a_[3] * a_[3]) + (b_[0] * b_[0] + b_[1] * b_[1]) + (b_[2] * b_[2] + b_[3] * b_[3]); \
            s1_ += __shfl_xor(s1_, 1); s2_ += __shfl_xor(s2_, 1); \
            if (hf_ == 0 && !DRY) { GAS long long* st_ = RST + ((rowbase + t0f_ + t_) * 8 + h) * 2; __hip_atomic_fetch_add(st_, fx20(s1_), __ATOMIC_RELAXED, __HIP_MEMORY_SCOPE_AGENT); __hip_atomic_fetch_add(st_ + 1, fx20(s2_), __ATOMIC_RELAXED, __HIP_MEMORY_SCOPE_AGENT); } } \
    } while (0)
    __syncthreads();
    if (w == 0) {
        f32x4v S[4]; S[0] = f32x4v{0.f, 0.f, 0.f, 0.f}; S[1] = S[0]; S[2] = S[0]; S[3] = S[0];
        v4u gTa[2], gBa[2], gRAa[2], gRKa[2];
#define CS_GM(CC, G) do { const GAS v4u* gm_ = GM + ((size_t)ch * 64 + (CC)) * 512 + lane; gT##G[0] = gm_[0]; gT##G[1] = gm_[64]; gB##G[0] = gm_[128]; gB##G[1] = gm_[192]; gRA##G[0] = gm_[256]; gRA##G[1] = gm_[320]; gRK##G[0] = gm_[384]; gRK##G[1] = gm_[448]; } while (0)
        CS_GM(0, a);
        LDS_BARRIER();
#define CS_CONS(c, G) do { \
            const LAS unsigned char* B = L + ((c) & 1) * CS_BUF; \
            const bf16x8 fT0 = __builtin_bit_cast(bf16x8, gT##G[0]), fT1 = __builtin_bit_cast(bf16x8, gT##G[1]), fB0 = __builtin_bit_cast(bf16x8, gB##G[0]), fB1 = __builtin_bit_cast(bf16x8, gB##G[1]); \
            const bf16x8 fRA0 = __builtin_bit_cast(bf16x8, gRA##G[0]), fRA1 = __builtin_bit_cast(bf16x8, gRA##G[1]), fRK0 = __builtin_bit_cast(bf16x8, gRK##G[0]), fRK1 = __builtin_bit_cast(bf16x8, gRK##G[1]); \
            CS_GM(CS_CL((c) + 1), G); \
            const bf16x8 sB0 = pack8(S[0], S[1]), sB1 = pack8(S[2], S[3]); \
            const bf16x8 vB = *(const LAS bf16x8*)(B + CS_VT + r16 * 80 + 16 * g4); \
            f32x4v X[2], Y[2]; \
            _Pragma("unroll") \
            for (int mt = 0; mt < 2; ++mt) { const LAS unsigned char* kr = B + CS_KH + (16 * mt + r16) * 144 + 8 * g4; const LAS unsigned char* rr = B + CS_RH + (16 * mt + r16) * 144 + 8 * g4; \
                const bf16x8 k0 = cat8(*(const LAS v2u*)(kr), *(const LAS v2u*)(kr + 32)), k1 = cat8(*(const LAS v2u*)(kr + 64), *(const LAS v2u*)(kr + 96)); \
                const bf16x8 q0 = cat8(*(const LAS v2u*)(rr), *(const LAS v2u*)(rr + 32)), q1 = cat8(*(const LAS v2u*)(rr + 64), *(const LAS v2u*)(rr + 96)); \
                f32x4v x = f32x4v{0.f, 0.f, 0.f, 0.f}; x = __builtin_amdgcn_mfma_f32_16x16x32_bf16(k0, sB0, x, 0, 0, 0); x = __builtin_amdgcn_mfma_f32_16x16x32_bf16(k1, sB1, x, 0, 0, 0); \
                X[mt] = __builtin_amdgcn_mfma_f32_16x16x32_bf16(mt ? fB1 : fB0, vB, x, 0, 0, 0); \
                f32x4v y = f32x4v{0.f, 0.f, 0.f, 0.f}; y = __builtin_amdgcn_mfma_f32_16x16x32_bf16(q0, sB0, y, 0, 0, 0); y = __builtin_amdgcn_mfma_f32_16x16x32_bf16(q1, sB1, y, 0, 0, 0); \
                Y[mt] = __builtin_amdgcn_mfma_f32_16x16x32_bf16(mt ? fRK1 : fRK0, vB, y, 0, 0, 0); } \
            const bf16x8 xB = pack8(X[0], X[1]); \
            const f32x4v z = f32x4v{0.f, 0.f, 0.f, 0.f}; \
            const f32x4v U0 = -__builtin_amdgcn_mfma_f32_16x16x32_bf16(fT0, xB, z, 0, 0, 0), U1 = -__builtin_amdgcn_mfma_f32_16x16x32_bf16(fT1, xB, z, 0, 0, 0); \
            const bf16x8 uB = pack8(U0, U1); \
            Y[0] = __builtin_amdgcn_mfma_f32_16x16x32_bf16(fRA0, uB, Y[0], 0, 0, 0); Y[1] = __builtin_amdgcn_mfma_f32_16x16x32_bf16(fRA1, uB, Y[1], 0, 0, 0); \
            _Pragma("unroll") \
            for (int kt = 0; kt < 4; ++kt) { const LAS unsigned char* ar = B + CS_AT + (16 * kt + r16) * 80 + 8 * g4; const bf16x8 af = cat8(*(const LAS v2u*)(ar), *(const LAS v2u*)(ar + 32)); \
                const bf16x8 kf = *(const LAS bf16x8*)(B + CS_KT + (16 * kt + r16) * 80 + 16 * g4); const f32x4v wc = *(const LAS f32x4v*)(B + CS_WC + (16 * kt + 4 * g4) * 4); \
                f32x4v acc = __builtin_amdgcn_mfma_f32_16x16x32_bf16(af, uB, S[kt], 0, 0, 0); acc = __builtin_amdgcn_mfma_f32_16x16x32_bf16(kf, vB, acc, 0, 0, 0); S[kt] = acc * wc; } \
            LAS float* yr = (LAS float*)(L + ((c) & 1) * CS_BUF + CS_YR); \
            _Pragma("unroll") \
            for (int mt = 0; mt < 2; ++mt) \
            _Pragma("unroll") \
                for (int rg_ = 0; rg_ < 4; ++rg_) yr[(16 * mt + 4 * g4 + rg_) * 16 + r16] = Y[mt][rg_]; \
        LDS_BARRIER(); \
    } while (0)
#pragma unroll 1
        for (int c2 = 0; c2 < 64; c2 += 2) { CS_CONS(c2, a); CS_CONS(c2 + 1, a); }
#undef CS_CONS
#undef CS_GM
    } else if (w == 1) {
        LDS_BARRIER();
#pragma unroll 1
        for (int c = 0; c < 64; ++c) { if (c >= 1) CS_FLUSH(c - 1); LDS_BARRIER(); }
        CS_FLUSH(63);
    } else if (w == 2) {
        const int t8 = lane >> 3, c8 = (lane & 7) * 8; const GAS bf16* src = IKT + (rowbase + t8) * 512 + h * 64 + c8; v4u qa[4], qb[4];
#define CS_LOAD(CC, Q) do { const GAS bf16* p_ = src + (size_t)CS_CL(CC) * (32 * 512); _Pragma("unroll") for (int it_ = 0; it_ < 4; ++it_) q##Q[it_] = *(const GAS v4u*)(p_ + it_ * (8 * 512)); } while (0)
#define CS_PREP(CC, Q) do { LAS unsigned char* B_ = L + ((CC) & 1) * CS_BUF; _Pragma("unroll") for (int it_ = 0; it_ < 4; ++it_) CS_T16(B_ + CS_KT, q##Q[it_], c8, 8 * it_ + t8); } while (0)
#define CS_PROD(c, Q) do { if (!NOPROD) { CS_PREP((c) + 1, Q); CS_LOAD((c) + 3, Q); } LDS_BARRIER(); } while (0)
        CS_LOAD(0, a); CS_PREP(0, a); CS_LOAD(1, b); CS_LOAD(2, a);
        LDS_BARRIER();
#pragma unroll 1
        for (int c2 = 0; c2 < 64; c2 += 2) { CS_PROD(c2, b); CS_PROD(c2 + 1, a); }
#undef CS_LOAD
#undef CS_PREP
    } else if (w == 3) {
        const int t_ = lane >> 1, hf = (lane & 1) * 8, vcol = h * 64 + rg * 16 + hf; const GAS float* mu = inp(F, 10); float cB[8];
#pragma unroll
        for (int e = 0; e < 8; ++e) cB[e] = mu[1024 + vcol + e];
        const GAS bf16* src = PR + (rowbase + t_) * RW_COLS + 1024 + vcol; v4u qa[2], qb[2];
#define CS_LOAD(CC, Q) do { const GAS bf16* p_ = src + (size_t)CS_CL(CC) * (32 * RW_COLS); q##Q[0] = *(const GAS v4u*)(p_); q##Q[1] = *(const GAS v4u*)(p_ - ((CS_CL(CC) * 32 + t_ > 0) ? RW_COLS : 0)); } while (0)
#define CS_PREP(CC, Q) do { LAS unsigned char* B_ = L + ((CC) & 1) * CS_BUF; const bool first_ = ((CC) * 32 + t_ == 0); \
            _Pragma("unroll") for (int e = 0; e < 8; ++e) { const float vc_ = bfel(q##Q[0], e), vp_ = first_ ? 0.f : bfel(q##Q[1], e); *(LAS unsigned short*)(B_ + CS_VT + (hf + e) * 80 + t_ * 2) = (unsigned short)f2bf(vc_ + (vp_ - vc_) * cB[e]); } } while (0)
        CS_LOAD(0, a); CS_PREP(0, a); CS_LOAD(1, b); CS_LOAD(2, a);
        LDS_BARRIER();
#pragma unroll 1
        for (int c2 = 0; c2 < 64; c2 += 2) { CS_PROD(c2, b); CS_PROD(c2 + 1, a); }
#undef CS_LOAD
#undef CS_PREP
    } else {
        const int ptid = tid & 255, pt = ptid >> 3, c8 = (ptid & 7) * 8; const size_t o0 = (rowbase + pt) * 512 + h * 64 + c8; const GAS float* wsrc = WCg + (size_t)ch * 64 * 64 + (ptid & 63);
        v4u qa[3], qb[3]; float qwa, qwb;
#define CS_LOAD(CC, Q) do { const size_t o_ = o0 + (size_t)CS_CL(CC) * (32 * 512); q##Q[0] = *(const GAS v4u*)(IKH + o_); q##Q[1] = *(const GAS v4u*)(IRH + o_); q##Q[2] = *(const GAS v4u*)(IAH + o_); qw##Q = wsrc[CS_CL(CC) * 64]; } while (0)
#define CS_PREP(CC, Q) do { LAS unsigned char* B_ = L + ((CC) & 1) * CS_BUF; *(LAS v4u*)(B_ + CS_KH + pt * 144 + c8 * 2) = q##Q[0]; *(LAS v4u*)(B_ + CS_RH + pt * 144 + c8 * 2) = q##Q[1]; CS_T16(B_ + CS_AT, q##Q[2], c8, pt); \
            if (ptid < 64) *(LAS float*)(B_ + CS_WC + ptid * 4) = qw##Q; } while (0)
        CS_LOAD(0, a); CS_PREP(0, a); CS_LOAD(1, b); CS_LOAD(2, a);
        LDS_BARRIER();
#pragma unroll 1
        for (int c2 = 0; c2 < 64; c2 += 2) { CS_PROD(c2, b); CS_PROD(c2 + 1, a); }
#undef CS_LOAD
#undef CS_PREP
#undef CS_PROD
    }
#undef CS_FLUSH
#undef CS_T16
#undef CS_CL
}
template <bool DRY = false, bool NOPROD = false> __device__ __forceinline__ void rwkv_cscan_phase(Frame& F) {
    for (int u = F.vcu; u < 256; u += F.G) rwkv_cscan_unit<DRY, NOPROD>(F, u);
}
__device__ __forceinline__ void rwkv_post_phase(Frame& F) {
    const int gw = F.vcu * NWAVES + F.wave, NGW = F.G * NWAVES, lane = F.lane, c = lane * 8, hh = lane >> 3;
    const GAS bf16* PR = WSP(bf16, WS_PR); const GAS bf16* RA = OSP(bf16, OS_RA); const GAS bf16* YRAW = WSP(bf16, WS_YRAW); const GAS long long* RST = OSP(long long, OS_RST); GAS bf16* Y = WSP(bf16, WS_Y);
    const GAS float* mu = inp(F, 10); const GAS float* k_a = inp(F, 17); const GAS float* r_k = inp(F, 18); const GAS float* lnw = inp(F, 19); const GAS float* lnb = inp(F, 20);
    float mur[8], muk[8], muv[8], cka[8], crk[8], clw[8], clb[8];
#pragma unroll
    for (int e = 0; e < 8; ++e) { mur[e] = mu[c + e]; muk[e] = mu[512 + c + e]; muv[e] = mu[1024 + c + e]; cka[e] = k_a[c + e]; crk[e] = r_k[c + e]; clw[e] = lnw[c + e]; clb[e] = lnb[c + e]; }
    for (int m0 = gw; m0 < M; m0 += 2 * NGW) {
        v4u rc_[2], kc_[2], vc_[2], rp_[2], kp_[2], vp_[2], av_[2], gv_[2], yv_[2]; long long s1_[2], s2_[2];
#pragma unroll
        for (int k = 0; k < 2; ++k) { const int mk = m0 + k * NGW, m = mk < M ? mk : M - 1; const size_t row = (size_t)m, rowp = (m & (SEQ - 1)) != 0 ? row - 1 : row;
            rc_[k] = *(const GAS v4u*)(PR + row * RW_COLS + c); kc_[k] = *(const GAS v4u*)(PR + row * RW_COLS + 512 + c); vc_[k] = *(const GAS v4u*)(PR + row * RW_COLS + 1024 + c);
            rp_[k] = *(const GAS v4u*)(PR + rowp * RW_COLS + c); kp_[k] = *(const GAS v4u*)(PR + rowp * RW_COLS + 512 + c); vp_[k] = *(const GAS v4u*)(PR + rowp * RW_COLS + 1024 + c);
            av_[k] = *(const GAS v4u*)(RA + row * 512 + c); gv_[k] = *(const GAS v4u*)(Y + row * 1024 + c); yv_[k] = *(const GAS v4u*)(YRAW + row * 512 + c);
            s1_[k] = RST[(row * 8 + hh) * 2]; s2_[k] = RST[(row * 8 + hh) * 2 + 1]; }
#pragma unroll
        for (int k = 0; k < 2; ++k) { const int m = m0 + k * NGW; if (m < M) { const size_t row = (size_t)m; const bool hp = (m & (SEQ - 1)) != 0; const v4u z = v4u{0u, 0u, 0u, 0u};
            float rc[8], rp[8], kc[8], kp[8], vc[8], vp[8], aa[8], gg[8], yy[8]; unpack8(rc_[k], rc); unpack8(hp ? rp_[k] : z, rp); unpack8(kc_[k], kc); unpack8(hp ? kp_[k] : z, kp); unpack8(vc_[k], vc); unpack8(hp ? vp_[k] : z, vp); unpack8(av_[k], aa); unpack8(gv_[k], gg); unpack8(yv_[k], yy);
            float vs[8]; float bon = 0.f;
#pragma unroll
            for (int e = 0; e < 8; ++e) { const float r = rc[e] + (rp[e] - rc[e]) * mur[e], kx = kc[e] + (kp[e] - kc[e]) * muk[e]; vs[e] = vc[e] + (vp[e] - vc[e]) * muv[e]; bon += r * (kx * (1.0f + (aa[e] - 1.0f) * cka[e])) * crk[e]; }
            bon += __shfl_xor(bon, 1); bon += __shfl_xor(bon, 2); bon += __shfl_xor(bon, 4);
            const float s1 = unfx20(s1_[k]), s2 = unfx20(s2_[k]); const float mean = s1 * (1.0f / 64.0f), var = fmaxf(s2 * (1.0f / 64.0f) - mean * mean, 0.f), rs = 1.0f / sqrtf(var + 64e-5f);
            float o[8];
#pragma unroll
            for (int e = 0; e < 8; ++e) o[e] = ((yy[e] - mean) * rs * clw[e] + clb[e] + bon * vs[e]) * gg[e];
            *(GAS v4u*)(Y + row * 1024 + c) = v4u{pk2(o[0], o[1]), pk2(o[2], o[3]), pk2(o[4], o[5]), pk2(o[6], o[7])}; } }
    }
}
template <int MODE = 0> __device__ __forceinline__ void lora_kmean_phase(Frame& F) {
    for (int u = F.vcu; u < 256; u += F.G) rwkv_lora_unit<MODE>(F, u);
}

__device__ __forceinline__ int crow(int r, int hi) { return (r & 3) + 8 * (r >> 2) + 4 * hi; }
constexpr int MO_ROWB = 144;
constexpr int MO_BUF = 2 * 64 * MO_ROWB;
constexpr int MO_KM = 40960;
static_assert(2 * MO_BUF <= MO_KM && MO_KM + 2048 <= RING_BYTES, "MoBA LDS");
__device__ __forceinline__ void moba_unit(Frame& F, int b, int h, int qb) {
    const int tid = F.tid, lane = F.lane, wid = F.wave, r32 = lane & 31, hi = lane >> 5;
    const GAS bf16* QB = WSP(bf16, WS_QB); const GAS bf16* KB = WSP(bf16, WS_KB); const GAS bf16* VB = WSP(bf16, WS_VB); GAS bf16* Y = WSP(bf16, WS_Y); const GAS float* km = WSP(float, WS_KMEAN);
    const size_t rowbase = (size_t)b * SEQ; const int qpos = qb * 256 + wid * 32 + r32; const float NEG = -INFINITY;
    bf16x8 qr[4]; { const GAS bf16* qp = QB + (rowbase + qpos) * 512 + h * 64 + hi * 8;
#pragma unroll
        for (int d0 = 0; d0 < 4; ++d0) qr[d0] = *(const GAS bf16x8*)(qp + d0 * 16); }
    unsigned sel = 0u;
    if (qb > 0) {
        LAS float* KM = (LAS float*)(F.lds + MO_KM);
        __syncthreads();
        KM[tid] = km[(size_t)(b * 8 + h) * 8 * 64 + tid];
        __syncthreads();
        float gate[7];
#pragma unroll
        for (int n = 0; n < 7; ++n) { float g = 0.f;
            if (n < qb) { const LAS float* kp = KM + n * 64 + hi * 8;
#pragma unroll
                for (int d0 = 0; d0 < 4; ++d0) { const f32x4v k0 = *(const LAS f32x4v*)(kp + d0 * 16), k1 = *(const LAS f32x4v*)(kp + d0 * 16 + 4);
#pragma unroll
                    for (int j = 0; j < 4; ++j) { g += bf2f((bf16)qr[d0][j]) * k0[j]; g += bf2f((bf16)qr[d0][4 + j]) * k1[j]; } }
                g += __shfl_xor(g, 32); }
            gate[n] = (n < qb) ? g : NEG; }
        const int nsel = qb < 3 ? qb : 3;
#pragma unroll
        for (int s = 0; s < 3; ++s) { int best = 0; float bv = NEG; bool have = false;
#pragma unroll
            for (int n = 0; n < 7; ++n) { const bool ok = (n < qb) && !((sel >> n) & 1u) && (!have || gate[n] > bv); if (ok) { best = n; bv = gate[n]; have = true; } }
            if (s < nsel) sel |= 1u << best; }
    }
    const float C2 = 0.125f * 1.4426950408889634f, sl2 = exp2f(-(float)(h + 1)) * 1.4426950408889634f;
    const int NT = 4 * (qb + 1);
    f32x16 abias[2];
#pragma unroll
    for (int kb = 0; kb < 2; ++kb)
#pragma unroll
        for (int r = 0; r < 16; ++r) abias[kb][r] = sl2 * (float)(32 * kb + crow(r, hi));
    const GAS bf16* kg = KB + (rowbase + (tid >> 3)) * 512 + h * 64 + (tid & 7) * 8; const GAS bf16* vg = VB + (rowbase + lane) * 512 + h * 64 + wid * 8;
    const int kdst = (tid >> 3) * MO_ROWB + (tid & 7) * 16, vdst = 64 * MO_ROWB + (wid * 8) * MO_ROWB + lane * 2;
    f32x16 o[2]; o[0] = f32x16{}; o[1] = f32x16{}; float mrun = NEG, lrun = 0.f;
    v4u kreg, vreg;
    { const int kb0 = (4 * qb) * 64; kreg = *(const GAS v4u*)(kg + (size_t)kb0 * 512); vreg = *(const GAS v4u*)(vg + (size_t)kb0 * 512); }
    __syncthreads();
    { LAS unsigned char* B0 = F.lds; *(LAS v4u*)(B0 + kdst) = kreg; const unsigned w[4] = {vreg.x, vreg.y, vreg.z, vreg.w};
#pragma unroll
        for (int e = 0; e < 8; ++e) *(LAS unsigned short*)(B0 + vdst + e * MO_ROWB) = (unsigned short)((e & 1) ? (w[e >> 1] >> 16) : (w[e >> 1] & 0xffffu)); }
    __syncthreads();
    for (int it = 0; it < NT; ++it) {
        const int tk = (it < 4) ? 4 * qb + it : it - 4, kb0 = tk * 64, nb = tk >> 2;
        if (it + 1 < NT) { const int tn = (it + 1 < 4) ? 4 * qb + it + 1 : it - 3; kreg = *(const GAS v4u*)(kg + (size_t)tn * 64 * 512); vreg = *(const GAS v4u*)(vg + (size_t)tn * 64 * 512); }
        LAS unsigned char* Kb = F.lds + (it & 1) * MO_BUF; LAS unsigned char* Vb = Kb + 64 * MO_ROWB;
        const bool row_ok = (nb == qb) || ((sel >> nb) & 1u);
        f32x16 p[2];
#pragma unroll
        for (int kb = 0; kb < 2; ++kb) { p[kb] = f32x16{};
#pragma unroll
            for (int d0 = 0; d0 < 4; ++d0) { const bf16x8 a = *(const LAS bf16x8*)(Kb + (32 * kb + r32) * MO_ROWB + (d0 * 16 + hi * 8) * 2); p[kb] = __builtin_amdgcn_mfma_f32_32x32x16_bf16(a, qr[d0], p[kb], 0, 0, 0); } }
        float rmax = NEG; const float off = row_ok ? sl2 * (float)(kb0 - qpos) : NEG;
        p[0] = p[0] * C2 + (abias[0] + off); p[1] = p[1] * C2 + (abias[1] + off);
        if (nb == qb) {
#pragma unroll
            for (int kb = 0; kb < 2; ++kb)
#pragma unroll
                for (int r = 0; r < 16; ++r) { const int kpos = kb0 + 32 * kb + crow(r, hi); if (kpos > qpos) p[kb][r] = NEG; }
        }
        {   const f32x16 mx = __builtin_elementwise_max(p[0], p[1]);
#pragma unroll
            for (int r = 0; r < 16; ++r) rmax = fmaxf(rmax, mx[r]); }
        rmax = fmaxf(rmax, __shfl_xor(rmax, 32));
        const float mnew = fmaxf(mrun, rmax), alpha = __builtin_amdgcn_exp2f(mrun - mnew); mrun = mnew; lrun *= alpha;
        if (__any(alpha != 1.0f)) {
#pragma unroll
            for (int r = 0; r < 16; ++r) { o[0][r] *= alpha; o[1][r] *= alpha; } }
        p[0] = p[0] - mnew; p[1] = p[1] - mnew;
#pragma unroll
        for (int kb = 0; kb < 2; ++kb)
#pragma unroll
            for (int r = 0; r < 16; ++r) p[kb][r] = __builtin_amdgcn_exp2f(p[kb][r]);
        {   const f32x16 sv = p[0] + p[1]; float psum = 0.f;
#pragma unroll
            for (int r = 0; r < 16; ++r) psum += sv[r];
            lrun += psum; }
#pragma unroll
        for (int kb = 0; kb < 2; ++kb)
#pragma unroll
            for (int s2 = 0; s2 < 2; ++s2) { v4u pw; pw.x = pg8::cvt_pk_bf16(p[kb][8 * s2 + 0], p[kb][8 * s2 + 1]); pw.y = pg8::cvt_pk_bf16(p[kb][8 * s2 + 2], p[kb][8 * s2 + 3]);
                pw.z = pg8::cvt_pk_bf16(p[kb][8 * s2 + 4], p[kb][8 * s2 + 5]); pw.w = pg8::cvt_pk_bf16(p[kb][8 * s2 + 6], p[kb][8 * s2 + 7]);
                const bf16x8 pb = __builtin_bit_cast(bf16x8, pw); const int k0 = 32 * kb + 16 * s2 + 4 * hi;
#pragma unroll
                for (int db = 0; db < 2; ++db) { const LAS unsigned char* vp = Vb + (32 * db + r32) * MO_ROWB + k0 * 2;
                    const v2u lo = *(const LAS v2u*)vp, hi8 = *(const LAS v2u*)(vp + 16); const v4u av = {lo.x, lo.y, hi8.x, hi8.y};
                    o[db] = __builtin_amdgcn_mfma_f32_32x32x16_bf16(__builtin_bit_cast(bf16x8, av), pb, o[db], 0, 0, 0); } }
        if (it + 1 < NT) { LAS unsigned char* B1 = F.lds + ((it + 1) & 1) * MO_BUF; *(LAS v4u*)(B1 + kdst) = kreg; const unsigned w[4] = {vreg.x, vreg.y, vreg.z, vreg.w};
#pragma unroll
            for (int e = 0; e < 8; ++e) *(LAS unsigned short*)(B1 + vdst + e * MO_ROWB) = (unsigned short)((e & 1) ? (w[e >> 1] >> 16) : (w[e >> 1] & 0xffffu)); }
        __syncthreads();
    }
    lrun += __shfl_xor(lrun, 32); const float inv = 1.0f / lrun;
    GAS bf16* yp = Y + (rowbase + qpos) * 1024 + 512 + h * 64 + 4 * hi;
#pragma unroll
    for (int db = 0; db < 2; ++db)
#pragma unroll
        for (int g = 0; g < 4; ++g) *(GAS v2u*)(yp + 32 * db + 8 * g) = v2u{pk2(o[db][4 * g] * inv, o[db][4 * g + 1] * inv), pk2(o[db][4 * g + 2] * inv, o[db][4 * g + 3] * inv)};
}
__device__ __forceinline__ void moba_phase(Frame& F) {
    for (int u = F.vcu; u < 256; u += F.G) { const int bh = u >> 2, pr = u & 3; moba_unit(F, bh >> 3, bh & 7, pr); moba_unit(F, bh >> 3, bh & 7, 7 - pr); }
}

constexpr int HG_PQ = 272, HG_PS = 144;
constexpr int HG_QT = 0, HG_KT = HG_QT + 64 * HG_PQ, HG_KTT = HG_KT + 64 * HG_PQ, HG_IT = HG_KTT + 128 * HG_PS, HG_ST = HG_IT + 32 * HG_PS, HG_AS = HG_ST + 32 * HG_PQ, HG_TOT = HG_AS + 64 * HG_PS, HG_END = HG_TOT + 8 * 128 * 4;
constexpr int HG_OB = 81920, HG_POB = 80;
static_assert(HG_END <= HG_OB && HG_OB + 512 * HG_POB <= RING_BYTES, "HGRN2 LDS");
static_assert(HG_END <= RING_BYTES, "hgrn LDS");
__device__ __forceinline__ void hgrn_prep_phase(Frame& F) {
    const int tid = F.tid; LAS float* TOT = (LAS float*)(F.lds + HG_TOT);
    GAS bf16* HQ = WSP(bf16, WS_HQ); GAS bf16* HF = WSP(bf16, WS_HF); GAS bf16* KT2 = OSP(bf16, OS_KT2); GAS float* RB = WSP(float, WS_RB);
    const GAS float* lbl = inp(F, 24); const int kp = tid & 63, tq = tid >> 6;
    unsigned fr_n[8], qr_n[8];
#define HP_LOAD(U) do { const int u_ = (U); const int gc_ = ((u_ >> 5) & 7) * 128 + 2 * kp; const size_t r0_ = (size_t)(u_ >> 8) * SEQ + (u_ & 31) * 64 + 8 * tq; \
        _Pragma("unroll") for (int i = 0; i < 8; ++i) { fr_n[i] = *(const GAS unsigned*)(HF + (r0_ + i) * 1024 + gc_); qr_n[i] = *(const GAS unsigned*)(HQ + (r0_ + i) * 1024 + gc_); } } while (0)
    if (F.vcu < 2048) HP_LOAD(F.vcu);
    for (int u = F.vcu; u < 2048; u += F.G) {
        const int h = (u >> 5) & 7, gc = h * 128 + 2 * kp; const size_t r0 = (size_t)(u >> 8) * SEQ + (u & 31) * 64 + 8 * tq;
        const float lb0 = __builtin_amdgcn_rcpf(1.0f + __expf(lbl[gc] - lbl[1024 + gc])), lb1 = __builtin_amdgcn_rcpf(1.0f + __expf(lbl[gc + 1] - lbl[1024 + gc + 1]));
        float qv[8][2], kd[8][2], bl[8][2]; float run0 = 0.f, run1 = 0.f;
#pragma unroll
        for (int i = 0; i < 8; ++i) { const float s0 = sigmf(bflo(fr_n[i])), s1 = sigmf(bfhi(fr_n[i]));
            kd[i][0] = (1.0f - lb0) * (1.0f - s0); kd[i][1] = (1.0f - lb1) * (1.0f - s1); qv[i][0] = bflo(qr_n[i]); qv[i][1] = bfhi(qr_n[i]);
            run0 += __logf(lb0 + (1.0f - lb0) * s0); run1 += __logf(lb1 + (1.0f - lb1) * s1); bl[i][0] = run0; bl[i][1] = run1; }
        LDS_BARRIER();
        *(LAS v2f*)(TOT + tq * 128 + 2 * kp) = v2f{run0, run1};
        LDS_BARRIER();
        if (u + F.G < 2048) HP_LOAD(u + F.G);
        float off0 = 0.f, off1 = 0.f, rr0 = 0.f, rr1 = 0.f, bb0 = 0.f, bb1 = 0.f;
#pragma unroll
        for (int q = 0; q < 8; ++q) { const v2f tv = *(const LAS v2f*)(TOT + q * 128 + 2 * kp); if (q < tq) { off0 += tv[0]; off1 += tv[1]; } if (q < 4) { rr0 += tv[0]; rr1 += tv[1]; } bb0 += tv[0]; bb1 += tv[1]; }
        unsigned kw0[4], kw1[4];
#pragma unroll
        for (int i = 0; i < 8; ++i) { const float e0 = __expf(bl[i][0] + off0 - rr0), e1 = __expf(bl[i][1] + off1 - rr1);
            *(GAS unsigned*)(HQ + (r0 + i) * 1024 + gc) = pk2(qv[i][0] * e0, qv[i][1] * e1);
            const unsigned kk = pk2(kd[i][0] * __builtin_amdgcn_rcpf(e0), kd[i][1] * __builtin_amdgcn_rcpf(e1)); *(GAS unsigned*)(HF + (r0 + i) * 1024 + gc) = kk;
            if (i & 1) { kw0[i >> 1] |= kk << 16; kw1[i >> 1] |= kk & 0xffff0000u; } else { kw0[i >> 1] = kk & 0xffffu; kw1[i >> 1] = kk >> 16; } }
        GAS bf16* kt = KT2 + ((size_t)u * 128 + 2 * kp) * 64 + 8 * tq; *(GAS v4u*)kt = v4u{kw0[0], kw0[1], kw0[2], kw0[3]}; *(GAS v4u*)(kt + 64) = v4u{kw1[0], kw1[1], kw1[2], kw1[3]};
        if (tq == 0) { *(GAS v2f*)(RB + (size_t)u * 256 + 2 * kp) = v2f{rr0, rr1}; *(GAS v2f*)(RB + (size_t)u * 256 + 128 + 2 * kp) = v2f{bb0, bb1}; }
    }
#undef HP_LOAD
}
template <bool DRY> __device__ __forceinline__ void hgrn_unit(Frame& F, int b, int h, int vq) {
    const int tid = F.tid, lane = F.lane, w = F.wave, r16 = lane & 15, g4 = lane >> 4;
    LAS unsigned char* L = F.lds;
    const GAS bf16* HQ = WSP(bf16, WS_HQ); const GAS bf16* HF = WSP(bf16, WS_HF); GAS bf16* HI = WSP(bf16, WS_HI); GAS long long* HSS = OSP(long long, OS_HSS); const GAS bf16* KT2 = OSP(bf16, OS_KT2); const GAS float* RB = WSP(float, WS_RB);
    const size_t rowbase = (size_t)b * SEQ; const int ubase = (b * 8 + h) * 32;
    f32x4v S[2]; S[0] = f32x4v{0.f, 0.f, 0.f, 0.f}; S[1] = S[0];
    __syncthreads();
    for (int i = tid; i < 64 * HG_PS / 4; i += NTHREADS) ((LAS unsigned*)(L + HG_AS))[i] = 0u;
    const int tr = w >> 1, vc = w & 1;
    v4u q0A, q1A, k0A, k1A, t0A, t1A, q0B, q1B, k0B, k1B, t0B, t1B, rbA, rbB; v2u iiA, iiB;
#define HS_LOAD(C, q0_, q1_, k0_, k1_, t0_, t1_, ii_, rb_) do { const size_t row_ = rowbase + (size_t)(C) * 64 + (tid >> 3); const GAS bf16* qp_ = HQ + row_ * 1024 + h * 128 + (tid & 7) * 16; const GAS bf16* kp_ = HF + row_ * 1024 + h * 128 + (tid & 7) * 16; \
        q0_ = *(const GAS v4u*)qp_; q1_ = *(const GAS v4u*)(qp_ + 8); k0_ = *(const GAS v4u*)kp_; k1_ = *(const GAS v4u*)(kp_ + 8); \
        const GAS bf16* tp_ = KT2 + ((size_t)(ubase + (C)) * 128 + (tid >> 2)) * 64 + (tid & 3) * 16; t0_ = *(const GAS v4u*)tp_; t1_ = *(const GAS v4u*)(tp_ + 8); \
        ii_ = *(const GAS v2u*)(HI + row_ * 1024 + h * 128 + vq * 32 + (tid & 7) * 4); \
        rb_ = *(const GAS v4u*)(RB + (size_t)(ubase + (C)) * 256 + (tid & 63) * 4); } while (0)
#define HS_CHUNK(CC, q0_, q1_, k0_, k1_, t0_, t1_, ii_, rb_, rbn_) do { \
        LDS_BARRIER(); \
        const f32x4v rv_ = *(const LAS f32x4v*)(L + HG_TOT + ((CC) & 1) * 1024 + (16 * w + 4 * g4) * 4), bv_ = *(const LAS f32x4v*)(L + HG_TOT + ((CC) & 1) * 1024 + 512 + (16 * w + 4 * g4) * 4); \
        {   LAS unsigned char* qd = L + HG_QT + (tid >> 3) * HG_PQ + (tid & 7) * 32; *(LAS v4u*)qd = q0_; *(LAS v4u*)(qd + 16) = q1_; \
            LAS unsigned char* kd_ = L + HG_KT + (tid >> 3) * HG_PQ + (tid & 7) * 32; *(LAS v4u*)kd_ = k0_; *(LAS v4u*)(kd_ + 16) = k1_; \
            LAS unsigned char* td = L + HG_KTT + (tid >> 2) * HG_PS + (tid & 3) * 32; *(LAS v4u*)td = t0_; *(LAS v4u*)(td + 16) = t1_; \
            LAS unsigned char* id = L + HG_IT + ((tid & 7) * 4) * HG_PS + (tid >> 3) * 2; \
            *(LAS unsigned short*)(id) = (unsigned short)(ii_.x & 0xffffu); *(LAS unsigned short*)(id + HG_PS) = (unsigned short)(ii_.x >> 16); *(LAS unsigned short*)(id + 2 * HG_PS) = (unsigned short)(ii_.y & 0xffffu); *(LAS unsigned short*)(id + 3 * HG_PS) = (unsigned short)(ii_.y >> 16); } \
        HS_LOAD(((CC) + 2 < 32 ? (CC) + 2 : 31), q0_, q1_, k0_, k1_, t0_, t1_, ii_, rb_);         \
        float e63[4], e63r[4]; \
        {   float er[4]; \
_Pragma("unroll") \
            for (int rg = 0; rg < 4; ++rg) { er[rg] = __expf(rv_[rg]); e63[rg] = __expf(bv_[rg]); e63r[rg] = __expf(bv_[rg] - rv_[rg]); } \
_Pragma("unroll") \
            for (int cc = 0; cc < 2; ++cc) *(LAS v2u*)(L + HG_ST + (16 * cc + r16) * HG_PQ + (16 * w + 4 * g4) * 2) = v2u{pk2(S[cc][0] * er[0], S[cc][1] * er[1]), pk2(S[cc][2] * er[2], S[cc][3] * er[3])}; } \
        LDS_BARRIER(); \
        f32x4v oacc = f32x4v{0.f, 0.f, 0.f, 0.f}; \
        {   bf16x8 qa[4]; \
_Pragma("unroll") \
            for (int kk = 0; kk < 4; ++kk) qa[kk] = *(const LAS bf16x8*)(L + HG_QT + (16 * tr + r16) * HG_PQ + (32 * kk + 8 * g4) * 2); \
_Pragma("unroll") \
            for (int cc = 0; cc < 2; ++cc) { const int tc = 2 * vc + cc; \
                if (tc <= tr) { f32x4v acc = f32x4v{0.f, 0.f, 0.f, 0.f}; \
_Pragma("unroll") \
                    for (int kk = 0; kk < 4; ++kk) { const bf16x8 kb = *(const LAS bf16x8*)(L + HG_KT + (16 * tc + r16) * HG_PQ + (32 * kk + 8 * g4) * 2); acc = __builtin_amdgcn_mfma_f32_16x16x32_bf16(qa[kk], kb, acc, 0, 0, 0); } \
_Pragma("unroll") \
                    for (int rg = 0; rg < 4; ++rg) { const int t = 16 * tr + 4 * g4 + rg, s_ = 16 * tc + r16; *(LAS unsigned short*)(L + HG_AS + t * HG_PS + s_ * 2) = (unsigned short)f2bf(s_ <= t ? acc[rg] : 0.f); } } } \
_Pragma("unroll") \
            for (int kk = 0; kk < 4; ++kk) { const bf16x8 sb = *(const LAS bf16x8*)(L + HG_ST + (16 * vc + r16) * HG_PQ + (32 * kk + 8 * g4) * 2); oacc = __builtin_amdgcn_mfma_f32_16x16x32_bf16(qa[kk], sb, oacc, 0, 0, 0); } \
        } \
        f32x4v dS[2]; \
_Pragma("unroll") \
        for (int cc = 0; cc < 2; ++cc) { dS[cc] = f32x4v{0.f, 0.f, 0.f, 0.f}; \
_Pragma("unroll") \
            for (int kk = 0; kk < 2; ++kk) { const bf16x8 ka = *(const LAS bf16x8*)(L + HG_KTT + (16 * w + r16) * HG_PS + (32 * kk + 8 * g4) * 2); const bf16x8 ib = *(const LAS bf16x8*)(L + HG_IT + (16 * cc + r16) * HG_PS + (32 * kk + 8 * g4) * 2); \
                dS[cc] = __builtin_amdgcn_mfma_f32_16x16x32_bf16(ka, ib, dS[cc], 0, 0, 0); } } \
_Pragma("unroll") \
        for (int cc = 0; cc < 2; ++cc) \
_Pragma("unroll") \
            for (int rg = 0; rg < 4; ++rg) S[cc][rg] = e63[rg] * S[cc][rg] + e63r[rg] * dS[cc][rg]; \
        LDS_BARRIER(); \
        if (tid < 64) *(LAS v4u*)(L + HG_TOT + (((CC) + 1) & 1) * 1024 + tid * 16) = rbn_;                    \
_Pragma("unroll") \
        for (int kk = 0; kk < 2; ++kk) { const bf16x8 aa = *(const LAS bf16x8*)(L + HG_AS + (16 * tr + r16) * HG_PS + (32 * kk + 8 * g4) * 2); const bf16x8 ib = *(const LAS bf16x8*)(L + HG_IT + (16 * vc + r16) * HG_PS + (32 * kk + 8 * g4) * 2); \
            oacc = __builtin_amdgcn_mfma_f32_16x16x32_bf16(aa, ib, oacc, 0, 0, 0); } \
_Pragma("unroll") \
        for (int rg = 0; rg < 4; ++rg) *(LAS unsigned short*)(L + HG_OB + (((CC) & 7) * 64 + 16 * tr + 4 * g4 + rg) * HG_POB + (16 * vc + r16) * 2) = (unsigned short)f2bf(oacc[rg]); \
    } while (0)
    HS_LOAD(0, q0A, q1A, k0A, k1A, t0A, t1A, iiA, rbA);
    HS_LOAD(1, q0B, q1B, k0B, k1B, t0B, t1B, iiB, rbB);
    if (tid < 64) *(LAS v4u*)(L + HG_TOT + tid * 16) = rbA;
#pragma unroll
    for (int blk = 0; blk < 4; ++blk) {
#pragma unroll 1
        for (int c = 8 * blk; c < 8 * blk + 8; c += 2) {
            HS_CHUNK(c, q0A, q1A, k0A, k1A, t0A, t1A, iiA, rbA, rbB);
            HS_CHUNK(c + 1, q0B, q1B, k0B, k1B, t0B, t1B, iiB, rbB, rbA);
        }
        LDS_BARRIER();
        {
            const size_t row = rowbase + (size_t)blk * 512 + tid; const LAS unsigned char* op = L + HG_OB + tid * HG_POB; float ss = 0.f;
            GAS bf16* dst = (DRY ? WSP(bf16, WS_DRY) : HI) + (DRY ? (row & 2047) : row) * 1024 + h * 128 + vq * 32;
#pragma unroll
            for (int q = 0; q < 4; ++q) { const v4u v = *(const LAS v4u*)(op + 16 * q); *(GAS v4u*)(dst + 8 * q) = v;
#pragma unroll
                for (int e = 0; e < 8; ++e) { const float x = bfel(v, e); ss += x * x; } }
            if (!DRY) __hip_atomic_fetch_add(HSS + row * 8 + h, fx20(ss), __ATOMIC_RELAXED, __HIP_MEMORY_SCOPE_AGENT);
            __builtin_amdgcn_s_waitcnt(0x0F70);
        }
    }
#undef HS_CHUNK
#undef HS_LOAD
}
template <bool DRY> __device__ __forceinline__ void hgrn_phase(Frame& F) {
    for (int u = F.vcu; u < 256; u += F.G) hgrn_unit<DRY>(F, u >> 5, (u >> 2) & 7, u & 3);
}
__device__ __forceinline__ void hgrn_post_phase(Frame& F) {
    const int gw = F.vcu * NWAVES + F.wave, NGW = F.G * NWAVES, c0 = F.lane * 8; GAS bf16* HI = WSP(bf16, WS_HI); const GAS bf16* HG = WSP(bf16, WS_HG); const GAS long long* HSS = OSP(long long, OS_HSS); const GAS float* nw = inp(F, 23);
    float nwv[2][8];
#pragma unroll
    for (int j = 0; j < 2; ++j)
#pragma unroll
        for (int e = 0; e < 8; ++e) nwv[j][e] = nw[c0 + 512 * j + e];
    for (int m0 = gw; m0 < M; m0 += 4 * NGW) { v4u ov[4][2], gv[4][2]; long long hs[4][2];
#pragma unroll
        for (int k = 0; k < 4; ++k) { const int mk = m0 + k * NGW, m = mk < M ? mk : M - 1;
#pragma unroll
            for (int j = 0; j < 2; ++j) { const int c = c0 + 512 * j; hs[k][j] = HSS[(size_t)m * 8 + (c >> 7)]; ov[k][j] = *(const GAS v4u*)(HI + (size_t)m * 1024 + c); gv[k][j] = *(const GAS v4u*)(HG + (size_t)m * 1024 + c); } }
#pragma unroll
        for (int k = 0; k < 4; ++k) { const int m = m0 + k * NGW; if (m < M) {
#pragma unroll
            for (int j = 0; j < 2; ++j) { const int c = c0 + 512 * j; const float rs = 1.0f / sqrtf(unfx20(hs[k][j]) * (1.0f / 128.0f) + 1e-6f);
                const unsigned ow[4] = {ov[k][j].x, ov[k][j].y, ov[k][j].z, ov[k][j].w}, gw4[4] = {gv[k][j].x, gv[k][j].y, gv[k][j].z, gv[k][j].w}; unsigned rw[4];
#pragma unroll
                for (int e = 0; e < 4; ++e) { const float o0 = __builtin_bit_cast(float, ow[e] << 16), o1 = __builtin_bit_cast(float, ow[e] & 0xffff0000u), g0 = __builtin_bit_cast(float, gw4[e] << 16), g1 = __builtin_bit_cast(float, gw4[e] & 0xffff0000u);
                    rw[e] = pk2(o0 * rs * nwv[j][2 * e] * sigmf(g0), o1 * rs * nwv[j][2 * e + 1] * sigmf(g1)); }
                *(GAS v4u*)(HI + (size_t)m * 1024 + c) = v4u{rw[0], rw[1], rw[2], rw[3]}; } } }
    }
}

__device__ __forceinline__ void final_phase(Frame& F) {
    const int gw = F.vcu * NWAVES + F.wave, NGW = F.G * NWAVES, c0 = F.lane * 8; const GAS float* fg = inp(F, 25); const GAS pg8::ssq_t* ssq = SSQ_SLOT(6); const GAS bf16* XB = WSP(bf16, WS_XB);
    f32x4 g[2][2];
#pragma unroll
    for (int j = 0; j < 2; ++j) { g[j][0] = *(const GAS f32x4*)(fg + c0 + 512 * j); g[j][1] = *(const GAS f32x4*)(fg + c0 + 512 * j + 4); }
    for (int m0 = gw; m0 < M; m0 += 4 * NGW) { v4u xr[4][2]; pg8::ssq_t sq[4];
#pragma unroll
        for (int k = 0; k < 4; ++k) { const int mk = m0 + k * NGW, m = mk < M ? mk : M - 1; sq[k] = ssq[m];
#pragma unroll
            for (int j = 0; j < 2; ++j) xr[k][j] = *(const GAS v4u*)(XB + (size_t)m * D + c0 + 512 * j); }
#pragma unroll
        for (int k = 0; k < 4; ++k) { const int m = m0 + k * NGW; if (m < M) { const float rs = pg8::ssq_to_rstd(sq[k]);
#pragma unroll
            for (int j = 0; j < 2; ++j) { float xv[8]; unpack8(xr[k][j], xv); GAS f32x4* o = (GAS f32x4*)(F.out + (size_t)m * D + c0 + 512 * j);
                o[0] = (f32x4){xv[0] * rs * g[j][0][0], xv[1] * rs * g[j][0][1], xv[2] * rs * g[j][0][2], xv[3] * rs * g[j][0][3]}; o[1] = (f32x4){xv[4] * rs * g[j][1][0], xv[5] * rs * g[j][1][1], xv[6] * rs * g[j][1][2], xv[7] * rs * g[j][1][3]}; } } }
    }
}

#ifndef PROBE_DBL
#define PROBE_DBL 0
#endif
#ifndef MK_N_LAUNCHES
#define MK_N_LAUNCHES 1
#endif
constexpr int NPHASE = 17;
__global__ void __launch_bounds__(NTHREADS, 2) hyb_fwd(Args args) {
    extern __shared__ __attribute__((aligned(16))) unsigned char lds[];
    Frame F0;
    F0.lds = (LAS unsigned char*)lds; F0.MISC = (volatile LAS unsigned*)(F0.lds + MISC_OFF);
    F0.tid = threadIdx.x; F0.lane = F0.tid & 63; F0.wave = __builtin_amdgcn_readfirstlane(F0.tid >> 6);
    F0.G = gridDim.x; { const int bx = blockIdx.x; F0.vcu = (F0.G % 8 == 0) ? (bx % 8) * (F0.G / 8) + bx / 8 : bx; }
    F0.out = (GAS float*)args.out; F0.ws = (GAS unsigned char*)args.ws; F0.ctl = (gu32*)(args.ws + WS_CTL);
    for (int u = F0.tid; u < (LDS_BYTES - LDSCTL_OFF) / 4; u += NTHREADS) ((LAS unsigned*)(F0.lds + LDSCTL_OFF))[u] = 0u;
    __syncthreads();
    if (F0.tid == 0) {
#pragma unroll
        for (int i = 0; i < N_IN; ++i) ((LAS unsigned long long*)(F0.lds + PTAB_OFF))[i] = (unsigned long long)args.in[i]; }
    __syncthreads();
    XcdBarrier bar; bar.bar = (unsigned*)(F0.ctl + CW_BAR); bar.x = 0; bar.st = nullptr;
    if (MK_N_LAUNCHES == 1) bar = xcd_barrier_post((unsigned*)(F0.ctl + CW_BAR), F0.MISC + 8);
    const int lo = args.ph_lo, hi = args.ph_hi;
#define IN(k) (MK_N_LAUNCHES == 1 || in_range((k), lo, hi))
#define GBAR() do { asm volatile("" : "+s"(bar.bar), "+s"(bar.x)); xcd_barrier(bar); } while (0)
#define SEAM(k) do { if (MK_N_LAUNCHES == 1) GBAR(); } while (0)
    if (IN(0)) { if (PROBE_DBL & 1) { { PHASE_FRAME(F); prologue_phase(F); } GBAR(); } PHASE_FRAME(F); prologue_phase(F); SEAM(0); }
#pragma unroll
    for (int f = 0; f < 4; ++f) {
        const int pu = (f == 0) ? 1 : (f == 1) ? 7 : (f == 2) ? 9 : 14;
        if (IN(pu)) { PHASE_FRAME(F);
            pg8::Gemm g{(const bf16*)WSP(bf16, WS_XB), (const bf16*)WSP(bf16, WS_WUP + f * W_UP_BYTES), M, 2 * FF, D}; pg8::StaticOrder S; S.init(M, 2 * FF, F.G, (int)blockIdx.x);
            pg8::EpiSwiglu E{WSP(bf16, WS_H), FF, SSQ_SLOT((f == 0) ? 0 : (f == 1) ? 2 : (f == 2) ? 3 : 5)};
            if (PROBE_DBL & (2 | 128)) { pg8::gemm_phase<pg8::EpiSwiglu, pg8::StaticOrder, true, true>(F.lds, g, S, E); GBAR(); }
            pg8::gemm_phase<pg8::EpiSwiglu, pg8::StaticOrder, true, true>(F.lds, g, S, E);
            {
                constexpr int UP_IDLE0 = (M / 256) * (2 * FF / 256) % 256; static_assert(UP_IDLE0 == 128, "idle tail of the up GEMM");
                if ((int)blockIdx.x >= UP_IDLE0 && F.G == 256) { const int rk = ((int)blockIdx.x - UP_IDLE0) * NWAVES + F.wave, nr = (256 - UP_IDLE0) * NWAVES;
                    if (f == 0) convert_items(F, CV_G1, CV_G2, rk, nr); else if (f == 1) convert_items(F, CV_G3, CV_G4, rk, nr); else if (f == 2) convert_items(F, CV_G4, CV_G5, rk, nr); else convert_items(F, CV_G5, CV_END, rk, nr); }
                else if (F.G != 256) { const int gw_ = (int)blockIdx.x * NWAVES + F.wave, nr_ = F.G * NWAVES;
                    if (f == 0) convert_items(F, CV_G1, CV_G2, gw_, nr_); else if (f == 1) convert_items(F, CV_G3, CV_G4, gw_, nr_); else if (f == 2) convert_items(F, CV_G4, CV_G5, gw_, nr_); else convert_items(F, CV_G5, CV_END, gw_, nr_); } }
            SEAM(pu);
        }
        if (IN(pu + 1)) { PHASE_FRAME(F);
            pg8::Gemm g{(const bf16*)WSP(bf16, WS_H), (const bf16*)WSP(bf16, WS_WDN + f * W_DN_BYTES), M, D, FF}; pg8::StaticOrder S; S.init(M, D, F.G, (int)blockIdx.x);
            pg8::EpiResid E{WSP(bf16, WS_XB), SSQ_SLOT((f == 0) ? 1 : (f == 1) ? 3 : (f == 2) ? 4 : 6), 0.5f};
            if (PROBE_DBL & (2 | 256)) { pg8::EpiResid E0 = E; E0.alpha = 0.f; pg8::gemm_phase<pg8::EpiResid, pg8::StaticOrder, true, true>(F.lds, g, S, E0); GBAR(); }
            pg8::gemm_phase<pg8::EpiResid, pg8::StaticOrder, true, true>(F.lds, g, S, E);
            SEAM(pu + 1);
        }
        if (f == 0) {
            if (IN(3)) { PHASE_FRAME(F);
                pg8::Gemm g{(const bf16*)WSP(bf16, WS_XB), (const bf16*)WSP(bf16, WS_WEVIN), M, EV_IN, D}; pg8::StaticOrder S; S.init(M, EV_IN, F.G, (int)blockIdx.x);
                pg8::EpiProj E{WSP(bf16, WS_PR), RW_COLS, RW_COLS / 256, WSP(bf16, WS_QB), 512, 2, (size_t)M * 512, SSQ_SLOT(1), WSP(float, WS_KMEAN), RW_COLS / 256 + 2};
                if (PROBE_DBL & (2 | 512)) { pg8::EpiProj E0 = E; E0.kmean = nullptr; pg8::gemm_phase<pg8::EpiProj, pg8::StaticOrder, true, true>(F.lds, g, S, E0); GBAR(); }
                pg8::gemm_phase<pg8::EpiProj, pg8::StaticOrder, true, true>(F.lds, g, S, E);
                {
                    if ((int)blockIdx.x >= 64 && F.G == 256) convert_items(F, CV_G2, CV_G3, ((int)blockIdx.x - 64) * NWAVES + F.wave, 192 * NWAVES);
                    else if (F.G != 256) convert_items(F, CV_G2, CV_G3, (int)blockIdx.x * NWAVES + F.wave, F.G * NWAVES); }
                SEAM(3);
            }
                        if (IN(5)) { if (PROBE_DBL & 4) { { PHASE_FRAME(F); lora_kmean_phase<(PROBE_DBL >> 16) & 3>(F); } GBAR(); } { PHASE_FRAME(F); lora_kmean_phase(F); } if (PROBE_DBL & 8) { { PHASE_FRAME(F); moba_phase(F); } GBAR(); } { PHASE_FRAME(F); moba_phase(F); } if (MK_N_LAUNCHES == 1) GBAR(); if (PROBE_DBL & 4096) { { PHASE_FRAME(F); rwkv_gram_phase(F); } GBAR(); } { PHASE_FRAME(F); rwkv_gram_phase(F); } GBAR(); if (PROBE_DBL & 16) { { PHASE_FRAME(F); rwkv_cscan_phase<true, false>(F); } GBAR(); } if (PROBE_DBL & 8192) { { PHASE_FRAME(F); rwkv_cscan_phase<true, true>(F); } GBAR(); } { PHASE_FRAME(F); rwkv_cscan_phase(F); } if (MK_N_LAUNCHES == 1) GBAR(); { PHASE_FRAME(F); rwkv_post_phase(F); } SEAM(5); }
            if (IN(6)) { PHASE_FRAME(F);
                pg8::Gemm g{(const bf16*)WSP(bf16, WS_Y), (const bf16*)WSP(bf16, WS_WEVOUT), M, D, D}; pg8::StaticOrder S; S.init(M, D, F.G, (int)blockIdx.x);
                pg8::EpiResid E{WSP(bf16, WS_XB), SSQ_SLOT(2), 1.0f};
                if (PROBE_DBL & (2 | 256)) { pg8::EpiResid E0 = E; E0.alpha = 0.f; pg8::gemm_phase<pg8::EpiResid, pg8::StaticOrder, true, true>(F.lds, g, S, E0); GBAR(); }
                pg8::gemm_phase<pg8::EpiResid, pg8::StaticOrder, true, true>(F.lds, g, S, E);
                SEAM(6);
            }
        }
        if (f == 2) {
            if (IN(11)) { PHASE_FRAME(F);
                pg8::Gemm g{(const bf16*)WSP(bf16, WS_XB), (const bf16*)WSP(bf16, WS_WODIN), M, OD_IN, D}; pg8::StaticOrder S; S.init(M, OD_IN, F.G, (int)blockIdx.x);
                pg8::EpiProj E{nullptr, 0, 0, WSP(bf16, WS_HQ), 1024, 4, (size_t)M * 1024, SSQ_SLOT(4), nullptr, 0};
                if (PROBE_DBL & (2 | 512)) { pg8::EpiProj E0 = E; E0.kmean = nullptr; pg8::gemm_phase<pg8::EpiProj, pg8::StaticOrder, true, true>(F.lds, g, S, E0); GBAR(); }
                pg8::gemm_phase<pg8::EpiProj, pg8::StaticOrder, true, true>(F.lds, g, S, E);
                SEAM(11);
            }
            if (IN(12)) { { PHASE_FRAME(F); hgrn_prep_phase(F); } GBAR(); if (PROBE_DBL & 32) { { PHASE_FRAME(F); hgrn_phase<true>(F); } GBAR(); } { PHASE_FRAME(F); hgrn_phase<false>(F); } if (MK_N_LAUNCHES == 1) GBAR(); { PHASE_FRAME(F); hgrn_post_phase(F); } SEAM(12); }
            if (IN(13)) { PHASE_FRAME(F);
                pg8::Gemm g{(const bf16*)WSP(bf16, WS_HI), (const bf16*)WSP(bf16, WS_WODOUT), M, D, D}; pg8::StaticOrder S; S.init(M, D, F.G, (int)blockIdx.x);
                pg8::EpiResid E{WSP(bf16, WS_XB), SSQ_SLOT(5), 1.0f};
                if (PROBE_DBL & (2 | 256)) { pg8::EpiResid E0 = E; E0.alpha = 0.f; pg8::gemm_phase<pg8::EpiResid, pg8::StaticOrder, true, true>(F.lds, g, S, E0); GBAR(); }
                pg8::gemm_phase<pg8::EpiResid, pg8::StaticOrder, true, true>(F.lds, g, S, E);
                SEAM(13);
            }
        }
    }
    if (PROBE_DBL & 64) { for (int i_ = 0; i_ < 20; ++i_) GBAR(); }
    if (IN(16)) { PHASE_FRAME(F); final_phase(F); }
#undef IN
#undef SEAM
}

extern "C" void kernel_launch(void* const* d_in, const int* in_sizes, int n_in, void* d_out, int out_size, void* d_ws, size_t ws_size, hipStream_t stream) {
    static int grid = 0;
    if (grid == 0) {
        if (n_in != N_IN || in_sizes[0] != M * D || out_size != M * D || ws_size < WS_END) { fprintf(stderr, "kernel_launch: unexpected shapes (n_in %d in0 %d out %d ws %zu); nothing launched\n", n_in, n_in > 0 ? in_sizes[0] : -1, out_size, ws_size); grid = -1; return; }
        int dev = 0, cus = 0, per_cu = 0;
        if (hipGetDevice(&dev) != hipSuccess || hipDeviceGetAttribute(&cus, hipDeviceAttributeMultiprocessorCount, dev) != hipSuccess) { grid = -1; return; }
        if (hipFuncSetAttribute((const void*)hyb_fwd, hipFuncAttributeMaxDynamicSharedMemorySize, LDS_BYTES) != hipSuccess) { fprintf(stderr, "kernel_launch: hipFuncSetAttribute failed\n"); grid = -1; return; }
        if (hipOccupancyMaxActiveBlocksPerMultiprocessor(&per_cu, (const void*)hyb_fwd, NTHREADS, LDS_BYTES) != hipSuccess || per_cu < 1) { fprintf(stderr, "kernel_launch: occupancy query says %d\n", per_cu); }
        (void)hipGetLastError();
        grid = cus;
    }
    if (grid < 0) return;
    if (hipMemsetAsync((char*)d_ws + WS_CTL, 0, CTL_ZERO_BYTES, stream) != hipSuccess) return;
    if (hipMemsetAsync((char*)d_out + OS_ZERO_BEGIN, 0, OS_ZERO_BYTES, stream) != hipSuccess) return;
    Args a{};
    for (int i = 0; i < N_IN; ++i) a.in[i] = (const float*)d_in[i];
    a.out = (float*)d_out; a.ws = (unsigned char*)d_ws;
    if (MK_N_LAUNCHES == 1) { a.ph_lo = 0; a.ph_hi = NPHASE; a.li = 0; hipLaunchKernelGGL(hyb_fwd, dim3(grid), dim3(NTHREADS), LDS_BYTES, stream, a); }
    else for (int li = 0; li < NPHASE; ++li) { a.ph_lo = li; a.ph_hi = li + 1; a.li = 0; hipLaunchKernelGGL(hyb_fwd, dim3(grid), dim3(NTHREADS), LDS_BYTES, stream, a); }
}
```

```cpp
#include <hip/hip_runtime.h>
#include <cstdio>
#include <cstdint>
namespace pg8 {
#define PG8_LAS __attribute__((address_space(3)))
typedef unsigned short bf16_t;
typedef short bf16x8 __attribute__((ext_vector_type(8)));
typedef float f32x4 __attribute__((ext_vector_type(4)));
typedef unsigned u32x4 __attribute__((ext_vector_type(4)));
constexpr int BM = 256, BK = 64, HALF = 128, HTB = HALF * BK * 2  , STAGE_BYTES = 8 * HTB, NXCD = 8, WGM = 8;

__host__ __device__ __forceinline__ int lds_byte(int r, int c) { const int st = (r >> 4) * 2 + (c >> 5), rr = r & 15, cc = c & 31, ob = rr * 64 + cc * 2; return st * 1024 + (ob ^ (((ob >> 9) & 1) << 5)); }
__host__ __device__ __forceinline__ void stage_rc(int b, int& R, int& C) { const int st = b / 1024, sb = b % 1024, swz = sb ^ (((sb >> 9) & 1) << 5); R = (st >> 1) * 16 + swz / 64; C = (st & 1) * 32 + (swz % 64) / 2; }
__host__ __device__ __forceinline__ int perm32(int rho) { const int n = rho >> 4, i = rho & 15; return 8 * (i >> 2) + 4 * n + (i & 3); }

struct Unit { int pm, pn; };
struct Gemm { const bf16_t* A; const bf16_t* Bt; int M, N, K; };

struct StaticOrder {
    int nM, nN, nwg, G, c;
    __host__ __device__ void init(int M, int N, int G_, int c_) { nM = M / BM; nN = N / BM; nwg = nM * nN; G = G_; c = c_; }
    __host__ __device__ bool next(int i, Unit& u) const {
        const long L = (long)i * G + c; if (L >= nwg) return false;
        int wgid = (int)L; { const int q = nwg / NXCD, r = nwg % NXCD, xcd = wgid % NXCD, off = wgid / NXCD; wgid = (xcd < r ? xcd * (q + 1) : r * (q + 1) + (xcd - r) * q) + off; }
        const int nig = WGM * nN, gid = wgid / nig, fm = gid * WGM, gsz = (nM - fm) < WGM ? (nM - fm) : WGM;
        u.pm = fm + ((wgid % nig) % gsz); u.pn = (wgid % nig) / gsz; return true;
    }
    __device__ __forceinline__ void a_ready(const Unit&) const {}
    __device__ __forceinline__ void done(const Unit&) const {}
};

__device__ __forceinline__ unsigned cvt_pk_bf16(float lo, float hi) { unsigned r; asm volatile("v_cvt_pk_bf16_f32 %0, %1, %2" : "=v"(r) : "v"(lo), "v"(hi)); return r; }
typedef float f32x2 __attribute__((ext_vector_type(2)));
#define PG8_GAS __attribute__((address_space(1)))
typedef unsigned long long ssq_t;
__device__ __forceinline__ float ssq_to_rstd(ssq_t v) { return __builtin_amdgcn_rsqf((float)v * (1.0f / (16777216.0f * 1024.0f)) + 1e-6f); }
__device__ __forceinline__ ssq_t ssq_fix(float s) { return (ssq_t)(s * 16777216.0f + 0.5f); }
__device__ __forceinline__ float row_rstd(const PG8_GAS ssq_t* ssq, int row) { return ssq_to_rstd(ssq[row]); }
__device__ __forceinline__ float silu_f(float x) { return x * __builtin_amdgcn_rcpf(1.0f + __builtin_amdgcn_exp2f(-1.4426950408889634f * x)); }
struct EpiSwiglu {
    static constexpr bool PERM = true, AFTER_DRAIN = false;
    PG8_GAS bf16_t* H; int ldh; const PG8_GAS ssq_t* ssq;
    __device__ __forceinline__ void operator()(const f32x4 (&acc)[2][2][4][2], const Unit& u, int wr, int wc, int fr, int fq) const {
        const int row0 = u.pm * BM + wr * 64 + fr, col0 = u.pn * HALF + wc * 32 + 8 * fq; ssq_t rsv[2][4];
#pragma unroll
        for (int ai = 0; ai < 2; ++ai)
#pragma unroll
            for (int m = 0; m < 4; ++m) rsv[ai][m] = ssq[row0 + ai * HALF + m * 16];
#pragma unroll
        for (int ai = 0; ai < 2; ++ai)
#pragma unroll
            for (int m = 0; m < 4; ++m) { const int row = row0 + ai * HALF + m * 16; const float rs = ssq_to_rstd(rsv[ai][m]);
                const f32x4 g0 = acc[ai][0][m][0] * rs, g1 = acc[ai][0][m][1] * rs, u0 = acc[ai][1][m][0] * rs, u1 = acc[ai][1][m][1] * rs;
                u32x4 w; w.x = cvt_pk_bf16(silu_f(g0[0]) * u0[0], silu_f(g0[1]) * u0[1]); w.y = cvt_pk_bf16(silu_f(g0[2]) * u0[2], silu_f(g0[3]) * u0[3]);
                w.z = cvt_pk_bf16(silu_f(g1[0]) * u1[0], silu_f(g1[1]) * u1[1]); w.w = cvt_pk_bf16(silu_f(g1[2]) * u1[2], silu_f(g1[3]) * u1[3]);
                *(PG8_GAS u32x4*)(H + (size_t)row * ldh + col0) = w; }
    }
};
struct EpiProj {
    static constexpr bool PERM = true, AFTER_DRAIN = false;
    PG8_GAS bf16_t* OA; int ldA; int ntA; PG8_GAS bf16_t* OB; int ldB; int tpB; size_t strideB; const PG8_GAS ssq_t* ssq; PG8_GAS float* kmean; int kt0;
    __device__ __forceinline__ void operator()(const f32x4 (&acc)[2][2][4][2], const Unit& u, int wr, int wc, int fr, int fq) const {
        const int row0 = u.pm * BM + wr * 64 + fr; PG8_GAS bf16_t* base; int ld, colt; f32x4 cs[2][2]; const bool km = kmean != nullptr && (unsigned)(u.pn - kt0) < 2u;
#pragma unroll
        for (int bj = 0; bj < 2; ++bj) { cs[bj][0] = (f32x4){0.f, 0.f, 0.f, 0.f}; cs[bj][1] = cs[bj][0]; }
        if (u.pn < ntA) { base = OA; ld = ldA; colt = u.pn * BM; } else { const int q = u.pn - ntA, t = q / tpB; base = OB + (size_t)t * strideB; ld = ldB; colt = (q - t * tpB) * BM; }
        const int col0 = colt + wc * 32 + 8 * fq; ssq_t rsv[2][4];
#pragma unroll
        for (int ai = 0; ai < 2; ++ai)
#pragma unroll
            for (int m = 0; m < 4; ++m) rsv[ai][m] = ssq[row0 + ai * HALF + m * 16];
#pragma unroll
        for (int ai = 0; ai < 2; ++ai)
#pragma unroll
            for (int m = 0; m < 4; ++m) { const int row = row0 + ai * HALF + m * 16; const float rs = ssq_to_rstd(rsv[ai][m]); PG8_GAS bf16_t* rowp = base + (size_t)row * ld + col0;
#pragma unroll
                for (int bj = 0; bj < 2; ++bj) { const f32x4 v0 = acc[ai][bj][m][0] * rs, v1 = acc[ai][bj][m][1] * rs; cs[bj][0] += v0; cs[bj][1] += v1;
                    u32x4 w; w.x = cvt_pk_bf16(v0[0], v0[1]); w.y = cvt_pk_bf16(v0[2], v0[3]); w.z = cvt_pk_bf16(v1[0], v1[1]); w.w = cvt_pk_bf16(v1[2], v1[3]);
                    *(PG8_GAS u32x4*)(rowp + bj * HALF) = w; } }
        if (km) {
            const int ck0 = (u.pn - kt0) * BM + wc * 32 + 8 * fq; PG8_GAS float* kb = kmean + (size_t)((u.pm >> 3) * 8) * 8 * 64 + (size_t)(u.pm & 7) * 64;
#pragma unroll
            for (int bj = 0; bj < 2; ++bj)
#pragma unroll
                for (int n = 0; n < 2; ++n)
#pragma unroll
                    for (int e = 0; e < 4; ++e) { float v = cs[bj][n][e]; v += __shfl_xor(v, 1); v += __shfl_xor(v, 2); v += __shfl_xor(v, 4); v += __shfl_xor(v, 8);
                        if (fr == 0) { const int ck = ck0 + bj * HALF + 4 * n + e; __builtin_amdgcn_global_atomic_fadd_f32(kb + (size_t)(ck >> 6) * 8 * 64 + (ck & 63), v * (1.0f / 256.0f)); } } }
    }
};
struct EpiResid {
    static constexpr bool PERM = false, AFTER_DRAIN = false;
    PG8_GAS bf16_t* XB; PG8_GAS ssq_t* ssq; float alpha;
    __device__ __forceinline__ void operator()(const f32x4 (&acc)[2][2][4][2], const Unit& u, int wr, int wc, int fr, int fq) const {
        typedef unsigned u32x2v __attribute__((ext_vector_type(2)));
        const int row0 = u.pm * BM + wr * 64 + fr, col0 = u.pn * BM + wc * 32 + 4 * fq;
        u32x2v bcur[2][2], bnxt[2][2];
#pragma unroll
        for (int bj = 0; bj < 2; ++bj)
#pragma unroll
            for (int n = 0; n < 2; ++n) bcur[bj][n] = *(const PG8_GAS u32x2v*)(XB + (size_t)row0 * 1024 + col0 + bj * HALF + n * 16);
#pragma unroll
        for (int g = 0; g < 8; ++g) { const int ai = g >> 2, m = g & 3; const int row = row0 + ai * HALF + m * 16; const size_t off = (size_t)row * 1024 + col0; float ss = 0.f;
            if (g < 7) { const int rown = row0 + ((g + 1) >> 2) * HALF + ((g + 1) & 3) * 16;
#pragma unroll
                for (int bj = 0; bj < 2; ++bj)
#pragma unroll
                    for (int n = 0; n < 2; ++n) bnxt[bj][n] = *(const PG8_GAS u32x2v*)(XB + (size_t)rown * 1024 + col0 + bj * HALF + n * 16); }
#pragma unroll
            for (int bj = 0; bj < 2; ++bj)
#pragma unroll
                for (int n = 0; n < 2; ++n) { const u32x2v bw = bcur[bj][n];
                    const f32x4 b = (f32x4){__builtin_bit_cast(float, bw.x << 16), __builtin_bit_cast(float, bw.x & 0xffff0000u), __builtin_bit_cast(float, bw.y << 16), __builtin_bit_cast(float, bw.y & 0xffff0000u)};
                    const f32x4 o = b + acc[ai][bj][m][n] * alpha; u32x2v w; w.x = cvt_pk_bf16(o[0], o[1]); w.y = cvt_pk_bf16(o[2], o[3]); *(PG8_GAS u32x2v*)(XB + off + bj * HALF + n * 16) = w;
                    const float r0 = __builtin_bit_cast(float, w.x << 16), r1 = __builtin_bit_cast(float, w.x & 0xffff0000u), r2 = __builtin_bit_cast(float, w.y << 16), r3 = __builtin_bit_cast(float, w.y & 0xffff0000u);
                    ss += (r0 * r0 + r1 * r1) + (r2 * r2 + r3 * r3); }
            ss += __shfl_xor(ss, 16); ss += __shfl_xor(ss, 32);
            if (fq == 0 && alpha != 0.f) __hip_atomic_fetch_add(ssq + row, ssq_fix(ss), __ATOMIC_RELAXED, __HIP_MEMORY_SCOPE_AGENT);
#pragma unroll
            for (int bj = 0; bj < 2; ++bj)
#pragma unroll
                for (int n = 0; n < 2; ++n) bcur[bj][n] = bnxt[bj][n];
            asm volatile("" ::: "memory"); }
    }
};

template <class Epi, class Sched, bool ALIGN_EPI = false, bool SP2 = false>
__device__ __forceinline__ void gemm_phase(PG8_LAS unsigned char* lds, const Gemm g, const Sched& S, const Epi& E) {
    int tid_l = threadIdx.x; asm volatile("" : "+v"(tid_l));
    const int tid = tid_l, wid = __builtin_amdgcn_readfirstlane(tid >> 6), lane = tid & 63, wr = wid >> 2, wc = wid & 3, fr = lane & 15, fq = lane >> 4;
    const int K = g.K, nt = K / BK;
    unsigned voffA[2], voffB[2];
#pragma unroll
    for (int i = 0; i < 2; ++i) { int R, C; stage_rc(tid * 16 + i * 8192, R, C); const int Rb = Epi::PERM ? ((R & ~31) + perm32(R & 31)) : R;
        voffA[i] = (unsigned)(R * K + C) * 2u; voffB[i] = (unsigned)(Rb * K + C) * 2u; }
    const size_t kstep = (size_t)(BK * 2);
    const size_t hstep = (size_t)HALF * K * 2;
    const size_t tstep = 2 * hstep;
    const unsigned ldsw = (unsigned)wid * 1024u;
    const int aoff = lds_byte(wr * 64 + fr, fq * 8), boff = lds_byte(wc * 32 + fr, fq * 8);
#define PG8_SA(b, h) (((b) * 2 + (h)) * HTB)
#define PG8_SB(b, h) ((4 + (b) * 2 + (h)) * HTB)
#define PG8_STAGE(bufoff, gbase, voff) do { _Pragma("unroll") for (int _i = 0; _i < 2; ++_i) \
        __builtin_amdgcn_global_load_lds((const unsigned*)((const char*)(gbase) + (voff)[_i]), (PG8_LAS unsigned*)(lds + (bufoff) + ldsw + _i * 8192), 16, 0, 0); } while (0)
#define PG8_LDA(dst, b, h) do { _Pragma("unroll") for (int m = 0; m < 4; ++m) _Pragma("unroll") for (int k = 0; k < 2; ++k) dst[m][k] = *(const PG8_LAS bf16x8*)(lds + PG8_SA(b, h) + aoff + m * 2048 + k * 1024); } while (0)
#define PG8_LDB(dst, b, h) do { _Pragma("unroll") for (int n = 0; n < 2; ++n) _Pragma("unroll") for (int k = 0; k < 2; ++k) dst[n][k] = *(const PG8_LAS bf16x8*)(lds + PG8_SB(b, h) + boff + n * 2048 + k * 1024); } while (0)
#define PG8_MMA(ai, bj, At, Bt) do { __builtin_amdgcn_s_setprio(1); _Pragma("unroll") for (int m = 0; m < 4; ++m) _Pragma("unroll") for (int n = 0; n < 2; ++n) _Pragma("unroll") for (int k = 0; k < 2; ++k) \
        acc[ai][bj][m][n] = __builtin_amdgcn_mfma_f32_16x16x32_bf16(Bt[n][k], At[m][k], acc[ai][bj][m][n], 0, 0, 0); __builtin_amdgcn_s_setprio(0); } while (0)
#define PG8_WAIT_V(n) asm volatile("s_waitcnt vmcnt(" #n ")" ::: "memory")
#define PG8_WAIT_L(n) asm volatile("s_waitcnt lgkmcnt(" #n ")" ::: "memory")
#define PG8_BAR __builtin_amdgcn_s_barrier()
#define PG8_SCHED __builtin_amdgcn_sched_barrier(0)
    Unit cur, nxt; int ui = 0;
    if (!S.next(0, cur)) return;
    f32x4 acc[2][2][4][2];
#pragma unroll
    for (int a = 0; a < 2; ++a)
#pragma unroll
        for (int b = 0; b < 2; ++b)
#pragma unroll
            for (int m = 0; m < 4; ++m)
#pragma unroll
                for (int n = 0; n < 2; ++n) acc[a][b][m][n] = (f32x4){0.f, 0.f, 0.f, 0.f};
    bf16x8 At[4][2], B0[2][2], B1[2][2];
    const char* cA = (const char*)g.A + (size_t)cur.pm * tstep; const char* cB = (const char*)g.Bt + (size_t)cur.pn * tstep;
    S.a_ready(cur);
    if constexpr (SP2) {
        PG8_STAGE(PG8_SB(0, 0), cB, voffB); PG8_STAGE(PG8_SB(0, 1), cB + hstep, voffB); PG8_STAGE(PG8_SA(0, 0), cA, voffA); PG8_STAGE(PG8_SA(0, 1), cA + hstep, voffA);
        if (wr == 1) PG8_BAR;
        PG8_WAIT_V(2); PG8_BAR;
        PG8_STAGE(PG8_SB(1, 0), cB + kstep, voffB); PG8_STAGE(PG8_SA(1, 0), cA + kstep, voffA); PG8_STAGE(PG8_SB(1, 1), cB + hstep + kstep, voffB);
        PG8_WAIT_V(6); PG8_BAR;
    } else {
        PG8_STAGE(PG8_SB(0, 0), cB, voffB); PG8_STAGE(PG8_SA(0, 0), cA, voffA); PG8_STAGE(PG8_SB(0, 1), cB + hstep, voffB); PG8_STAGE(PG8_SA(0, 1), cA + hstep, voffA);
        if (wr == 1) PG8_BAR;
        PG8_WAIT_V(4); PG8_BAR;
        PG8_STAGE(PG8_SB(1, 0), cB + kstep, voffB); PG8_STAGE(PG8_SA(1, 0), cA + kstep, voffA); PG8_STAGE(PG8_SB(1, 1), cB + hstep + kstep, voffB);
        PG8_WAIT_V(6); PG8_BAR;
    }
    for (;;) {
        const bool has_next = S.next(ui + 1, nxt);
        const char* nA = has_next ? (const char*)g.A + (size_t)nxt.pm * tstep : cA; const char* nB = has_next ? (const char*)g.Bt + (size_t)nxt.pn * tstep : cB;
        for (int t = 0; t < nt; t += 2) {
            const bool last = (t == nt - 2);
            const char* a1 = cA + (size_t)(t + 1) * kstep;
            const char* a2 = last ? nA : cA + (size_t)(t + 2) * kstep; const char* b2 = last ? nB : cB + (size_t)(t + 2) * kstep;
            const char* a3 = a2 + kstep; const char* b3 = b2 + kstep;
            if (last && has_next) S.a_ready(nxt);
            if constexpr (SP2) {
            PG8_LDB(B0, 0, 0); PG8_LDB(B1, 0, 1); PG8_SCHED; PG8_LDA(At, 0, 0); PG8_STAGE(PG8_SA(1, 1), a1 + hstep, voffA);
            PG8_WAIT_V(8); PG8_WAIT_L(0); PG8_BAR; PG8_MMA(0, 0, At, B0); PG8_MMA(0, 1, At, B1); PG8_BAR; PG8_SCHED;
            PG8_LDA(At, 0, 1); PG8_STAGE(PG8_SB(0, 0), b2, voffB); PG8_STAGE(PG8_SB(0, 1), b2 + hstep, voffB); PG8_STAGE(PG8_SA(0, 0), a2, voffA);
            PG8_WAIT_V(8); PG8_WAIT_L(0); PG8_BAR; PG8_MMA(1, 0, At, B0); PG8_MMA(1, 1, At, B1); PG8_BAR; PG8_SCHED;
            PG8_LDB(B0, 1, 0); PG8_LDB(B1, 1, 1); PG8_SCHED; PG8_LDA(At, 1, 0); PG8_STAGE(PG8_SA(0, 1), a2 + hstep, voffA);
            PG8_WAIT_V(8); PG8_WAIT_L(0); PG8_BAR; PG8_MMA(0, 0, At, B0); PG8_MMA(0, 1, At, B1); PG8_BAR; PG8_SCHED;
            PG8_LDA(At, 1, 1); PG8_STAGE(PG8_SB(1, 0), b3, voffB); PG8_STAGE(PG8_SB(1, 1), b3 + hstep, voffB); PG8_STAGE(PG8_SA(1, 0), a3, voffA);
            PG8_WAIT_V(8); PG8_WAIT_L(0); PG8_BAR; PG8_MMA(1, 0, At, B0); PG8_MMA(1, 1, At, B1); PG8_BAR; PG8_SCHED;
            } else {
            PG8_LDB(B0, 0, 0); PG8_SCHED; PG8_LDA(At, 0, 0); PG8_STAGE(PG8_SA(1, 1), a1 + hstep, voffA);
            PG8_WAIT_L(8); PG8_BAR; PG8_WAIT_L(0); PG8_MMA(0, 0, At, B0); PG8_BAR; PG8_SCHED;
            PG8_LDB(B1, 0, 1); PG8_STAGE(PG8_SB(0, 0), b2, voffB);
            PG8_BAR; PG8_WAIT_L(0); PG8_MMA(0, 1, At, B1); PG8_BAR;
            PG8_LDA(At, 0, 1); PG8_STAGE(PG8_SA(0, 0), a2, voffA);
            PG8_BAR; PG8_WAIT_L(0); PG8_MMA(1, 0, At, B0); PG8_BAR; PG8_SCHED;
            PG8_STAGE(PG8_SB(0, 1), b2 + hstep, voffB);
            PG8_WAIT_V(6); PG8_BAR; PG8_MMA(1, 1, At, B1); PG8_BAR;
            PG8_LDB(B0, 1, 0); PG8_SCHED; PG8_LDA(At, 1, 0); PG8_STAGE(PG8_SA(0, 1), a2 + hstep, voffA);
            PG8_WAIT_L(8); PG8_BAR; PG8_WAIT_L(0); PG8_MMA(0, 0, At, B0); PG8_BAR; PG8_SCHED;
            PG8_LDB(B1, 1, 1); PG8_STAGE(PG8_SB(1, 0), b3, voffB);
            PG8_BAR; PG8_WAIT_L(0); PG8_MMA(0, 1, At, B1); PG8_BAR;
            PG8_LDA(At, 1, 1); PG8_STAGE(PG8_SA(1, 0), a3, voffA);
            PG8_BAR; PG8_WAIT_L(0); PG8_MMA(1, 0, At, B0); PG8_BAR; PG8_SCHED;
            PG8_STAGE(PG8_SB(1, 1), b3 + hstep, voffB);
            PG8_WAIT_V(6); PG8_BAR; PG8_MMA(1, 1, At, B1); PG8_BAR;
            }
        }
        if constexpr (ALIGN_EPI) { if (wr == 0) PG8_BAR; }
        if constexpr (!Epi::AFTER_DRAIN) { E(acc, cur, wr, wc, fr, fq); S.done(cur); }
        if (!has_next) break;
#pragma unroll
        for (int a = 0; a < 2; ++a)
#pragma unroll
            for (int b = 0; b < 2; ++b)
#pragma unroll
                for (int m = 0; m < 4; ++m)
#pragma unroll
                    for (int n = 0; n < 2; ++n) acc[a][b][m][n] = (f32x4){0.f, 0.f, 0.f, 0.f};
        cur = nxt; cA = nA; cB = nB; ++ui;
        if constexpr (ALIGN_EPI) { if (wr == 1) PG8_BAR; }
    }
    PG8_WAIT_V(0);
    if constexpr (!ALIGN_EPI) { if (wr == 0) PG8_BAR; }
    PG8_BAR;
    if constexpr (Epi::AFTER_DRAIN) { E.fused(acc, cur, wr, wc, fr, fq, lds, wid, lane); S.done(cur); }
#undef PG8_SA
#undef PG8_SB
#undef PG8_STAGE
#undef PG8_LDA
#undef PG8_LDB
#undef PG8_MMA
#undef PG8_WAIT_V
#undef PG8_WAIT_L
#undef PG8_BAR
#undef PG8_SCHED
}
}

#define GAS __attribute__((address_space(1)))
#define LAS __attribute__((address_space(3)))
typedef unsigned short bf16;
typedef unsigned v4u __attribute__((ext_vector_type(4)));
typedef float f32x4 __attribute__((ext_vector_type(4)));
typedef short bf16x8 __attribute__((ext_vector_type(8)));
typedef GAS unsigned gu32;
typedef GAS unsigned long long gu64;
#define RLX_AGENT __ATOMIC_RELAXED, __HIP_MEMORY_SCOPE_AGENT
#define LDS_WAIT() asm volatile("s_waitcnt lgkmcnt(0)" ::: "memory")
#define VM_WAIT() asm volatile("s_waitcnt vmcnt(0)" ::: "memory")
__device__ __forceinline__ unsigned long long rt() { return __builtin_amdgcn_s_memrealtime(); }
typedef float f32x2_t __attribute__((ext_vector_type(2))); typedef __bf16 bf16x2_t __attribute__((ext_vector_type(2)));
__device__ __forceinline__ unsigned pk2(float lo, float hi) { const f32x2_t v = {lo, hi}; return __builtin_bit_cast(unsigned, __builtin_convertvector(v, bf16x2_t)); }
__device__ __forceinline__ unsigned f2bf(float f) { return pk2(f, f) & 0xffffu; }
#define XB_TMO      128
#define XB_XCNT(j)  (256  + 64 * (j))
#define XB_XSUB(j)  (1280 + 64 * (j))
#define XB_XGEN(j)  (2304 + 64 * (j))
#define XB_TOP      3328
#define XB_TOPGEN   3392
#define XCD_BAR_WORDS 3456
#define XB_SPIN_CAP (1u << 18)

__device__ __forceinline__ unsigned xb_ld(unsigned* p)              { return __hip_atomic_load(p, __ATOMIC_RELAXED, __HIP_MEMORY_SCOPE_AGENT); }
__device__ __forceinline__ unsigned xb_add(unsigned* p, unsigned v) { return __hip_atomic_fetch_add(p, v, __ATOMIC_RELAXED, __HIP_MEMORY_SCOPE_AGENT); }
__device__ __forceinline__ unsigned xb_xcc_id() { return (unsigned)__builtin_amdgcn_s_getreg((3 << 11) | 20) & 0xFu; }
#define XB_SPIN(cond, bar) do { unsigned _sp = 0; while (cond) { __builtin_amdgcn_s_sleep(1); \
    if ((++_sp & 255u) == 0u) { if (xb_ld(&(bar)[XB_TMO])) break; if (_sp > XB_SPIN_CAP) { atomicAdd(&(bar)[XB_TMO], 1u); break; } } } } while (0)

struct XcdBarrier {
    unsigned* bar; unsigned x;
    volatile LAS unsigned* st;
};

__device__ __forceinline__ XcdBarrier xcd_barrier_post(unsigned* bar, volatile LAS unsigned* st) {
    XcdBarrier b; b.bar = bar; b.x = xb_xcc_id(); b.st = st;
    if (threadIdx.x == 0) (void)xb_add(&bar[XB_XCNT(b.x)], 1u);
    return b;
}
__device__ __forceinline__ void xcd_barrier_complete(unsigned* bar, unsigned x, unsigned& nloc, unsigned& nx) {
    const unsigned G = gridDim.x * gridDim.y * gridDim.z;
    unsigned sum, cnt, mine, sp = 0u;
    for (;;) {
        sum = 0u; cnt = 0u; mine = 0u;
#pragma unroll 1
        for (unsigned j = 0; j < 16; ++j) { const unsigned c = xb_ld(&bar[XB_XCNT(j)]); sum += c; cnt += (c > 0u) ? 1u : 0u; mine = (j == x) ? c : mine; }
        if (sum == G) break;
        __builtin_amdgcn_s_sleep(1);
        if ((++sp & 255u) == 0u) { if (xb_ld(&bar[XB_TMO])) break; if (sp > XB_SPIN_CAP) { atomicAdd(&bar[XB_TMO], 1u); break; } }
    }
    nloc = mine > 0u ? mine : 1u; nx = cnt > 0u ? cnt : 1u;
}

__device__ __forceinline__ void xcd_barrier(const XcdBarrier& b) {
    asm volatile("s_waitcnt vmcnt(0)" ::: "memory");
    __syncthreads();
    if (threadIdx.x == 0) {
        unsigned* bar = b.bar;
        __builtin_amdgcn_s_waitcnt(0);
        unsigned nloc = b.st[0], nx = b.st[1];
        if (nloc == 0u) { xcd_barrier_complete(bar, b.x, nloc, nx); b.st[0] = nloc; b.st[1] = nx; }
        const unsigned old = xb_add(&bar[XB_XSUB(b.x)], 1u);
        const unsigned gen = old / nloc;
        if (old + 1u == (gen + 1u) * nloc) {
            __builtin_amdgcn_fence(__ATOMIC_RELEASE, "agent");
            asm volatile("s_waitcnt vmcnt(0)" ::: "memory");
            const unsigned og = xb_add(&bar[XB_TOP], 1u);
            const unsigned tg = og / nx;
            if (og + 1u == (tg + 1u) * nx) xb_add(&bar[XB_TOPGEN], 1u);
            else XB_SPIN(xb_ld(&bar[XB_TOPGEN]) == tg, bar);
            __builtin_amdgcn_fence(__ATOMIC_ACQUIRE, "agent");
            xb_add(&bar[XB_XGEN(b.x)], 1u);
            asm volatile("s_waitcnt vmcnt(0)" ::: "memory");
        } else {
            XB_SPIN(xb_ld(&bar[XB_XGEN(b.x)]) == gen, bar);
            __builtin_amdgcn_fence(__ATOMIC_ACQUIRE, "agent");
            asm volatile("s_waitcnt vmcnt(0)" ::: "memory");
        }
    }
    __syncthreads();
}
constexpr int BATCH = 8, SEQ = 2048, D = 1024, M = BATCH * SEQ, FF = 2816;
constexpr int RW_COLS = 1792, EV_IN = 3328, OD_IN = 4096;
constexpr int NWAVES = 8, NTHREADS = NWAVES * 64;
constexpr int N_IN = 26;
constexpr size_t MiB = 1u << 20;
constexpr size_t WS_CTL = 0, CTL_ZERO_BYTES = 3 * MiB;
constexpr size_t OS_HSS = 32 * MiB;
constexpr size_t OS_WC = 56 * MiB;
constexpr size_t OS_IKH = 0, OS_IRH = 40 * MiB, WS_IAH = 36 * MiB, WS_IKT_LO = 3 * MiB, WS_IKT_HI = 48 * MiB;
constexpr size_t OS_RN = 36 * MiB;
constexpr size_t OS_RST = 33 * MiB, OS_ZERO_BEGIN = 32 * MiB, OS_ZERO_BYTES = 3 * MiB;
constexpr size_t WS_SSQ = 2 * MiB;
#define SSQ_SLOT(k) WSP(pg8::ssq_t, WS_SSQ + (size_t)(k) * M * 8)
constexpr size_t WS_W = 3 * MiB;
constexpr size_t W_UP_BYTES = (size_t)2 * FF * D * 2, W_DN_BYTES = (size_t)D * FF * 2;
constexpr size_t WS_WUP = WS_W, WS_WDN = WS_WUP + 4 * W_UP_BYTES, WS_WEVIN = WS_WDN + 4 * W_DN_BYTES, WS_WEVOUT = WS_WEVIN + (size_t)EV_IN * D * 2,
                 WS_WODIN = WS_WEVOUT + (size_t)D * D * 2, WS_WODOUT = WS_WODIN + (size_t)OD_IN * D * 2, WS_WEND = WS_WODOUT + (size_t)D * D * 2;
constexpr size_t WS_KMEAN = 128 * 1024;
constexpr size_t WS_LW2 = 88 * MiB - 512 * 1024, WS_LA2 = WS_LW2 + 64 * 1024, WS_LG2 = WS_LA2 + 64 * 1024;
constexpr size_t WS_XB = 88 * MiB;
constexpr size_t WS_H = 120 * MiB;
constexpr size_t WS_PR = 120 * MiB, WS_QB = 176 * MiB, WS_KB = 192 * MiB, WS_VB = 208 * MiB, WS_Y = 224 * MiB;
constexpr size_t OS_RE = 0, OS_RA = 16 * MiB, WS_YRAW = WS_QB;
constexpr size_t WS_GM = WS_KB;
constexpr size_t WS_HQ = 120 * MiB, WS_HF = 152 * MiB, WS_HI = 184 * MiB, WS_HG = 216 * MiB;
constexpr size_t OS_KT2 = 0;
constexpr size_t WS_RB = 248 * MiB;
constexpr size_t WS_DRY = 250 * MiB;
constexpr size_t WS_END = 256 * MiB;
static_assert(WS_WEND <= WS_LW2 && WS_LG2 + 128 * 1024 <= WS_XB && WS_H + (size_t)M * FF * 2 <= WS_Y + 0 * MiB + 32 * MiB && WS_PR + (size_t)M * RW_COLS * 2 <= WS_QB && WS_Y + (size_t)M * D * 2 <= WS_END && WS_HG + (size_t)M * D * 2 <= WS_END, "d_ws map");
constexpr int CW_BAR = 4096;
constexpr int RING_BYTES = 131072, LDSCTL_OFF = RING_BYTES, MISC_OFF = LDSCTL_OFF + 320, LDS_BYTES = 147456;

__device__ __forceinline__ float bf2f(bf16 v) { return __builtin_bit_cast(float, (unsigned)v << 16); }
__device__ __forceinline__ float sigm(float x) { return 1.0f / (1.0f + __expf(-x)); }
__device__ __forceinline__ float sigmf(float x) { return __builtin_amdgcn_rcpf(1.0f + __builtin_amdgcn_exp2f(-1.4426950408889634f * x)); }
__device__ __forceinline__ float wave_sum(float v) {
#pragma unroll
    for (int o = 1; o < 64; o <<= 1) v += __shfl_xor(v, o);
    return v;
}
__device__ __forceinline__ float wave_max(float v) {
#pragma unroll
    for (int o = 1; o < 64; o <<= 1) v = fmaxf(v, __shfl_xor(v, o));
    return v;
}

typedef float f32x4v __attribute__((ext_vector_type(4)));
typedef float f32x16 __attribute__((ext_vector_type(16)));
typedef unsigned v2u __attribute__((ext_vector_type(2)));
typedef float v2f __attribute__((ext_vector_type(2)));
#define LDS_BARRIER() do { asm volatile("s_waitcnt lgkmcnt(0)" ::: "memory"); __builtin_amdgcn_s_barrier(); asm volatile("" ::: "memory"); } while (0)
__device__ __forceinline__ long long fx20(float v) { return (long long)llrintf(v * 1073741824.0f); }
__device__ __forceinline__ float unfx20(long long v) { return (float)v * (1.0f / 1073741824.0f); }
struct Frame {
    LAS unsigned char* lds; volatile LAS unsigned* MISC; gu32* ctl;
    int tid, lane, wave, vcu, G;
    GAS float* out; GAS unsigned char* ws;
};
#define WSP(T, off) ((GAS T*)(F.ws + (off)))
#define OSP(T, off) ((GAS T*)((GAS unsigned char*)F.out + (off)))
constexpr int PTAB_OFF = LDSCTL_OFF + 1024;
__device__ __forceinline__ const GAS float* inp(const Frame& F, int i) {
    const unsigned long long v = ((const LAS unsigned long long*)(F.lds + PTAB_OFF))[i];
    const unsigned lo = __builtin_amdgcn_readfirstlane((unsigned)v), hi = __builtin_amdgcn_readfirstlane((unsigned)(v >> 32));
    return (const GAS float*)(((unsigned long long)hi << 32) | lo);
}
__device__ __forceinline__ bool in_range(int k, int lo, int hi) { asm volatile("" : "+s"(lo), "+s"(hi)); return lo <= k && k < hi; }
#define PHASE_FRAME(FP) Frame FP = F0; asm volatile("" : "+v"(FP.tid), "+v"(FP.lane)); asm volatile("" : "+s"(FP.wave), "+s"(FP.vcu), "+s"(FP.G), "+s"(FP.ws), "+s"(FP.out))
struct Args { const float* in[N_IN]; float* out; unsigned char* ws; int ph_lo, ph_hi, li, pad; };

__device__ __forceinline__ void transpose_item(const GAS float* W, int K, int N, const GAS float* gain, GAS bf16* WT, int mode, LAS float* scr, int item, int lane) {
    const int nblk = N / 32, kb = item / nblk, nb = item % nblk, k0 = 64 * kb, n0 = 32 * nb;
    float wv[32];
#pragma unroll
    for (int i = 0; i < 32; ++i) wv[i] = W[(size_t)(k0 + 2 * i + (lane >> 5)) * N + n0 + (lane & 31)];
    if (gain) { const float g0 = gain[k0 + lane];
#pragma unroll
        for (int i = 0; i < 32; ++i) wv[i] *= __shfl(g0, 2 * i + (lane >> 5)); }
#pragma unroll
    for (int i = 0; i < 32; ++i) scr[(2 * i + (lane >> 5)) * 33 + (lane & 31)] = wv[i];
    LDS_WAIT(); asm volatile("" ::: "memory");
    const int c = lane & 7; const int rbase = (mode == 0) ? n0 : (n0 + 128 * (n0 >> 7) + (mode == 2 ? 128 : 0));
#pragma unroll
    for (int j = 0; j < 4; ++j) { const int n = (lane >> 3) + 8 * j; const LAS float* s = scr + (8 * c) * 33 + n;
        v4u o; o.x = pk2(s[0 * 33], s[1 * 33]); o.y = pk2(s[2 * 33], s[3 * 33]); o.z = pk2(s[4 * 33], s[5 * 33]); o.w = pk2(s[6 * 33], s[7 * 33]);
        *(GAS v4u*)(WT + (size_t)(rbase + n) * K + k0 + 8 * c) = o; }
    LDS_WAIT(); asm volatile("" ::: "memory");
}
constexpr int I_FF = (D / 64) * (FF / 32), I_EVIN = (D / 64) * (EV_IN / 32), I_OUT = (D / 64) * (D / 32), I_ODIN = (D / 64) * (OD_IN / 32);
constexpr int CV_G1 = 2 * I_FF, CV_G2 = CV_G1 + I_FF + I_EVIN + I_OUT, CV_G3 = CV_G2 + 4 * I_FF, CV_G4 = CV_G3 + 2 * I_FF + I_OUT + I_ODIN / 2, CV_G5 = CV_G4 + I_ODIN / 2 + 2 * I_FF, CV_END = CV_G5 + I_FF;
static_assert(CV_END == 12 * I_FF + I_EVIN + 2 * I_OUT + I_ODIN, "conversion item count");
__device__ __forceinline__ void convert_ffn(Frame& F, int f, int which  , int item, LAS float* scr) {
    const int l = f >> 1, second = f & 1; const GAS float* gain = inp(F, 1) + (size_t)(l * 3 + (second ? 2 : 0)) * D;
    if (which == 0) transpose_item((second ? inp(F, 5) : inp(F, 2)) + (size_t)l * D * FF, D, FF, gain, WSP(bf16, WS_WUP + f * W_UP_BYTES), 1, scr, item, F.lane);
    else if (which == 1) transpose_item((second ? inp(F, 6) : inp(F, 3)) + (size_t)l * D * FF, D, FF, gain, WSP(bf16, WS_WUP + f * W_UP_BYTES), 2, scr, item, F.lane);
    else transpose_item((second ? inp(F, 7) : inp(F, 4)) + (size_t)l * FF * D, FF, D, nullptr, WSP(bf16, WS_WDN + f * W_DN_BYTES), 0, scr, item, F.lane);
}
__device__ __forceinline__ void convert_items(Frame& F, int first, int last, int rank, int nranks) {
    LAS float* scr = (LAS float*)(F.lds + F.wave * 16384);
    for (int it = first + rank; it < last; it += nranks) {
        int r = it;
        if (r < CV_G1) { convert_ffn(F, 0, r / I_FF, r % I_FF, scr); continue; } r -= CV_G1;
        if (r < I_FF) { convert_ffn(F, 0, 2, r, scr); continue; } r -= I_FF;
        if (r < I_EVIN) { transpose_item(inp(F, 8), D, EV_IN, inp(F, 1) + 1 * D, WSP(bf16, WS_WEVIN), 0, scr, r, F.lane); continue; } r -= I_EVIN;
        if (r < I_OUT) { transpose_item(inp(F, 9), D, D, nullptr, WSP(bf16, WS_WEVOUT), 0, scr, r, F.lane); continue; } r -= I_OUT;
        if (r < 3 * I_FF) { convert_ffn(F, 1, r / I_FF, r % I_FF, scr); continue; } r -= 3 * I_FF;
        if (r < 2 * I_FF) { convert_ffn(F, 2, r / I_FF, r % I_FF, scr); continue; } r -= 2 * I_FF;
        if (r < I_FF) { convert_ffn(F, 2, 2, r, scr); continue; } r -= I_FF;
        if (r < I_OUT) { transpose_item(inp(F, 22), D, D, nullptr, WSP(bf16, WS_WODOUT), 0, scr, r, F.lane); continue; } r -= I_OUT;
        if (r < I_ODIN) { transpose_item(inp(F, 21), D, OD_IN, inp(F, 1) + 4 * D, WSP(bf16, WS_WODIN), 0, scr, r, F.lane); continue; } r -= I_ODIN;
        convert_ffn(F, 3, r / I_FF, r % I_FF, scr);
    }
}
__device__ __forceinline__ void prologue_phase(Frame& F) {
    const int gw = F.vcu * NWAVES + F.wave, NGW = F.G * NWAVES;
    convert_items(F, 0, CV_G1, gw, NGW);
    {
        const GAS float* w2 = inp(F, 12); const GAS float* a2 = inp(F, 14); const GAS float* g2 = inp(F, 15); GAS bf16* lw = WSP(bf16, WS_LW2); GAS bf16* la = WSP(bf16, WS_LA2); GAS bf16* lg = WSP(bf16, WS_LG2);
        for (int i = gw * 64 + F.lane; i < 512 * 64; i += NGW * 64) { const int n = i >> 6, k = i & 63; lw[i] = (bf16)f2bf(w2[k * 512 + n]); la[i] = (bf16)f2bf(a2[k * 512 + n]); }
        for (int i = gw * 64 + F.lane; i < 512 * 128; i += NGW * 64) { const int n = i >> 7, k = i & 127; lg[i] = (bf16)f2bf(g2[k * 512 + n]); } }
    const GAS float* x = inp(F, 0); GAS bf16* XB = WSP(bf16, WS_XB); GAS pg8::ssq_t* ssq = SSQ_SLOT(0);
    for (int m = gw; m < M; m += NGW) {
        const GAS f32x4* xr = (const GAS f32x4*)(x + (size_t)m * D) + F.lane; f32x4 v[4]; float s = 0.f;
#pragma unroll
        for (int j = 0; j < 4; ++j) { v[j] = xr[64 * j]; s += (v[j].x * v[j].x + v[j].y * v[j].y) + (v[j].z * v[j].z + v[j].w * v[j].w); }
        s = wave_sum(s);
        GAS unsigned long long* o8 = (GAS unsigned long long*)(XB + (size_t)m * D) + F.lane;
#pragma unroll
        for (int j = 0; j < 4; ++j) o8[64 * j] = (unsigned long long)pk2(v[j].x, v[j].y) | ((unsigned long long)pk2(v[j].z, v[j].w) << 32);
        if (F.lane == 0) ssq[m] = pg8::ssq_fix(s);
    }
}

__device__ __forceinline__ float dpp_add16(float v) {
    v += __builtin_bit_cast(float, __builtin_amdgcn_mov_dpp(__builtin_bit_cast(int, v), 0xB1, 0xF, 0xF, true));
    v += __builtin_bit_cast(float, __builtin_amdgcn_mov_dpp(__builtin_bit_cast(int, v), 0x4E, 0xF, 0xF, true));
    v += __builtin_bit_cast(float, __builtin_amdgcn_mov_dpp(__builtin_bit_cast(int, v), 0x141, 0xF, 0xF, true));
    v += __builtin_bit_cast(float, __builtin_amdgcn_mov_dpp(__builtin_bit_cast(int, v), 0x140, 0xF, 0xF, true));
    return v;
}
__device__ __forceinline__ float bflo(unsigned w) { return __builtin_bit_cast(float, w << 16); }
__device__ __forceinline__ float bfhi(unsigned w) { return __builtin_bit_cast(float, w & 0xffff0000u); }
__device__ __forceinline__ float bfel(const v4u v, int e) { const unsigned w = (e >> 1) == 0 ? v.x : (e >> 1) == 1 ? v.y : (e >> 1) == 2 ? v.z : v.w; return (e & 1) ? bfhi(w) : bflo(w); }
__device__ __forceinline__ void unpack8(const v4u v, float (&o)[8]) { o[0] = bflo(v.x); o[1] = bfhi(v.x); o[2] = bflo(v.y); o[3] = bfhi(v.y); o[4] = bflo(v.z); o[5] = bfhi(v.z); o[6] = bflo(v.w); o[7] = bfhi(v.w); }
constexpr int LO_PITCH = 528;
__device__ __forceinline__ void rwkv_lora_unit(Frame& F, int u) {
    const int tid = F.tid, lane = F.lane, w = F.wave, r16 = lane & 15, g4 = lane >> 4; LAS unsigned char* L = F.lds;
    const GAS bf16* PR = WSP(bf16, WS_PR); GAS bf16* RE = OSP(bf16, OS_RE); GAS bf16* RA = OSP(bf16, OS_RA); GAS bf16* Y = WSP(bf16, WS_Y);
    const GAS bf16* LW = WSP(bf16, WS_LW2); const GAS bf16* LA = WSP(bf16, WS_LA2); const GAS bf16* LG = WSP(bf16, WS_LG2);
    const GAS float* mu = inp(F, 10); const GAS float* w0 = inp(F, 11); const GAS float* a0 = inp(F, 13);
    const int m0 = u * 64;
    const int t = tid >> 3; const size_t row = (size_t)m0 + t; const bool hp = ((m0 + t) & (SEQ - 1)) != 0; const size_t rowp = hp ? row - 1 : row;
    __syncthreads();
    {   const int c0 = (tid & 7) * 32; v4u cur[4], prv[4];
#pragma unroll
        for (int q = 0; q < 4; ++q) { cur[q] = *(const GAS v4u*)(PR + row * RW_COLS + 1536 + c0 + 8 * q); prv[q] = *(const GAS v4u*)(PR + rowp * RW_COLS + 1536 + c0 + 8 * q); }
#pragma unroll
        for (int q = 0; q < 4; ++q) { const int c = c0 + 8 * q; float cf[8], pf[8]; unpack8(cur[q], cf); unpack8(hp ? prv[q] : v4u{0u, 0u, 0u, 0u}, pf); float o[8];
#pragma unroll
            for (int e = 0; e < 8; ++e) { float v = cf[e] + (pf[e] - cf[e]) * mu[1536 + c + e]; if (c < 64) v = 1.0f - 2.0f * __builtin_amdgcn_rcpf(1.0f + __builtin_amdgcn_exp2f(2.8853900817779268f * v)); else if (c >= 128) v = sigmf(v); o[e] = v; }
            *(LAS v4u*)(L + t * LO_PITCH + c * 2) = v4u{pk2(o[0], o[1]), pk2(o[2], o[3]), pk2(o[4], o[5]), pk2(o[6], o[7])}; } }
    {
        const int hh = tid & 7; const GAS float* k_k = inp(F, 16); GAS float* RN = OSP(float, OS_RN); float ss = 0.f; v4u cur[8], prv[8];
#pragma unroll
        for (int q = 0; q < 8; ++q) { const int cc = hh * 64 + 8 * q; cur[q] = *(const GAS v4u*)(PR + row * RW_COLS + 512 + cc); prv[q] = *(const GAS v4u*)(PR + rowp * RW_COLS + 512 + cc); }
#pragma unroll
        for (int q = 0; q < 8; ++q) { const int cc = hh * 64 + 8 * q;
#pragma unroll
            for (int e = 0; e < 8; ++e) { const float kc = bfel(cur[q], e), kp = hp ? bfel(prv[q], e) : 0.f; const float kk = (kc + (kp - kc) * mu[512 + cc + e]) * k_k[cc + e]; ss += kk * kk; } }
        RN[row * 8 + hh] = 1.0f / sqrtf(fmaxf(ss, 1e-24f)); }
    asm volatile("" ::: "memory");
    bf16x8 bw[4][2], ba[4][2], bg[4][4]; f32x4v biw[4], bia[4];
#pragma unroll
    for (int ntl = 0; ntl < 4; ++ntl) { const int n = 16 * (4 * w + ntl) + r16, n4 = 16 * (4 * w + ntl) + 4 * g4;
#pragma unroll
        for (int kk = 0; kk < 2; ++kk) { bw[ntl][kk] = *(const GAS bf16x8*)(LW + (size_t)n * 64 + 32 * kk + 8 * g4); ba[ntl][kk] = *(const GAS bf16x8*)(LA + (size_t)n * 64 + 32 * kk + 8 * g4); }
        biw[ntl] = *(const GAS f32x4v*)(w0 + n4); bia[ntl] = *(const GAS f32x4v*)(a0 + n4); }
    __syncthreads();
#define LO_PROD(KK, KOFF, BF, ...) do { _Pragma("unroll") for (int ntl = 0; ntl < 4; ++ntl) { const int n4 = 16 * (4 * w + ntl) + 4 * g4; _Pragma("unroll") for (int mt = 0; mt < 4; ++mt) { f32x4v acc = f32x4v{0.f, 0.f, 0.f, 0.f}; \
        _Pragma("unroll") for (int kk = 0; kk < (KK); ++kk) { const bf16x8 af = *(const LAS bf16x8*)(L + (16 * mt + r16) * LO_PITCH + ((KOFF) + 32 * kk + 8 * g4) * 2); acc = __builtin_amdgcn_mfma_f32_16x16x32_bf16(BF[ntl][kk], af, acc, 0, 0, 0); } \
        const size_t orow = (size_t)m0 + 16 * mt + r16; __VA_ARGS__; } } } while (0)
    LO_PROD(2, 0, bw, { const f32x4v x = acc + biw[ntl]; *(GAS v2u*)(RE + orow * 512 + n4) = v2u{pk2(0.6065306597126334f * sigmf(x[0]), 0.6065306597126334f * sigmf(x[1])), pk2(0.6065306597126334f * sigmf(x[2]), 0.6065306597126334f * sigmf(x[3]))}; });
#pragma unroll
    for (int ntl = 0; ntl < 2; ++ntl) { const int n = 16 * (4 * w + ntl) + r16;
#pragma unroll
        for (int kk = 0; kk < 4; ++kk) bg[ntl][kk] = *(const GAS bf16x8*)(LG + (size_t)n * 128 + 32 * kk + 8 * g4); }
    LO_PROD(2, 64, ba, { const f32x4v x = acc + bia[ntl]; *(GAS v2u*)(RA + orow * 512 + n4) = v2u{pk2(sigmf(x[0]), sigmf(x[1])), pk2(sigmf(x[2]), sigmf(x[3]))}; });
#pragma unroll
    for (int ntl = 2; ntl < 4; ++ntl) { const int n = 16 * (4 * w + ntl) + r16;
#pragma unroll
        for (int kk = 0; kk < 4; ++kk) bg[ntl][kk] = *(const GAS bf16x8*)(LG + (size_t)n * 128 + 32 * kk + 8 * g4); }
    LO_PROD(4, 128, bg, { *(GAS v2u*)(Y + orow * 1024 + n4) = v2u{pk2(acc[0], acc[1]), pk2(acc[2], acc[3])}; });
#undef LO_PROD
}
constexpr int GR_P = 128, GR_BUF = 32 * GR_P, GR_AF = 0, GR_WAVE = 4 * GR_BUF;
static_assert(8 * GR_WAVE <= RING_BYTES && 32 * 33 * 4 + 3 * 2560 <= GR_WAVE, "gram LDS");
__device__ __forceinline__ void rwkv_gram_phase(Frame& F) {
    const int lane = F.lane, r16 = lane & 15, g4 = lane >> 4; LAS unsigned char* Lw = F.lds + F.wave * GR_WAVE; LAS float* Af = (LAS float*)(Lw + GR_AF);
    const GAS bf16* PR = WSP(bf16, WS_PR); const GAS bf16* RE = OSP(bf16, OS_RE); const GAS bf16* RA = OSP(bf16, OS_RA); const GAS float* RN = OSP(float, OS_RN); GAS v4u* GM = WSP(v4u, WS_GM); GAS float* WCg = OSP(float, OS_WC);
    GAS bf16* IKH = OSP(bf16, OS_IKH); GAS bf16* IRH = OSP(bf16, OS_IRH); GAS bf16* IAH = WSP(bf16, WS_IAH);
    const GAS float* mu = inp(F, 10); const GAS float* k_k = inp(F, 16); const GAS float* k_a = inp(F, 17);
    const int gw = F.vcu * NWAVES + F.wave, NGW = F.G * NWAVES;
    for (int u = gw; u < 64 * 64; u += NGW) { const int bh = u >> 6, c = u & 63, b = bh >> 3, h = bh & 7, gc = h * 64 + lane; const size_t row0 = (size_t)b * SEQ + c * 32;
        const float mr = mu[gc], mk = mu[512 + gc], ckk = k_k[gc], cka = k_a[gc];
        bf16x8 fKh[2][2], fAh[2][2], fKt[2][2], fRh[2][2];
        {   float cs = 0.f, rprev = 0.f, kprev = 0.f; if (c > 0) { rprev = bf2f(PR[(row0 - 1) * RW_COLS + gc]); kprev = bf2f(PR[(row0 - 1) * RW_COLS + 512 + gc]); }
            unsigned short lr[8], lk[8], le[8], la[8], nr[8], nk[8], ne[8], na[8];
#pragma unroll
            for (int i = 0; i < 8; ++i) { const size_t row = row0 + i; lr[i] = PR[row * RW_COLS + gc]; lk[i] = PR[row * RW_COLS + 512 + gc]; le[i] = RE[row * 512 + gc]; la[i] = RA[row * 512 + gc]; }
#pragma unroll 1
            for (int tb = 0; tb < 32; tb += 8) {
                if (tb + 8 < 32) {
#pragma unroll
                    for (int i = 0; i < 8; ++i) { const size_t row = row0 + tb + 8 + i; nr[i] = PR[row * RW_COLS + gc]; nk[i] = PR[row * RW_COLS + 512 + gc]; ne[i] = RE[row * 512 + gc]; na[i] = RA[row * 512 + gc]; } }
#pragma unroll
                for (int i = 0; i < 8; ++i) { const int t = tb + i; const size_t row = row0 + t; const float rc = bf2f(lr[i]), kc = bf2f(lk[i]), e = bf2f(le[i]), a = bf2f(la[i]);
                    const float r = rc + (rprev - rc) * mr, kx = kc + (kprev - kc) * mk; rprev = rc; kprev = kc;
                    const float kk = kx * ckk * RN[row * 8 + h];
                    const float wm = __expf(-cs); cs += e; const float wt = __expf(-cs), iw = __builtin_amdgcn_rcpf(wt);
                    if (t == 31) WCg[(size_t)u * 64 + lane] = wt;
                    LAS unsigned char* im = Lw + t * GR_P + lane * 2;
                    *(LAS unsigned short*)(im) = (unsigned short)f2bf(kk * wm); *(LAS unsigned short*)(im + GR_BUF) = (unsigned short)f2bf(kk * a * iw);
                    *(LAS unsigned short*)(im + 2 * GR_BUF) = (unsigned short)f2bf(kx * (1.0f + (a - 1.0f) * cka) * iw); *(LAS unsigned short*)(im + 3 * GR_BUF) = (unsigned short)f2bf(r * wt); }
#pragma unroll
                for (int i = 0; i < 8; ++i) { lr[i] = nr[i]; lk[i] = nk[i]; le[i] = ne[i]; la[i] = na[i]; }
            }
            asm volatile("s_waitcnt lgkmcnt(0)" ::: "memory");
#pragma unroll
            for (int mt = 0; mt < 2; ++mt)
#pragma unroll
                for (int kk2 = 0; kk2 < 2; ++kk2) { const LAS unsigned char* fp = Lw + (16 * mt + r16) * GR_P + (32 * kk2 + 8 * g4) * 2;
                    fKh[mt][kk2] = *(const LAS bf16x8*)(fp); fAh[mt][kk2] = *(const LAS bf16x8*)(fp + GR_BUF); fKt[mt][kk2] = *(const LAS bf16x8*)(fp + 2 * GR_BUF); fRh[mt][kk2] = *(const LAS bf16x8*)(fp + 3 * GR_BUF); }
            asm volatile("s_waitcnt lgkmcnt(0)" ::: "memory");
            {
                GAS bf16* IKT = (b < 5) ? WSP(bf16, WS_IKT_LO) : WSP(bf16, WS_IKT_HI); const int tq = lane >> 3, k8 = (lane & 7) * 8;
#pragma unroll 1
                for (int q = 0; q < 4; ++q) { const int t = q * 8 + tq; const LAS unsigned char* ip = Lw + t * GR_P + k8 * 2; const size_t go = (row0 + t) * 512 + h * 64 + k8;
                    const v4u i0 = *(const LAS v4u*)(ip), i1 = *(const LAS v4u*)(ip + GR_BUF), i2 = *(const LAS v4u*)(ip + 2 * GR_BUF), i3 = *(const LAS v4u*)(ip + 3 * GR_BUF);
                    *(GAS v4u*)(IKH + go) = i0; *(GAS v4u*)(IAH + go) = i1; *(GAS v4u*)(IKT + go) = i2; *(GAS v4u*)(IRH + go) = i3; }
                asm volatile("s_waitcnt lgkmcnt(0)" ::: "memory"); }
        }
        f32x4v gA[2][2], gB[2][2], gRA[2][2], gRK[2][2];
#pragma unroll
        for (int mt = 0; mt < 2; ++mt)
#pragma unroll
            for (int st = 0; st < 2; ++st) { f32x4v z = f32x4v{0.f, 0.f, 0.f, 0.f}; gA[mt][st] = z; gB[mt][st] = z; gRA[mt][st] = z; gRK[mt][st] = z;
#pragma unroll
                for (int kk = 0; kk < 2; ++kk) { gA[mt][st] = __builtin_amdgcn_mfma_f32_16x16x32_bf16(fKh[mt][kk], fAh[st][kk], gA[mt][st], 0, 0, 0); gB[mt][st] = __builtin_amdgcn_mfma_f32_16x16x32_bf16(fKh[mt][kk], fKt[st][kk], gB[mt][st], 0, 0, 0);
                    gRA[mt][st] = __builtin_amdgcn_mfma_f32_16x16x32_bf16(fRh[mt][kk], fAh[st][kk], gRA[mt][st], 0, 0, 0); gRK[mt][st] = __builtin_amdgcn_mfma_f32_16x16x32_bf16(fRh[mt][kk], fKt[st][kk], gRK[mt][st], 0, 0, 0); } }
#pragma unroll
        for (int mt = 0; mt < 2; ++mt)
#pragma unroll
            for (int st = 0; st < 2; ++st)
#pragma unroll
                for (int rg = 0; rg < 4; ++rg) { const int t = 16 * mt + 4 * g4 + rg, s_ = 16 * st + r16; Af[t * 33 + s_] = (s_ < t) ? gA[mt][st][rg] : 0.f; }
        asm volatile("s_waitcnt lgkmcnt(0)" ::: "memory");
        float Tc[32]; const int j = lane & 31;
#pragma unroll
        for (int t = 0; t < 32; ++t) { float acc[4] = {(t == j) ? 1.0f : 0.f, 0.f, 0.f, 0.f};
#pragma unroll
            for (int s_ = 0; s_ < t; ++s_) acc[s_ & 3] -= Af[t * 33 + s_] * Tc[s_];
            Tc[t] = (acc[0] + acc[1]) + (acc[2] + acc[3]); }
        LAS unsigned char* I0 = Lw, * I1 = Lw + 2560, * I2 = Lw + 5120;
        if (lane < 32) {
#pragma unroll
            for (int t = 0; t < 32; ++t) *(LAS unsigned short*)(I0 + t * 80 + j * 2) = (unsigned short)f2bf(Tc[t]); }
#define GR_CW(IMG, G, STRICT) do { _Pragma("unroll") for (int mt = 0; mt < 2; ++mt) _Pragma("unroll") for (int st = 0; st < 2; ++st) _Pragma("unroll") for (int rg = 0; rg < 4; ++rg) { const int t = 16 * mt + 4 * g4 + rg, s_ = 16 * st + r16; \
            *(LAS unsigned short*)(IMG + t * 80 + s_ * 2) = (unsigned short)f2bf(((STRICT) ? (s_ < t) : (s_ <= t)) ? G[mt][st][rg] : 0.f); } } while (0)
        GR_CW(I1, gB, true); GR_CW(I2, gRA, false);
        asm volatile("s_waitcnt lgkmcnt(0)" ::: "memory");
        GAS v4u* gm = GM + (size_t)u * 512 + lane;
#pragma unroll
        for (int mt = 0; mt < 2; ++mt) { const LAS unsigned char* rT = I0 + (16 * mt + r16) * 80, * rB = I1 + (16 * mt + r16) * 80, * rR = I2 + (16 * mt + r16) * 80;
            const v2u t0 = *(const LAS v2u*)(rT + (4 * g4) * 2), t1 = *(const LAS v2u*)(rT + (16 + 4 * g4) * 2); gm[(0 * 2 + mt) * 64] = v4u{t0.x, t0.y, t1.x, t1.y};
            gm[(1 * 2 + mt) * 64] = *(const LAS v4u*)(rB + (8 * g4) * 2);
            const v2u a0 = *(const LAS v2u*)(rR + (4 * g4) * 2), a1 = *(const LAS v2u*)(rR + (16 + 4 * g4) * 2); gm[(2 * 2 + mt) * 64] = v4u{a0.x, a0.y, a1.x, a1.y}; }
        asm volatile("s_waitcnt lgkmcnt(0)" ::: "memory");
        GR_CW(I0, gRK, false);
        asm volatile("s_waitcnt lgkmcnt(0)" ::: "memory");
#pragma unroll
        for (int mt = 0; mt < 2; ++mt) gm[(3 * 2 + mt) * 64] = *(const LAS v4u*)(I0 + (16 * mt + r16) * 80 + (8 * g4) * 2);
        asm volatile("s_waitcnt lgkmcnt(0)" ::: "memory");
#undef GR_CW
    }
}
constexpr int CS_KH = 0, CS_RH = CS_KH + 32 * 144, CS_AT = CS_RH + 32 * 144, CS_KT = CS_AT + 64 * 80, CS_VT = CS_KT + 64 * 80, CS_WC = CS_VT + 16 * 80, CS_YR = CS_WC + 256, CS_BUF = CS_YR + 32 * 16 * 4;
static_assert(2 * CS_BUF <= RING_BYTES && CS_AT % 16 == 0 && CS_VT % 16 == 0 && CS_WC % 16 == 0 && CS_YR % 16 == 0 && CS_BUF % 16 == 0, "chunk scan LDS");
__device__ __forceinline__ bf16x8 pack8(const f32x4v a, const f32x4v b) { const v4u w = v4u{pk2(a[0], a[1]), pk2(a[2], a[3]), pk2(b[0], b[1]), pk2(b[2], b[3])}; return __builtin_bit_cast(bf16x8, w); }
__device__ __forceinline__ bf16x8 cat8(const v2u a, const v2u b) { const v4u w = v4u{a.x, a.y, b.x, b.y}; return __builtin_bit_cast(bf16x8, w); }
template <bool DRY = false, bool NOPROD = false> __device__ __forceinline__ void rwkv_cscan_unit(Frame& F, int u) {
    const int tid = F.tid, lane = F.lane, w = F.wave, r16 = lane & 15, g4 = lane >> 4; LAS unsigned char* L = F.lds;
    const int ch = u >> 2, rg = u & 3, b = ch >> 3, h = ch & 7; const size_t rowbase = (size_t)b * SEQ;
    const GAS bf16* PR = WSP(bf16, WS_PR); const GAS v4u* GM = WSP(v4u, WS_GM); GAS bf16* YRAW = WSP(bf16, WS_YRAW); GAS long long* RST = OSP(long long, OS_RST);
    const GAS float* WCg = OSP(float, OS_WC); const GAS bf16* IKH = OSP(bf16, OS_IKH); const GAS bf16* IRH = OSP(bf16, OS_IRH); const GAS bf16* IAH = WSP(bf16, WS_IAH);
    const GAS bf16* IKT = (b < 5) ? WSP(bf16, WS_IKT_LO) : WSP(bf16, WS_IKT_HI);
#define CS_T16(DST, V, C8, T_) do { _Pragma("unroll") for (int e = 0; e < 8; ++e) *(LAS unsigned short*)((DST) + ((C8) + e) * 80 + (T_) * 2) = (unsigned short)(((V)[e >> 1]) >> (16 * (e & 1))); } while (0)
#define CS_CL(CC) ((CC) < 63 ? (CC) : 63)
#define CS_FLUSH(CC) do { const int t0f_ = (CC) * 32; const LAS float* yr_ = (const LAS float*)(L + ((CC) & 1) * CS_BUF + CS_YR); \
        { const int t_ = lane >> 1, hf_ = lane & 1; const LAS float* p_ = yr_ + t_ * 16 + hf_ * 8; const f32x4v a_ = *(const LAS f32x4v*)p_, b_ = *(const LAS f32x4v*)(p_ + 4); \
            *(GAS v4u*)(YRAW + (rowbase + t0f_ + t_) * 512 + h * 64 + rg * 16 + hf_ * 8) = v4u{pk2(a_[0], a_[1]), pk2(a_[2], a_[3]), pk2(b_[0], b_[1]), pk2(b_[2], b_[3])}; \
            float s1_ = (a_[0] + a_[1]) + (a_[2] + a_[3]) + (b_[0] + b_[1]) + (b_[2] + b_[3]); float s2_ = (a_[0] * a_[0] + a_[1] * a_[1]) + (a_[2] * a_[2] + a_[3] * a_[3]) + (b_[0] * b_[0] + b_[1] * b_[1]) + (b_[2] * b_[2] + b_[3] * b_[3]); \
            s1_ += __shfl_xor(s1_, 1); s2_ += __shfl_xor(s2_, 1); \
            if (hf_ == 0 && !DRY) { GAS long long* st_ = RST + ((rowbase + t0f_ + t_) * 8 + h) * 2; __hip_atomic_fetch_add(st_, fx20(s1_), __ATOMIC_RELAXED, __HIP_MEMORY_SCOPE_AGENT); __hip_atomic_fetch_add(st_ + 1, fx20(s2_), __ATOMIC_RELAXED, __HIP_MEMORY_SCOPE_AGENT); } } \
    } while (0)
    __syncthreads();
    if (w == 0) {
        f32x4v S[4]; S[0] = f32x4v{0.f, 0.f, 0.f, 0.f}; S[1] = S[0]; S[2] = S[0]; S[3] = S[0];
        v4u gTa[2], gBa[2], gRAa[2], gRKa[2];
#define CS_GM(CC, G) do { const GAS v4u* gm_ = GM + ((size_t)ch * 64 + (CC)) * 512 + lane; gT##G[0] = gm_[0]; gT##G[1] = gm_[64]; gB##G[0] = gm_[128]; gB##G[1] = gm_[192]; gRA##G[0] = gm_[256]; gRA##G[1] = gm_[320]; gRK##G[0] = gm_[384]; gRK##G[1] = gm_[448]; } while (0)
        CS_GM(0, a);
        LDS_BARRIER();
#define CS_CONS(c, G) do { \
            const LAS unsigned char* B = L + ((c) & 1) * CS_BUF; \
            const bf16x8 fT0 = __builtin_bit_cast(bf16x8, gT##G[0]), fT1 = __builtin_bit_cast(bf16x8, gT##G[1]), fB0 = __builtin_bit_cast(bf16x8, gB##G[0]), fB1 = __builtin_bit_cast(bf16x8, gB##G[1]); \
            const bf16x8 fRA0 = __builtin_bit_cast(bf16x8, gRA##G[0]), fRA1 = __builtin_bit_cast(bf16x8, gRA##G[1]), fRK0 = __builtin_bit_cast(bf16x8, gRK##G[0]), fRK1 = __builtin_bit_cast(bf16x8, gRK##G[1]); \
            CS_GM(CS_CL((c) + 1), G); \
            const bf16x8 sB0 = pack8(S[0], S[1]), sB1 = pack8(S[2], S[3]); \
            const bf16x8 vB = *(const LAS bf16x8*)(B + CS_VT + r16 * 80 + 16 * g4); \
            f32x4v X[2], Y[2]; \
            _Pragma("unroll") \
            for (int mt = 0; mt < 2; ++mt) { const LAS unsigned char* kr = B + CS_KH + (16 * mt + r16) * 144 + 8 * g4; const LAS unsigned char* rr = B + CS_RH + (16 * mt + r16) * 144 + 8 * g4; \
                const bf16x8 k0 = cat8(*(const LAS v2u*)(kr), *(const LAS v2u*)(kr + 32)), k1 = cat8(*(const LAS v2u*)(kr + 64), *(const LAS v2u*)(kr + 96)); \
                const bf16x8 q0 = cat8(*(const LAS v2u*)(rr), *(const LAS v2u*)(rr + 32)), q1 = cat8(*(const LAS v2u*)(rr + 64), *(const LAS v2u*)(rr + 96)); \
                f32x4v x = f32x4v{0.f, 0.f, 0.f, 0.f}; x = __builtin_amdgcn_mfma_f32_16x16x32_bf16(k0, sB0, x, 0, 0, 0); x = __builtin_amdgcn_mfma_f32_16x16x32_bf16(k1, sB1, x, 0, 0, 0); \
                X[mt] = __builtin_amdgcn_mfma_f32_16x16x32_bf16(mt ? fB1 : fB0, vB, x, 0, 0, 0); \
                f32x4v y = f32x4v{0.f, 0.f, 0.f, 0.f}; y = __builtin_amdgcn_mfma_f32_16x16x32_bf16(q0, sB0, y, 0, 0, 0); y = __builtin_amdgcn_mfma_f32_16x16x32_bf16(q1, sB1, y, 0, 0, 0); \
                Y[mt] = __builtin_amdgcn_mfma_f32_16x16x32_bf16(mt ? fRK1 : fRK0, vB, y, 0, 0, 0); } \
            const bf16x8 xB = pack8(X[0], X[1]); \
            const f32x4v z = f32x4v{0.f, 0.f, 0.f, 0.f}; \
            const f32x4v U0 = -__builtin_amdgcn_mfma_f32_16x16x32_bf16(fT0, xB, z, 0, 0, 0), U1 = -__builtin_amdgcn_mfma_f32_16x16x32_bf16(fT1, xB, z, 0, 0, 0); \
            const bf16x8 uB = pack8(U0, U1); \
            Y[0] = __builtin_amdgcn_mfma_f32_16x16x32_bf16(fRA0, uB, Y[0], 0, 0, 0); Y[1] = __builtin_amdgcn_mfma_f32_16x16x32_bf16(fRA1, uB, Y[1], 0, 0, 0); \
            _Pragma("unroll") \
            for (int kt = 0; kt < 4; ++kt) { const LAS unsigned char* ar = B + CS_AT + (16 * kt + r16) * 80 + 8 * g4; const bf16x8 af = cat8(*(const LAS v2u*)(ar), *(const LAS v2u*)(ar + 32)); \
                const bf16x8 kf = *(const LAS bf16x8*)(B + CS_KT + (16 * kt + r16) * 80 + 16 * g4); const f32x4v wc = *(const LAS f32x4v*)(B + CS_WC + (16 * kt + 4 * g4) * 4); \
                f32x4v acc = __builtin_amdgcn_mfma_f32_16x16x32_bf16(af, uB, S[kt], 0, 0, 0); acc = __builtin_amdgcn_mfma_f32_16x16x32_bf16(kf, vB, acc, 0, 0, 0); S[kt] = acc * wc; } \
            LAS float* yr = (LAS float*)(L + ((c) & 1) * CS_BUF + CS_YR); \
            _Pragma("unroll") \
            for (int mt = 0; mt < 2; ++mt) \
            _Pragma("unroll") \
                for (int rg_ = 0; rg_ < 4; ++rg_) yr[(16 * mt + 4 * g4 + rg_) * 16 + r16] = Y[mt][rg_]; \
        LDS_BARRIER(); \
    } while (0)
#pragma unroll 1
        for (int c2 = 0; c2 < 64; c2 += 2) { CS_CONS(c2, a); CS_CONS(c2 + 1, a); }
#undef CS_CONS
#undef CS_GM
    } else if (w == 1) {
        LDS_BARRIER();
#pragma unroll 1
        for (int c = 0; c < 64; ++c) { if (c >= 1) CS_FLUSH(c - 1); LDS_BARRIER(); }
        CS_FLUSH(63);
    } else if (w == 2) {
        const int t8 = lane >> 3, c8 = (lane & 7) * 8; const GAS bf16* src = IKT + (rowbase + t8) * 512 + h * 64 + c8; v4u qa[4], qb[4];
#define CS_LOAD(CC, Q) do { const GAS bf16* p_ = src + (size_t)CS_CL(CC) * (32 * 512); _Pragma("unroll") for (int it_ = 0; it_ < 4; ++it_) q##Q[it_] = *(const GAS v4u*)(p_ + it_ * (8 * 512)); } while (0)
#define CS_PREP(CC, Q) do { LAS unsigned char* B_ = L + ((CC) & 1) * CS_BUF; _Pragma("unroll") for (int it_ = 0; it_ < 4; ++it_) CS_T16(B_ + CS_KT, q##Q[it_], c8, 8 * it_ + t8); } while (0)
#define CS_PROD(c, Q) do { if (!NOPROD) { CS_PREP((c) + 1, Q); CS_LOAD((c) + 3, Q); } LDS_BARRIER(); } while (0)
        CS_LOAD(0, a); CS_PREP(0, a); CS_LOAD(1, b); CS_LOAD(2, a);
        LDS_BARRIER();
#pragma unroll 1
        for (int c2 = 0; c2 < 64; c2 += 2) { CS_PROD(c2, b); CS_PROD(c2 + 1, a); }
#undef CS_LOAD
#undef CS_PREP
    } else if (w == 3) {
        const int t_ = lane >> 1, hf = (lane & 1) * 8, vcol = h * 64 + rg * 16 + hf; const GAS float* mu = inp(F, 10); float cB[8];
#pragma unroll
        for (int e = 0; e < 8; ++e) cB[e] = mu[1024 + vcol + e];
        const GAS bf16* src = PR + (rowbase + t_) * RW_COLS + 1024 + vcol; v4u qa[2], qb[2];
#define CS_LOAD(CC, Q) do { const GAS bf16* p_ = src + (size_t)CS_CL(CC) * (32 * RW_COLS); q##Q[0] = *(const GAS v4u*)(p_); q##Q[1] = *(const GAS v4u*)(p_ - ((CS_CL(CC) * 32 + t_ > 0) ? RW_COLS : 0)); } while (0)
#define CS_PREP(CC, Q) do { LAS unsigned char* B_ = L + ((CC) & 1) * CS_BUF; const bool first_ = ((CC) * 32 + t_ == 0); \
            _Pragma("unroll") for (int e = 0; e < 8; ++e) { const float vc_ = bfel(q##Q[0], e), vp_ = first_ ? 0.f : bfel(q##Q[1], e); *(LAS unsigned short*)(B_ + CS_VT + (hf + e) * 80 + t_ * 2) = (unsigned short)f2bf(vc_ + (vp_ - vc_) * cB[e]); } } while (0)
        CS_LOAD(0, a); CS_PREP(0, a); CS_LOAD(1, b); CS_LOAD(2, a);
        LDS_BARRIER();
#pragma unroll 1
        for (int c2 = 0; c2 < 64; c2 += 2) { CS_PROD(c2, b); CS_PROD(c2 + 1, a); }
#undef CS_LOAD
#undef CS_PREP
    } else {
        const int ptid = tid & 255, pt = ptid >> 3, c8 = (ptid & 7) * 8; const size_t o0 = (rowbase + pt) * 512 + h * 64 + c8; const GAS float* wsrc = WCg + (size_t)ch * 64 * 64 + (ptid & 63);
        v4u qa[3], qb[3]; float qwa, qwb;
#define CS_LOAD(CC, Q) do { const size_t o_ = o0 + (size_t)CS_CL(CC) * (32 * 512); q##Q[0] = *(const GAS v4u*)(IKH + o_); q##Q[1] = *(const GAS v4u*)(IRH + o_); q##Q[2] = *(const GAS v4u*)(IAH + o_); qw##Q = wsrc[CS_CL(CC) * 64]; } while (0)
#define CS_PREP(CC, Q) do { LAS unsigned char* B_ = L + ((CC) & 1) * CS_BUF; *(LAS v4u*)(B_ + CS_KH + pt * 144 + c8 * 2) = q##Q[0]; *(LAS v4u*)(B_ + CS_RH + pt * 144 + c8 * 2) = q##Q[1]; CS_T16(B_ + CS_AT, q##Q[2], c8, pt); \
            if (ptid < 64) *(LAS float*)(B_ + CS_WC + ptid * 4) = qw##Q; } while (0)
        CS_LOAD(0, a); CS_PREP(0, a); CS_LOAD(1, b); CS_LOAD(2, a);
        LDS_BARRIER();
#pragma unroll 1
        for (int c2 = 0; c2 < 64; c2 += 2) { CS_PROD(c2, b); CS_PROD(c2 + 1, a); }
#undef CS_LOAD
#undef CS_PREP
#undef CS_PROD
    }
#undef CS_FLUSH
#undef CS_T16
#undef CS_CL
}
template <bool DRY = false, bool NOPROD = false> __device__ __forceinline__ void rwkv_cscan_phase(Frame& F) {
    for (int u = F.vcu; u < 256; u += F.G) rwkv_cscan_unit<DRY, NOPROD>(F, u);
}
__device__ __forceinline__ void rwkv_post_phase(Frame& F) {
    const int gw = F.vcu * NWAVES + F.wave, NGW = F.G * NWAVES, lane = F.lane, c = lane * 8, hh = lane >> 3;
    const GAS bf16* PR = WSP(bf16, WS_PR); const GAS bf16* RA = OSP(bf16, OS_RA); const GAS bf16* YRAW = WSP(bf16, WS_YRAW); const GAS long long* RST = OSP(long long, OS_RST); GAS bf16* Y = WSP(bf16, WS_Y);
    const GAS float* mu = inp(F, 10); const GAS float* k_a = inp(F, 17); const GAS float* r_k = inp(F, 18); const GAS float* lnw = inp(F, 19); const GAS float* lnb = inp(F, 20);
    float mur[8], muk[8], muv[8], cka[8], crk[8], clw[8], clb[8];
#pragma unroll
    for (int e = 0; e < 8; ++e) { mur[e] = mu[c + e]; muk[e] = mu[512 + c + e]; muv[e] = mu[1024 + c + e]; cka[e] = k_a[c + e]; crk[e] = r_k[c + e]; clw[e] = lnw[c + e]; clb[e] = lnb[c + e]; }
    for (int m0 = gw; m0 < M; m0 += 2 * NGW) {
        v4u rc_[2], kc_[2], vc_[2], rp_[2], kp_[2], vp_[2], av_[2], gv_[2], yv_[2]; long long s1_[2], s2_[2];
#pragma unroll
        for (int k = 0; k < 2; ++k) { const int mk = m0 + k * NGW, m = mk < M ? mk : M - 1; const size_t row = (size_t)m, rowp = (m & (SEQ - 1)) != 0 ? row - 1 : row;
            rc_[k] = *(const GAS v4u*)(PR + row * RW_COLS + c); kc_[k] = *(const GAS v4u*)(PR + row * RW_COLS + 512 + c); vc_[k] = *(const GAS v4u*)(PR + row * RW_COLS + 1024 + c);
            rp_[k] = *(const GAS v4u*)(PR + rowp * RW_COLS + c); kp_[k] = *(const GAS v4u*)(PR + rowp * RW_COLS + 512 + c); vp_[k] = *(const GAS v4u*)(PR + rowp * RW_COLS + 1024 + c);
            av_[k] = *(const GAS v4u*)(RA + row * 512 + c); gv_[k] = *(const GAS v4u*)(Y + row * 1024 + c); yv_[k] = *(const GAS v4u*)(YRAW + row * 512 + c);
            s1_[k] = RST[(row * 8 + hh) * 2]; s2_[k] = RST[(row * 8 + hh) * 2 + 1]; }
#pragma unroll
        for (int k = 0; k < 2; ++k) { const int m = m0 + k * NGW; if (m < M) { const size_t row = (size_t)m; const bool hp = (m & (SEQ - 1)) != 0; const v4u z = v4u{0u, 0u, 0u, 0u};
            float rc[8], rp[8], kc[8], kp[8], vc[8], vp[8], aa[8], gg[8], yy[8]; unpack8(rc_[k], rc); unpack8(hp ? rp_[k] : z, rp); unpack8(kc_[k], kc); unpack8(hp ? kp_[k] : z, kp); unpack8(vc_[k], vc); unpack8(hp ? vp_[k] : z, vp); unpack8(av_[k], aa); unpack8(gv_[k], gg); unpack8(yv_[k], yy);
            float vs[8]; float bon = 0.f;
#pragma unroll
            for (int e = 0; e < 8; ++e) { const float r = rc[e] + (rp[e] - rc[e]) * mur[e], kx = kc[e] + (kp[e] - kc[e]) * muk[e]; vs[e] = vc[e] + (vp[e] - vc[e]) * muv[e]; bon += r * (kx * (1.0f + (aa[e] - 1.0f) * cka[e])) * crk[e]; }
            bon += __shfl_xor(bon, 1); bon += __shfl_xor(bon, 2); bon += __shfl_xor(bon, 4);
            const float s1 = unfx20(s1_[k]), s2 = unfx20(s2_[k]); const float mean = s1 * (1.0f / 64.0f), var = fmaxf(s2 * (1.0f / 64.0f) - mean * mean, 0.f), rs = 1.0f / sqrtf(var + 64e-5f);
            float o[8];
#pragma unroll
            for (int e = 0; e < 8; ++e) o[e] = ((yy[e] - mean) * rs * clw[e] + clb[e] + bon * vs[e]) * gg[e];
            *(GAS v4u*)(Y + row * 1024 + c) = v4u{pk2(o[0], o[1]), pk2(o[2], o[3]), pk2(o[4], o[5]), pk2(o[6], o[7])}; } }
    }
}
__device__ __forceinline__ void lora_kmean_phase(Frame& F) {
    for (int u = F.vcu; u < 256; u += F.G) rwkv_lora_unit(F, u);
}

__device__ __forceinline__ int crow(int r, int hi) { return (r & 3) + 8 * (r >> 2) + 4 * hi; }
constexpr int MO_ROWB = 144;
constexpr int MO_BUF = 2 * 64 * MO_ROWB;
constexpr int MO_KM = 40960;
static_assert(2 * MO_BUF <= MO_KM && MO_KM + 2048 <= RING_BYTES, "MoBA LDS");
__device__ __forceinline__ void moba_unit(Frame& F, int b, int h, int qb) {
    const int tid = F.tid, lane = F.lane, wid = F.wave, r32 = lane & 31, hi = lane >> 5;
    const GAS bf16* QB = WSP(bf16, WS_QB); const GAS bf16* KB = WSP(bf16, WS_KB); const GAS bf16* VB = WSP(bf16, WS_VB); GAS bf16* Y = WSP(bf16, WS_Y); const GAS float* km = WSP(float, WS_KMEAN);
    const size_t rowbase = (size_t)b * SEQ; const int qpos = qb * 256 + wid * 32 + r32; const float NEG = -INFINITY;
    bf16x8 qr[4]; { const GAS bf16* qp = QB + (rowbase + qpos) * 512 + h * 64 + hi * 8;
#pragma unroll
        for (int d0 = 0; d0 < 4; ++d0) qr[d0] = *(const GAS bf16x8*)(qp + d0 * 16); }
    unsigned sel = 0u;
    if (qb > 0) {
        LAS float* KM = (LAS float*)(F.lds + MO_KM);
        __syncthreads();
        KM[tid] = km[(size_t)(b * 8 + h) * 8 * 64 + tid];
        __syncthreads();
        float gate[7];
#pragma unroll
        for (int n = 0; n < 7; ++n) { float g = 0.f;
            if (n < qb) { const LAS float* kp = KM + n * 64 + hi * 8;
#pragma unroll
                for (int d0 = 0; d0 < 4; ++d0) { const f32x4v k0 = *(const LAS f32x4v*)(kp + d0 * 16), k1 = *(const LAS f32x4v*)(kp + d0 * 16 + 4);
#pragma unroll
                    for (int j = 0; j < 4; ++j) { g += bf2f((bf16)qr[d0][j]) * k0[j]; g += bf2f((bf16)qr[d0][4 + j]) * k1[j]; } }
                g += __shfl_xor(g, 32); }
            gate[n] = (n < qb) ? g : NEG; }
        const int nsel = qb < 3 ? qb : 3;
#pragma unroll
        for (int s = 0; s < 3; ++s) { int best = 0; float bv = NEG; bool have = false;
#pragma unroll
            for (int n = 0; n < 7; ++n) { const bool ok = (n < qb) && !((sel >> n) & 1u) && (!have || gate[n] > bv); if (ok) { best = n; bv = gate[n]; have = true; } }
            if (s < nsel) sel |= 1u << best; }
    }
    const float C2 = 0.125f * 1.4426950408889634f, sl2 = exp2f(-(float)(h + 1)) * 1.4426950408889634f;
    const int NT = 4 * (qb + 1);
    f32x16 abias[2];
#pragma unroll
    for (int kb = 0; kb < 2; ++kb)
#pragma unroll
        for (int r = 0; r < 16; ++r) abias[kb][r] = sl2 * (float)(32 * kb + crow(r, hi));
    const GAS bf16* kg = KB + (rowbase + (tid >> 3)) * 512 + h * 64 + (tid & 7) * 8; const GAS bf16* vg = VB + (rowbase + lane) * 512 + h * 64 + wid * 8;
    const int kdst = (tid >> 3) * MO_ROWB + (tid & 7) * 16, vdst = 64 * MO_ROWB + (wid * 8) * MO_ROWB + lane * 2;
    f32x16 o[2]; o[0] = f32x16{}; o[1] = f32x16{}; float mrun = NEG, lrun = 0.f;
    v4u kreg, vreg;
    { const int kb0 = (4 * qb) * 64; kreg = *(const GAS v4u*)(kg + (size_t)kb0 * 512); vreg = *(const GAS v4u*)(vg + (size_t)kb0 * 512); }
    __syncthreads();
    { LAS unsigned char* B0 = F.lds; *(LAS v4u*)(B0 + kdst) = kreg; const unsigned w[4] = {vreg.x, vreg.y, vreg.z, vreg.w};
#pragma unroll
        for (int e = 0; e < 8; ++e) *(LAS unsigned short*)(B0 + vdst + e * MO_ROWB) = (unsigned short)((e & 1) ? (w[e >> 1] >> 16) : (w[e >> 1] & 0xffffu)); }
    __syncthreads();
    for (int it = 0; it < NT; ++it) {
        const int tk = (it < 4) ? 4 * qb + it : it - 4, kb0 = tk * 64, nb = tk >> 2;
        if (it + 1 < NT) { const int tn = (it + 1 < 4) ? 4 * qb + it + 1 : it - 3; kreg = *(const GAS v4u*)(kg + (size_t)tn * 64 * 512); vreg = *(const GAS v4u*)(vg + (size_t)tn * 64 * 512); }
        LAS unsigned char* Kb = F.lds + (it & 1) * MO_BUF; LAS unsigned char* Vb = Kb + 64 * MO_ROWB;
        const bool row_ok = (nb == qb) || ((sel >> nb) & 1u);
        f32x16 p[2];
#pragma unroll
        for (int kb = 0; kb < 2; ++kb) { p[kb] = f32x16{};
#pragma unroll
            for (int d0 = 0; d0 < 4; ++d0) { const bf16x8 a = *(const LAS bf16x8*)(Kb + (32 * kb + r32) * MO_ROWB + (d0 * 16 + hi * 8) * 2); p[kb] = __builtin_amdgcn_mfma_f32_32x32x16_bf16(a, qr[d0], p[kb], 0, 0, 0); } }
        float rmax = NEG; const float off = row_ok ? sl2 * (float)(kb0 - qpos) : NEG;
        p[0] = p[0] * C2 + (abias[0] + off); p[1] = p[1] * C2 + (abias[1] + off);
        if (nb == qb) {
#pragma unroll
            for (int kb = 0; kb < 2; ++kb)
#pragma unroll
                for (int r = 0; r < 16; ++r) { const int kpos = kb0 + 32 * kb + crow(r, hi); if (kpos > qpos) p[kb][r] = NEG; }
        }
        {   const f32x16 mx = __builtin_elementwise_max(p[0], p[1]);
#pragma unroll
            for (int r = 0; r < 16; ++r) rmax = fmaxf(rmax, mx[r]); }
        rmax = fmaxf(rmax, __shfl_xor(rmax, 32));
        const float mnew = fmaxf(mrun, rmax), alpha = __builtin_amdgcn_exp2f(mrun - mnew); mrun = mnew; lrun *= alpha;
        if (__any(alpha != 1.0f)) {
#pragma unroll
            for (int r = 0; r < 16; ++r) { o[0][r] *= alpha; o[1][r] *= alpha; } }
        p[0] = p[0] - mnew; p[1] = p[1] - mnew;
#pragma unroll
        for (int kb = 0; kb < 2; ++kb)
#pragma unroll
            for (int r = 0; r < 16; ++r) p[kb][r] = __builtin_amdgcn_exp2f(p[kb][r]);
        {   const f32x16 sv = p[0] + p[1]; float psum = 0.f;
#pragma unroll
            for (int r = 0; r < 16; ++r) psum += sv[r];
            lrun += psum; }
#pragma unroll
        for (int kb = 0; kb < 2; ++kb)
#pragma unroll
            for (int s2 = 0; s2 < 2; ++s2) { v4u pw; pw.x = pg8::cvt_pk_bf16(p[kb][8 * s2 + 0], p[kb][8 * s2 + 1]); pw.y = pg8::cvt_pk_bf16(p[kb][8 * s2 + 2], p[kb][8 * s2 + 3]);
                pw.z = pg8::cvt_pk_bf16(p[kb][8 * s2 + 4], p[kb][8 * s2 + 5]); pw.w = pg8::cvt_pk_bf16(p[kb][8 * s2 + 6], p[kb][8 * s2 + 7]);
                const bf16x8 pb = __builtin_bit_cast(bf16x8, pw); const int k0 = 32 * kb + 16 * s2 + 4 * hi;
#pragma unroll
                for (int db = 0; db < 2; ++db) { const LAS unsigned char* vp = Vb + (32 * db + r32) * MO_ROWB + k0 * 2;
                    const v2u lo = *(const LAS v2u*)vp, hi8 = *(const LAS v2u*)(vp + 16); const v4u av = {lo.x, lo.y, hi8.x, hi8.y};
                    o[db] = __builtin_amdgcn_mfma_f32_32x32x16_bf16(__builtin_bit_cast(bf16x8, av), pb, o[db], 0, 0, 0); } }
        if (it + 1 < NT) { LAS unsigned char* B1 = F.lds + ((it + 1) & 1) * MO_BUF; *(LAS v4u*)(B1 + kdst) = kreg; const unsigned w[4] = {vreg.x, vreg.y, vreg.z, vreg.w};
#pragma unroll
            for (int e = 0; e < 8; ++e) *(LAS unsigned short*)(B1 + vdst + e * MO_ROWB) = (unsigned short)((e & 1) ? (w[e >> 1] >> 16) : (w[e >> 1] & 0xffffu)); }
        __syncthreads();
    }
    lrun += __shfl_xor(lrun, 32); const float inv = 1.0f / lrun;
    GAS bf16* yp = Y + (rowbase + qpos) * 1024 + 512 + h * 64 + 4 * hi;
#pragma unroll
    for (int db = 0; db < 2; ++db)
#pragma unroll
        for (int g = 0; g < 4; ++g) *(GAS v2u*)(yp + 32 * db + 8 * g) = v2u{pk2(o[db][4 * g] * inv, o[db][4 * g + 1] * inv), pk2(o[db][4 * g + 2] * inv, o[db][4 * g + 3] * inv)};
}
__device__ __forceinline__ void moba_phase(Frame& F) {
    for (int u = F.vcu; u < 256; u += F.G) { const int bh = u >> 2, pr = u & 3; moba_unit(F, bh >> 3, bh & 7, pr); moba_unit(F, bh >> 3, bh & 7, 7 - pr); }
}

constexpr int HG_PQ = 272, HG_PS = 144;
constexpr int HG_QT = 0, HG_KT = HG_QT + 64 * HG_PQ, HG_KTT = HG_KT + 64 * HG_PQ, HG_IT = HG_KTT + 128 * HG_PS, HG_ST = HG_IT + 32 * HG_PS, HG_AS = HG_ST + 32 * HG_PQ, HG_TOT = HG_AS + 64 * HG_PS, HG_END = HG_TOT + 8 * 128 * 4;
constexpr int HG_OB = 81920, HG_POB = 80;
static_assert(HG_END <= HG_OB && HG_OB + 512 * HG_POB <= RING_BYTES, "HGRN2 LDS");
static_assert(HG_END <= RING_BYTES, "hgrn LDS");
__device__ __forceinline__ void hgrn_prep_phase(Frame& F) {
    const int tid = F.tid; LAS float* TOT = (LAS float*)(F.lds + HG_TOT);
    GAS bf16* HQ = WSP(bf16, WS_HQ); GAS bf16* HF = WSP(bf16, WS_HF); GAS bf16* KT2 = OSP(bf16, OS_KT2); GAS float* RB = WSP(float, WS_RB);
    const GAS float* lbl = inp(F, 24); const int kp = tid & 63, tq = tid >> 6;
    unsigned fr_n[8], qr_n[8];
#define HP_LOAD(U) do { const int u_ = (U); const int gc_ = ((u_ >> 5) & 7) * 128 + 2 * kp; const size_t r0_ = (size_t)(u_ >> 8) * SEQ + (u_ & 31) * 64 + 8 * tq; \
        _Pragma("unroll") for (int i = 0; i < 8; ++i) { fr_n[i] = *(const GAS unsigned*)(HF + (r0_ + i) * 1024 + gc_); qr_n[i] = *(const GAS unsigned*)(HQ + (r0_ + i) * 1024 + gc_); } } while (0)
    if (F.vcu < 2048) HP_LOAD(F.vcu);
    for (int u = F.vcu; u < 2048; u += F.G) {
        const int h = (u >> 5) & 7, gc = h * 128 + 2 * kp; const size_t r0 = (size_t)(u >> 8) * SEQ + (u & 31) * 64 + 8 * tq;
        const float lb0 = __builtin_amdgcn_rcpf(1.0f + __expf(lbl[gc] - lbl[1024 + gc])), lb1 = __builtin_amdgcn_rcpf(1.0f + __expf(lbl[gc + 1] - lbl[1024 + gc + 1]));
        float qv[8][2], kd[8][2], bl[8][2]; float run0 = 0.f, run1 = 0.f;
#pragma unroll
        for (int i = 0; i < 8; ++i) { const float s0 = sigmf(bflo(fr_n[i])), s1 = sigmf(bfhi(fr_n[i]));
            kd[i][0] = (1.0f - lb0) * (1.0f - s0); kd[i][1] = (1.0f - lb1) * (1.0f - s1); qv[i][0] = bflo(qr_n[i]); qv[i][1] = bfhi(qr_n[i]);
            run0 += __logf(lb0 + (1.0f - lb0) * s0); run1 += __logf(lb1 + (1.0f - lb1) * s1); bl[i][0] = run0; bl[i][1] = run1; }
        LDS_BARRIER();
        *(LAS v2f*)(TOT + tq * 128 + 2 * kp) = v2f{run0, run1};
        LDS_BARRIER();
        if (u + F.G < 2048) HP_LOAD(u + F.G);
        float off0 = 0.f, off1 = 0.f, rr0 = 0.f, rr1 = 0.f, bb0 = 0.f, bb1 = 0.f;
#pragma unroll
        for (int q = 0; q < 8; ++q) { const v2f tv = *(const LAS v2f*)(TOT + q * 128 + 2 * kp); if (q < tq) { off0 += tv[0]; off1 += tv[1]; } if (q < 4) { rr0 += tv[0]; rr1 += tv[1]; } bb0 += tv[0]; bb1 += tv[1]; }
        unsigned kw0[4], kw1[4];
#pragma unroll
        for (int i = 0; i < 8; ++i) { const float e0 = __expf(bl[i][0] + off0 - rr0), e1 = __expf(bl[i][1] + off1 - rr1);
            *(GAS unsigned*)(HQ + (r0 + i) * 1024 + gc) = pk2(qv[i][0] * e0, qv[i][1] * e1);
            const unsigned kk = pk2(kd[i][0] * __builtin_amdgcn_rcpf(e0), kd[i][1] * __builtin_amdgcn_rcpf(e1)); *(GAS unsigned*)(HF + (r0 + i) * 1024 + gc) = kk;
            if (i & 1) { kw0[i >> 1] |= kk << 16; kw1[i >> 1] |= kk & 0xffff0000u; } else { kw0[i >> 1] = kk & 0xffffu; kw1[i >> 1] = kk >> 16; } }
        GAS bf16* kt = KT2 + ((size_t)u * 128 + 2 * kp) * 64 + 8 * tq; *(GAS v4u*)kt = v4u{kw0[0], kw0[1], kw0[2], kw0[3]}; *(GAS v4u*)(kt + 64) = v4u{kw1[0], kw1[1], kw1[2], kw1[3]};
        if (tq == 0) { *(GAS v2f*)(RB + (size_t)u * 256 + 2 * kp) = v2f{rr0, rr1}; *(GAS v2f*)(RB + (size_t)u * 256 + 128 + 2 * kp) = v2f{bb0, bb1}; }
    }
#undef HP_LOAD
}
template <bool DRY> __device__ __forceinline__ void hgrn_unit(Frame& F, int b, int h, int vq) {
    const int tid = F.tid, lane = F.lane, w = F.wave, r16 = lane & 15, g4 = lane >> 4;
    LAS unsigned char* L = F.lds;
    const GAS bf16* HQ = WSP(bf16, WS_HQ); const GAS bf16* HF = WSP(bf16, WS_HF); GAS bf16* HI = WSP(bf16, WS_HI); GAS long long* HSS = OSP(long long, OS_HSS); const GAS bf16* KT2 = OSP(bf16, OS_KT2); const GAS float* RB = WSP(float, WS_RB);
    const size_t rowbase = (size_t)b * SEQ; const int ubase = (b * 8 + h) * 32;
    f32x4v S[2]; S[0] = f32x4v{0.f, 0.f, 0.f, 0.f}; S[1] = S[0];
    __syncthreads();
    for (int i = tid; i < 64 * HG_PS / 4; i += NTHREADS) ((LAS unsigned*)(L + HG_AS))[i] = 0u;
    const int tr = w >> 1, vc = w & 1;
    v4u q0A, q1A, k0A, k1A, t0A, t1A, q0B, q1B, k0B, k1B, t0B, t1B, rbA, rbB; v2u iiA, iiB;
#define HS_LOAD(C, q0_, q1_, k0_, k1_, t0_, t1_, ii_, rb_) do { const size_t row_ = rowbase + (size_t)(C) * 64 + (tid >> 3); const GAS bf16* qp_ = HQ + row_ * 1024 + h * 128 + (tid & 7) * 16; const GAS bf16* kp_ = HF + row_ * 1024 + h * 128 + (tid & 7) * 16; \
        q0_ = *(const GAS v4u*)qp_; q1_ = *(const GAS v4u*)(qp_ + 8); k0_ = *(const GAS v4u*)kp_; k1_ = *(const GAS v4u*)(kp_ + 8); \
        const GAS bf16* tp_ = KT2 + ((size_t)(ubase + (C)) * 128 + (tid >> 2)) * 64 + (tid & 3) * 16; t0_ = *(const GAS v4u*)tp_; t1_ = *(const GAS v4u*)(tp_ + 8); \
        ii_ = *(const GAS v2u*)(HI + row_ * 1024 + h * 128 + vq * 32 + (tid & 7) * 4); \
        rb_ = *(const GAS v4u*)(RB + (size_t)(ubase + (C)) * 256 + (tid & 63) * 4); } while (0)
#define HS_CHUNK(CC, q0_, q1_, k0_, k1_, t0_, t1_, ii_, rb_, rbn_) do { \
        LDS_BARRIER(); \
        const f32x4v rv_ = *(const LAS f32x4v*)(L + HG_TOT + ((CC) & 1) * 1024 + (16 * w + 4 * g4) * 4), bv_ = *(const LAS f32x4v*)(L + HG_TOT + ((CC) & 1) * 1024 + 512 + (16 * w + 4 * g4) * 4); \
        {   LAS unsigned char* qd = L + HG_QT + (tid >> 3) * HG_PQ + (tid & 7) * 32; *(LAS v4u*)qd = q0_; *(LAS v4u*)(qd + 16) = q1_; \
            LAS unsigned char* kd_ = L + HG_KT + (tid >> 3) * HG_PQ + (tid & 7) * 32; *(LAS v4u*)kd_ = k0_; *(LAS v4u*)(kd_ + 16) = k1_; \
            LAS unsigned char* td = L + HG_KTT + (tid >> 2) * HG_PS + (tid & 3) * 32; *(LAS v4u*)td = t0_; *(LAS v4u*)(td + 16) = t1_; \
            LAS unsigned char* id = L + HG_IT + ((tid & 7) * 4) * HG_PS + (tid >> 3) * 2; \
            *(LAS unsigned short*)(id) = (unsigned short)(ii_.x & 0xffffu); *(LAS unsigned short*)(id + HG_PS) = (unsigned short)(ii_.x >> 16); *(LAS unsigned short*)(id + 2 * HG_PS) = (unsigned short)(ii_.y & 0xffffu); *(LAS unsigned short*)(id + 3 * HG_PS) = (unsigned short)(ii_.y >> 16); } \
        HS_LOAD(((CC) + 2 < 32 ? (CC) + 2 : 31), q0_, q1_, k0_, k1_, t0_, t1_, ii_, rb_);         \
        float e63[4], e63r[4]; \
        {   float er[4]; \
_Pragma("unroll") \
            for (int rg = 0; rg < 4; ++rg) { er[rg] = __expf(rv_[rg]); e63[rg] = __expf(bv_[rg]); e63r[rg] = __expf(bv_[rg] - rv_[rg]); } \
_Pragma("unroll") \
            for (int cc = 0; cc < 2; ++cc) *(LAS v2u*)(L + HG_ST + (16 * cc + r16) * HG_PQ + (16 * w + 4 * g4) * 2) = v2u{pk2(S[cc][0] * er[0], S[cc][1] * er[1]), pk2(S[cc][2] * er[2], S[cc][3] * er[3])}; } \
        LDS_BARRIER(); \
        f32x4v oacc = f32x4v{0.f, 0.f, 0.f, 0.f}; \
        {   bf16x8 qa[4]; \
_Pragma("unroll") \
            for (int kk = 0; kk < 4; ++kk) qa[kk] = *(const LAS bf16x8*)(L + HG_QT + (16 * tr + r16) * HG_PQ + (32 * kk + 8 * g4) * 2); \
_Pragma("unroll") \
            for (int cc = 0; cc < 2; ++cc) { const int tc = 2 * vc + cc; \
                if (tc <= tr) { f32x4v acc = f32x4v{0.f, 0.f, 0.f, 0.f}; \
_Pragma("unroll") \
                    for (int kk = 0; kk < 4; ++kk) { const bf16x8 kb = *(const LAS bf16x8*)(L + HG_KT + (16 * tc + r16) * HG_PQ + (32 * kk + 8 * g4) * 2); acc = __builtin_amdgcn_mfma_f32_16x16x32_bf16(qa[kk], kb, acc, 0, 0, 0); } \
_Pragma("unroll") \
                    for (int rg = 0; rg < 4; ++rg) { const int t = 16 * tr + 4 * g4 + rg, s_ = 16 * tc + r16; *(LAS unsigned short*)(L + HG_AS + t * HG_PS + s_ * 2) = (unsigned short)f2bf(s_ <= t ? acc[rg] : 0.f); } } } \
_Pragma("unroll") \
            for (int kk = 0; kk < 4; ++kk) { const bf16x8 sb = *(const LAS bf16x8*)(L + HG_ST + (16 * vc + r16) * HG_PQ + (32 * kk + 8 * g4) * 2); oacc = __builtin_amdgcn_mfma_f32_16x16x32_bf16(qa[kk], sb, oacc, 0, 0, 0); } \
        } \
        f32x4v dS[2]; \
_Pragma("unroll") \
        for (int cc = 0; cc < 2; ++cc) { dS[cc] = f32x4v{0.f, 0.f, 0.f, 0.f}; \
_Pragma("unroll") \
            for (int kk = 0; kk < 2; ++kk) { const bf16x8 ka = *(const LAS bf16x8*)(L + HG_KTT + (16 * w + r16) * HG_PS + (32 * kk + 8 * g4) * 2); const bf16x8 ib = *(const LAS bf16x8*)(L + HG_IT + (16 * cc + r16) * HG_PS + (32 * kk + 8 * g4) * 2); \
                dS[cc] = __builtin_amdgcn_mfma_f32_16x16x32_bf16(ka, ib, dS[cc], 0, 0, 0); } } \
_Pragma("unroll") \
        for (int cc = 0; cc < 2; ++cc) \
_Pragma("unroll") \
            for (int rg = 0; rg < 4; ++rg) S[cc][rg] = e63[rg] * S[cc][rg] + e63r[rg] * dS[cc][rg]; \
        LDS_BARRIER(); \
        if (tid < 64) *(LAS v4u*)(L + HG_TOT + (((CC) + 1) & 1) * 1024 + tid * 16) = rbn_;                    \
_Pragma("unroll") \
        for (int kk = 0; kk < 2; ++kk) { const bf16x8 aa = *(const LAS bf16x8*)(L + HG_AS + (16 * tr + r16) * HG_PS + (32 * kk + 8 * g4) * 2); const bf16x8 ib = *(const LAS bf16x8*)(L + HG_IT + (16 * vc + r16) * HG_PS + (32 * kk + 8 * g4) * 2); \
            oacc = __builtin_amdgcn_mfma_f32_16x16x32_bf16(aa, ib, oacc, 0, 0, 0); } \
_Pragma("unroll") \
        for (int rg = 0; rg < 4; ++rg) *(LAS unsigned short*)(L + HG_OB + (((CC) & 7) * 64 + 16 * tr + 4 * g4 + rg) * HG_POB + (16 * vc + r16) * 2) = (unsigned short)f2bf(oacc[rg]); \
    } while (0)
    HS_LOAD(0, q0A, q1A, k0A, k1A, t0A, t1A, iiA, rbA);
    HS_LOAD(1, q0B, q1B, k0B, k1B, t0B, t1B, iiB, rbB);
    if (tid < 64) *(LAS v4u*)(L + HG_TOT + tid * 16) = rbA;
#pragma unroll
    for (int blk = 0; blk < 4; ++blk) {
#pragma unroll 1
        for (int c = 8 * blk; c < 8 * blk + 8; c += 2) {
            HS_CHUNK(c, q0A, q1A, k0A, k1A, t0A, t1A, iiA, rbA, rbB);
            HS_CHUNK(c + 1, q0B, q1B, k0B, k1B, t0B, t1B, iiB, rbB, rbA);
        }
        LDS_BARRIER();
        {
            const size_t row = rowbase + (size_t)blk * 512 + tid; const LAS unsigned char* op = L + HG_OB + tid * HG_POB; float ss = 0.f;
            GAS bf16* dst = (DRY ? WSP(bf16, WS_DRY) : HI) + (DRY ? (row & 2047) : row) * 1024 + h * 128 + vq * 32;
#pragma unroll
            for (int q = 0; q < 4; ++q) { const v4u v = *(const LAS v4u*)(op + 16 * q); *(GAS v4u*)(dst + 8 * q) = v;
#pragma unroll
                for (int e = 0; e < 8; ++e) { const float x = bfel(v, e); ss += x * x; } }
            if (!DRY) __hip_atomic_fetch_add(HSS + row * 8 + h, fx20(ss), __ATOMIC_RELAXED, __HIP_MEMORY_SCOPE_AGENT);
            __builtin_amdgcn_s_waitcnt(0x0F70);
        }
    }
#undef HS_CHUNK
#undef HS_LOAD
}
template <bool DRY> __device__ __forceinline__ void hgrn_phase(Frame& F) {
    for (int u = F.vcu; u < 256; u += F.G) hgrn_unit<DRY>(F, u >> 5, (u >> 2) & 7, u & 3);
}
__device__ __forceinline__ void hgrn_post_phase(Frame& F) {
    const int gw = F.vcu * NWAVES + F.wave, NGW = F.G * NWAVES, c0 = F.lane * 8; GAS bf16* HI = WSP(bf16, WS_HI); const GAS bf16* HG = WSP(bf16, WS_HG); const GAS long long* HSS = OSP(long long, OS_HSS); const GAS float* nw = inp(F, 23);
    float nwv[2][8];
#pragma unroll
    for (int j = 0; j < 2; ++j)
#pragma unroll
        for (int e = 0; e < 8; ++e) nwv[j][e] = nw[c0 + 512 * j + e];
    for (int m0 = gw; m0 < M; m0 += 4 * NGW) { v4u ov[4][2], gv[4][2]; long long hs[4][2];
#pragma unroll
        for (int k = 0; k < 4; ++k) { const int mk = m0 + k * NGW, m = mk < M ? mk : M - 1;
#pragma unroll
            for (int j = 0; j < 2; ++j) { const int c = c0 + 512 * j; hs[k][j] = HSS[(size_t)m * 8 + (c >> 7)]; ov[k][j] = *(const GAS v4u*)(HI + (size_t)m * 1024 + c); gv[k][j] = *(const GAS v4u*)(HG + (size_t)m * 1024 + c); } }
#pragma unroll
        for (int k = 0; k < 4; ++k) { const int m = m0 + k * NGW; if (m < M) {
#pragma unroll
            for (int j = 0; j < 2; ++j) { const int c = c0 + 512 * j; const float rs = 1.0f / sqrtf(unfx20(hs[k][j]) * (1.0f / 128.0f) + 1e-6f);
                const unsigned ow[4] = {ov[k][j].x, ov[k][j].y, ov[k][j].z, ov[k][j].w}, gw4[4] = {gv[k][j].x, gv[k][j].y, gv[k][j].z, gv[k][j].w}; unsigned rw[4];
#pragma unroll
                for (int e = 0; e < 4; ++e) { const float o0 = __builtin_bit_cast(float, ow[e] << 16), o1 = __builtin_bit_cast(float, ow[e] & 0xffff0000u), g0 = __builtin_bit_cast(float, gw4[e] << 16), g1 = __builtin_bit_cast(float, gw4[e] & 0xffff0000u);
                    rw[e] = pk2(o0 * rs * nwv[j][2 * e] * sigmf(g0), o1 * rs * nwv[j][2 * e + 1] * sigmf(g1)); }
                *(GAS v4u*)(HI + (size_t)m * 1024 + c) = v4u{rw[0], rw[1], rw[2], rw[3]}; } } }
    }
}

__device__ __forceinline__ void final_phase(Frame& F) {
    const int gw = F.vcu * NWAVES + F.wave, NGW = F.G * NWAVES, c0 = F.lane * 8; const GAS float* fg = inp(F, 25); const GAS pg8::ssq_t* ssq = SSQ_SLOT(6); const GAS bf16* XB = WSP(bf16, WS_XB);
    f32x4 g[2][2];
#pragma unroll
    for (int j = 0; j < 2; ++j) { g[j][0] = *(const GAS f32x4*)(fg + c0 + 512 * j); g[j][1] = *(const GAS f32x4*)(fg + c0 + 512 * j + 4); }
    for (int m0 = gw; m0 < M; m0 += 4 * NGW) { v4u xr[4][2]; pg8::ssq_t sq[4];
#pragma unroll
        for (int k = 0; k < 4; ++k) { const int mk = m0 + k * NGW, m = mk < M ? mk : M - 1; sq[k] = ssq[m];
#pragma unroll
            for (int j = 0; j < 2; ++j) xr[k][j] = *(const GAS v4u*)(XB + (size_t)m * D + c0 + 512 * j); }
#pragma unroll
        for (int k = 0; k < 4; ++k) { const int m = m0 + k * NGW; if (m < M) { const float rs = pg8::ssq_to_rstd(sq[k]);
#pragma unroll
            for (int j = 0; j < 2; ++j) { float xv[8]; unpack8(xr[k][j], xv); GAS f32x4* o = (GAS f32x4*)(F.out + (size_t)m * D + c0 + 512 * j);
                o[0] = (f32x4){xv[0] * rs * g[j][0][0], xv[1] * rs * g[j][0][1], xv[2] * rs * g[j][0][2], xv[3] * rs * g[j][0][3]}; o[1] = (f32x4){xv[4] * rs * g[j][1][0], xv[5] * rs * g[j][1][1], xv[6] * rs * g[j][1][2], xv[7] * rs * g[j][1][3]}; } } }
    }
}

#ifndef PROBE_DBL
#define PROBE_DBL 0
#endif
#ifndef MK_N_LAUNCHES
#define MK_N_LAUNCHES 1
#endif
constexpr int NPHASE = 17;
__global__ void __launch_bounds__(NTHREADS, 2) hyb_fwd(Args args) {
    extern __shared__ __attribute__((aligned(16))) unsigned char lds[];
    Frame F0;
    F0.lds = (LAS unsigned char*)lds; F0.MISC = (volatile LAS unsigned*)(F0.lds + MISC_OFF);
    F0.tid = threadIdx.x; F0.lane = F0.tid & 63; F0.wave = __builtin_amdgcn_readfirstlane(F0.tid >> 6);
    F0.G = gridDim.x; { const int bx = blockIdx.x; F0.vcu = (F0.G % 8 == 0) ? (bx % 8) * (F0.G / 8) + bx / 8 : bx; }
    F0.out = (GAS float*)args.out; F0.ws = (GAS unsigned char*)args.ws; F0.ctl = (gu32*)(args.ws + WS_CTL);
    for (int u = F0.tid; u < (LDS_BYTES - LDSCTL_OFF) / 4; u += NTHREADS) ((LAS unsigned*)(F0.lds + LDSCTL_OFF))[u] = 0u;
    __syncthreads();
    if (F0.tid == 0) {
#pragma unroll
        for (int i = 0; i < N_IN; ++i) ((LAS unsigned long long*)(F0.lds + PTAB_OFF))[i] = (unsigned long long)args.in[i]; }
    __syncthreads();
    XcdBarrier bar; bar.bar = (unsigned*)(F0.ctl + CW_BAR); bar.x = 0; bar.st = nullptr;
    if (MK_N_LAUNCHES == 1) bar = xcd_barrier_post((unsigned*)(F0.ctl + CW_BAR), F0.MISC + 8);
    const int lo = args.ph_lo, hi = args.ph_hi;
#define IN(k) (MK_N_LAUNCHES == 1 || in_range((k), lo, hi))
#define GBAR() do { asm volatile("" : "+s"(bar.bar), "+s"(bar.x)); xcd_barrier(bar); } while (0)
#define SEAM(k) do { if (MK_N_LAUNCHES == 1) GBAR(); } while (0)
    if (IN(0)) { if (PROBE_DBL & 1) { { PHASE_FRAME(F); prologue_phase(F); } GBAR(); } PHASE_FRAME(F); prologue_phase(F); SEAM(0); }
#pragma unroll
    for (int f = 0; f < 4; ++f) {
        const int pu = (f == 0) ? 1 : (f == 1) ? 7 : (f == 2) ? 9 : 14;
        if (IN(pu)) { PHASE_FRAME(F);
            pg8::Gemm g{(const bf16*)WSP(bf16, WS_XB), (const bf16*)WSP(bf16, WS_WUP + f * W_UP_BYTES), M, 2 * FF, D}; pg8::StaticOrder S; S.init(M, 2 * FF, F.G, (int)blockIdx.x);
            pg8::EpiSwiglu E{WSP(bf16, WS_H), FF, SSQ_SLOT((f == 0) ? 0 : (f == 1) ? 2 : (f == 2) ? 3 : 5)};
            if (PROBE_DBL & (2 | 128)) { pg8::gemm_phase<pg8::EpiSwiglu, pg8::StaticOrder, true, true>(F.lds, g, S, E); GBAR(); }
            pg8::gemm_phase<pg8::EpiSwiglu, pg8::StaticOrder, true, true>(F.lds, g, S, E);
            {
                constexpr int UP_IDLE0 = (M / 256) * (2 * FF / 256) % 256; static_assert(UP_IDLE0 == 128, "idle tail of the up GEMM");
                if ((int)blockIdx.x >= UP_IDLE0 && F.G == 256) { const int rk = ((int)blockIdx.x - UP_IDLE0) * NWAVES + F.wave, nr = (256 - UP_IDLE0) * NWAVES;
                    if (f == 0) convert_items(F, CV_G1, CV_G2, rk, nr); else if (f == 1) convert_items(F, CV_G3, CV_G4, rk, nr); else if (f == 2) convert_items(F, CV_G4, CV_G5, rk, nr); else convert_items(F, CV_G5, CV_END, rk, nr); }
                else if (F.G != 256) { const int gw_ = (int)blockIdx.x * NWAVES + F.wave, nr_ = F.G * NWAVES;
                    if (f == 0) convert_items(F, CV_G1, CV_G2, gw_, nr_); else if (f == 1) convert_items(F, CV_G3, CV_G4, gw_, nr_); else if (f == 2) convert_items(F, CV_G4, CV_G5, gw_, nr_); else convert_items(F, CV_G5, CV_END, gw_, nr_); } }
            SEAM(pu);
        }
        if (IN(pu + 1)) { PHASE_FRAME(F);
            pg8::Gemm g{(const bf16*)WSP(bf16, WS_H), (const bf16*)WSP(bf16, WS_WDN + f * W_DN_BYTES), M, D, FF}; pg8::StaticOrder S; S.init(M, D, F.G, (int)blockIdx.x);
            pg8::EpiResid E{WSP(bf16, WS_XB), SSQ_SLOT((f == 0) ? 1 : (f == 1) ? 3 : (f == 2) ? 4 : 6), 0.5f};
            if (PROBE_DBL & (2 | 256)) { pg8::EpiResid E0 = E; E0.alpha = 0.f; pg8::gemm_phase<pg8::EpiResid, pg8::StaticOrder, true, true>(F.lds, g, S, E0); GBAR(); }
            pg8::gemm_phase<pg8::EpiResid, pg8::StaticOrder, true, true>(F.lds, g, S, E);
            SEAM(pu + 1);
        }
        if (f == 0) {
            if (IN(3)) { PHASE_FRAME(F);
                pg8::Gemm g{(const bf16*)WSP(bf16, WS_XB), (const bf16*)WSP(bf16, WS_WEVIN), M, EV_IN, D}; pg8::StaticOrder S; S.init(M, EV_IN, F.G, (int)blockIdx.x);
                pg8::EpiProj E{WSP(bf16, WS_PR), RW_COLS, RW_COLS / 256, WSP(bf16, WS_QB), 512, 2, (size_t)M * 512, SSQ_SLOT(1), WSP(float, WS_KMEAN), RW_COLS / 256 + 2};
                if (PROBE_DBL & (2 | 512)) { pg8::EpiProj E0 = E; E0.kmean = nullptr; pg8::gemm_phase<pg8::EpiProj, pg8::StaticOrder, true, true>(F.lds, g, S, E0); GBAR(); }
                pg8::gemm_phase<pg8::EpiProj, pg8::StaticOrder, true, true>(F.lds, g, S, E);
                {
                    if ((int)blockIdx.x >= 64 && F.G == 256) convert_items(F, CV_G2, CV_G3, ((int)blockIdx.x - 64) * NWAVES + F.wave, 192 * NWAVES);
                    else if (F.G != 256) convert_items(F, CV_G2, CV_G3, (int)blockIdx.x * NWAVES + F.wave, F.G * NWAVES); }
                SEAM(3);
            }
                        if (IN(5)) { if (PROBE_DBL & 4) { { PHASE_FRAME(F); lora_kmean_phase(F); } GBAR(); } { PHASE_FRAME(F); lora_kmean_phase(F); } if (PROBE_DBL & 8) { { PHASE_FRAME(F); moba_phase(F); } GBAR(); } { PHASE_FRAME(F); moba_phase(F); } if (MK_N_LAUNCHES == 1) GBAR(); if (PROBE_DBL & 4096) { { PHASE_FRAME(F); rwkv_gram_phase(F); } GBAR(); } { PHASE_FRAME(F); rwkv_gram_phase(F); } GBAR(); if (PROBE_DBL & 16) { { PHASE_FRAME(F); rwkv_cscan_phase<true, false>(F); } GBAR(); } if (PROBE_DBL & 8192) { { PHASE_FRAME(F); rwkv_cscan_phase<true, true>(F); } GBAR(); } { PHASE_FRAME(F); rwkv_cscan_phase(F); } if (MK_N_LAUNCHES == 1) GBAR(); { PHASE_FRAME(F); rwkv_post_phase(F); } SEAM(5); }
            if (IN(6)) { PHASE_FRAME(F);
                pg8::Gemm g{(const bf16*)WSP(bf16, WS_Y), (const bf16*)WSP(bf16, WS_WEVOUT), M, D, D}; pg8::StaticOrder S; S.init(M, D, F.G, (int)blockIdx.x);
                pg8::EpiResid E{WSP(bf16, WS_XB), SSQ_SLOT(2), 1.0f};
                if (PROBE_DBL & (2 | 256)) { pg8::EpiResid E0 = E; E0.alpha = 0.f; pg8::gemm_phase<pg8::EpiResid, pg8::StaticOrder, true, true>(F.lds, g, S, E0); GBAR(); }
                pg8::gemm_phase<pg8::EpiResid, pg8::StaticOrder, true, true>(F.lds, g, S, E);
                SEAM(6);
            }
        }
        if (f == 2) {
            if (IN(11)) { PHASE_FRAME(F);
                pg8::Gemm g{(const bf16*)WSP(bf16, WS_XB), (const bf16*)WSP(bf16, WS_WODIN), M, OD_IN, D}; pg8::StaticOrder S; S.init(M, OD_IN, F.G, (int)blockIdx.x);
                pg8::EpiProj E{nullptr, 0, 0, WSP(bf16, WS_HQ), 1024, 4, (size_t)M * 1024, SSQ_SLOT(4), nullptr, 0};
                if (PROBE_DBL & (2 | 512)) { pg8::EpiProj E0 = E; E0.kmean = nullptr; pg8::gemm_phase<pg8::EpiProj, pg8::StaticOrder, true, true>(F.lds, g, S, E0); GBAR(); }
                pg8::gemm_phase<pg8::EpiProj, pg8::StaticOrder, true, true>(F.lds, g, S, E);
                SEAM(11);
            }
            if (IN(12)) { { PHASE_FRAME(F); hgrn_prep_phase(F); } GBAR(); if (PROBE_DBL & 32) { { PHASE_FRAME(F); hgrn_phase<true>(F); } GBAR(); } { PHASE_FRAME(F); hgrn_phase<false>(F); } if (MK_N_LAUNCHES == 1) GBAR(); { PHASE_FRAME(F); hgrn_post_phase(F); } SEAM(12); }
            if (IN(13)) { PHASE_FRAME(F);
                pg8::Gemm g{(const bf16*)WSP(bf16, WS_HI), (const bf16*)WSP(bf16, WS_WODOUT), M, D, D}; pg8::StaticOrder S; S.init(M, D, F.G, (int)blockIdx.x);
                pg8::EpiResid E{WSP(bf16, WS_XB), SSQ_SLOT(5), 1.0f};
                if (PROBE_DBL & (2 | 256)) { pg8::EpiResid E0 = E; E0.alpha = 0.f; pg8::gemm_phase<pg8::EpiResid, pg8::StaticOrder, true, true>(F.lds, g, S, E0); GBAR(); }
                pg8::gemm_phase<pg8::EpiResid, pg8::StaticOrder, true, true>(F.lds, g, S, E);
                SEAM(13);
            }
        }
    }
    if (PROBE_DBL & 64) { for (int i_ = 0; i_ < 20; ++i_) GBAR(); }
    if (IN(16)) { PHASE_FRAME(F); final_phase(F); }
#undef IN
#undef SEAM
}

extern "C" void kernel_launch(void* const* d_in, const int* in_sizes, int n_in, void* d_out, int out_size, void* d_ws, size_t ws_size, hipStream_t stream) {
    static int grid = 0;
    if (grid == 0) {
        if (n_in != N_IN || in_sizes[0] != M * D || out_size != M * D || ws_size < WS_END) { fprintf(stderr, "kernel_launch: unexpected shapes (n_in %d in0 %d out %d ws %zu); nothing launched\n", n_in, n_in > 0 ? in_sizes[0] : -1, out_size, ws_size); grid = -1; return; }
        int dev = 0, cus = 0, per_cu = 0;
        if (hipGetDevice(&dev) != hipSuccess || hipDeviceGetAttribute(&cus, hipDeviceAttributeMultiprocessorCount, dev) != hipSuccess) { grid = -1; return; }
        if (hipFuncSetAttribute((const void*)hyb_fwd, hipFuncAttributeMaxDynamicSharedMemorySize, LDS_BYTES) != hipSuccess) { fprintf(stderr, "kernel_launch: hipFuncSetAttribute failed\n"); grid = -1; return; }
        if (hipOccupancyMaxActiveBlocksPerMultiprocessor(&per_cu, (const void*)hyb_fwd, NTHREADS, LDS_BYTES) != hipSuccess || per_cu < 1) { fprintf(stderr, "kernel_launch: occupancy query says %d\n", per_cu); }
        (void)hipGetLastError();
        grid = cus;
    }
    if (grid < 0) return;
    if (hipMemsetAsync((char*)d_ws + WS_CTL, 0, CTL_ZERO_BYTES, stream) != hipSuccess) return;
    if (hipMemsetAsync((char*)d_out + OS_ZERO_BEGIN, 0, OS_ZERO_BYTES, stream) != hipSuccess) return;
    Args a{};
    for (int i = 0; i < N_IN; ++i) a.in[i] = (const float*)d_in[i];
    a.out = (float*)d_out; a.ws = (unsigned char*)d_ws;
    if (MK_N_LAUNCHES == 1) { a.ph_lo = 0; a.ph_hi = NPHASE; a.li = 0; hipLaunchKernelGGL(hyb_fwd, dim3(grid), dim3(NTHREADS), LDS_BYTES, stream, a); }
    else for (int li = 0; li < NPHASE; ++li) { a.ph_lo = li; a.ph_hi = li + 1; a.li = 0; hipLaunchKernelGGL(hyb_fwd, dim3(grid), dim3(NTHREADS), LDS_BYTES, stream, a); }
}
```

```cpp
#include <hip/hip_runtime.h>
#include <cstdio>
#include <cstdint>
namespace pg8 {
#define PG8_LAS __attribute__((address_space(3)))
typedef unsigned short bf16_t;
typedef short bf16x8 __attribute__((ext_vector_type(8)));
typedef float f32x4 __attribute__((ext_vector_type(4)));
typedef unsigned u32x4 __attribute__((ext_vector_type(4)));
constexpr int BM = 256, BK = 64, HALF = 128, HTB = HALF * BK * 2  , STAGE_BYTES = 8 * HTB, NXCD = 8, WGM = 8;

__host__ __device__ __forceinline__ int lds_byte(int r, int c) { const int st = (r >> 4) * 2 + (c >> 5), rr = r & 15, cc = c & 31, ob = rr * 64 + cc * 2; return st * 1024 + (ob ^ (((ob >> 9) & 1) << 5)); }
__host__ __device__ __forceinline__ void stage_rc(int b, int& R, int& C) { const int st = b / 1024, sb = b % 1024, swz = sb ^ (((sb >> 9) & 1) << 5); R = (st >> 1) * 16 + swz / 64; C = (st & 1) * 32 + (swz % 64) / 2; }
__host__ __device__ __forceinline__ int perm32(int rho) { const int n = rho >> 4, i = rho & 15; return 8 * (i >> 2) + 4 * n + (i & 3); }

struct Unit { int pm, pn; };
struct Gemm { const bf16_t* A; const bf16_t* Bt; int M, N, K; };

struct StaticOrder {
    int nM, nN, nwg, G, c;
    __host__ __device__ void init(int M, int N, int G_, int c_) { nM = M / BM; nN = N / BM; nwg = nM * nN; G = G_; c = c_; }
    __host__ __device__ bool next(int i, Unit& u) const {
        const long L = (long)i * G + c; if (L >= nwg) return false;
        int wgid = (int)L; { const int q = nwg / NXCD, r = nwg % NXCD, xcd = wgid % NXCD, off = wgid / NXCD; wgid = (xcd < r ? xcd * (q + 1) : r * (q + 1) + (xcd - r) * q) + off; }
        const int nig = WGM * nN, gid = wgid / nig, fm = gid * WGM, gsz = (nM - fm) < WGM ? (nM - fm) : WGM;
        u.pm = fm + ((wgid % nig) % gsz); u.pn = (wgid % nig) / gsz; return true;
    }
    __device__ __forceinline__ void a_ready(const Unit&) const {}
    __device__ __forceinline__ void done(const Unit&) const {}
};

__device__ __forceinline__ unsigned cvt_pk_bf16(float lo, float hi) { unsigned r; asm volatile("v_cvt_pk_bf16_f32 %0, %1, %2" : "=v"(r) : "v"(lo), "v"(hi)); return r; }
typedef float f32x2 __attribute__((ext_vector_type(2)));
#define PG8_GAS __attribute__((address_space(1)))
typedef unsigned long long ssq_t;
__device__ __forceinline__ float ssq_to_rstd(ssq_t v) { return __builtin_amdgcn_rsqf((float)v * (1.0f / (16777216.0f * 1024.0f)) + 1e-6f); }
__device__ __forceinline__ ssq_t ssq_fix(float s) { return (ssq_t)(s * 16777216.0f + 0.5f); }
__device__ __forceinline__ float row_rstd(const PG8_GAS ssq_t* ssq, int row) { return ssq_to_rstd(ssq[row]); }
__device__ __forceinline__ float silu_f(float x) { return x * __builtin_amdgcn_rcpf(1.0f + __builtin_amdgcn_exp2f(-1.4426950408889634f * x)); }
struct EpiSwiglu {
    static constexpr bool PERM = true, AFTER_DRAIN = false;
    PG8_GAS bf16_t* H; int ldh; const PG8_GAS ssq_t* ssq;
    __device__ __forceinline__ void operator()(const f32x4 (&acc)[2][2][4][2], const Unit& u, int wr, int wc, int fr, int fq) const {
        const int row0 = u.pm * BM + wr * 64 + fr, col0 = u.pn * HALF + wc * 32 + 8 * fq; ssq_t rsv[2][4];
#pragma unroll
        for (int ai = 0; ai < 2; ++ai)
#pragma unroll
            for (int m = 0; m < 4; ++m) rsv[ai][m] = ssq[row0 + ai * HALF + m * 16];
#pragma unroll
        for (int ai = 0; ai < 2; ++ai)
#pragma unroll
            for (int m = 0; m < 4; ++m) { const int row = row0 + ai * HALF + m * 16; const float rs = ssq_to_rstd(rsv[ai][m]), cexp = -1.4426950408889634f * rs, rs2 = rs * rs;
                typedef float v2f_ __attribute__((ext_vector_type(2))); u32x4 w; unsigned wv[4];
#pragma unroll
                for (int p = 0; p < 4; ++p) { const f32x4 gq = acc[ai][0][m][p >> 1], uq = acc[ai][1][m][p >> 1]; const v2f_ g = {gq[2 * (p & 1)], gq[2 * (p & 1) + 1]}, u = {uq[2 * (p & 1)], uq[2 * (p & 1) + 1]};
                    const v2f_ t = g * cexp; v2f_ d = {__builtin_amdgcn_exp2f(t.x), __builtin_amdgcn_exp2f(t.y)}; d = d + 1.0f; const v2f_ r = {__builtin_amdgcn_rcpf(d.x), __builtin_amdgcn_rcpf(d.y)};
                    const v2f_ o = (g * u) * (r * rs2); wv[p] = cvt_pk_bf16(o.x, o.y); }
                w.x = wv[0]; w.y = wv[1]; w.z = wv[2]; w.w = wv[3];
                *(PG8_GAS u32x4*)(H + (size_t)row * ldh + col0) = w; }
    }
};
struct EpiProj {
    static constexpr bool PERM = true, AFTER_DRAIN = false;
    PG8_GAS bf16_t* OA; int ldA; int ntA; PG8_GAS bf16_t* OB; int ldB; int tpB; size_t strideB; const PG8_GAS ssq_t* ssq; PG8_GAS float* kmean; int kt0;
    __device__ __forceinline__ void operator()(const f32x4 (&acc)[2][2][4][2], const Unit& u, int wr, int wc, int fr, int fq) const {
        const int row0 = u.pm * BM + wr * 64 + fr; PG8_GAS bf16_t* base; int ld, colt; f32x4 cs[2][2]; const bool km = kmean != nullptr && (unsigned)(u.pn - kt0) < 2u;
#pragma unroll
        for (int bj = 0; bj < 2; ++bj) { cs[bj][0] = (f32x4){0.f, 0.f, 0.f, 0.f}; cs[bj][1] = cs[bj][0]; }
        if (u.pn < ntA) { base = OA; ld = ldA; colt = u.pn * BM; } else { const int q = u.pn - ntA, t = q / tpB; base = OB + (size_t)t * strideB; ld = ldB; colt = (q - t * tpB) * BM; }
        const int col0 = colt + wc * 32 + 8 * fq; ssq_t rsv[2][4];
#pragma unroll
        for (int ai = 0; ai < 2; ++ai)
#pragma unroll
            for (int m = 0; m < 4; ++m) rsv[ai][m] = ssq[row0 + ai * HALF + m * 16];
#pragma unroll
        for (int ai = 0; ai < 2; ++ai)
#pragma unroll
            for (int m = 0; m < 4; ++m) { const int row = row0 + ai * HALF + m * 16; const float rs = ssq_to_rstd(rsv[ai][m]); PG8_GAS bf16_t* rowp = base + (size_t)row * ld + col0;
#pragma unroll
                for (int bj = 0; bj < 2; ++bj) { const f32x4 v0 = acc[ai][bj][m][0] * rs, v1 = acc[ai][bj][m][1] * rs; cs[bj][0] += v0; cs[bj][1] += v1;
                    u32x4 w; w.x = cvt_pk_bf16(v0[0], v0[1]); w.y = cvt_pk_bf16(v0[2], v0[3]); w.z = cvt_pk_bf16(v1[0], v1[1]); w.w = cvt_pk_bf16(v1[2], v1[3]);
                    *(PG8_GAS u32x4*)(rowp + bj * HALF) = w; } }
        if (km) {
            const int ck0 = (u.pn - kt0) * BM + wc * 32 + 8 * fq; PG8_GAS float* kb = kmean + (size_t)((u.pm >> 3) * 8) * 8 * 64 + (size_t)(u.pm & 7) * 64;
#pragma unroll
            for (int bj = 0; bj < 2; ++bj)
#pragma unroll
                for (int n = 0; n < 2; ++n)
#pragma unroll
                    for (int e = 0; e < 4; ++e) { float v = cs[bj][n][e]; v += __shfl_xor(v, 1); v += __shfl_xor(v, 2); v += __shfl_xor(v, 4); v += __shfl_xor(v, 8);
                        if (fr == 0) { const int ck = ck0 + bj * HALF + 4 * n + e; __builtin_amdgcn_global_atomic_fadd_f32(kb + (size_t)(ck >> 6) * 8 * 64 + (ck & 63), v * (1.0f / 256.0f)); } } }
    }
};
struct EpiResid {
    static constexpr bool PERM = false, AFTER_DRAIN = false;
    PG8_GAS bf16_t* XB; PG8_GAS ssq_t* ssq; float alpha;
    __device__ __forceinline__ void operator()(const f32x4 (&acc)[2][2][4][2], const Unit& u, int wr, int wc, int fr, int fq) const {
        typedef unsigned u32x2v __attribute__((ext_vector_type(2)));
        const int row0 = u.pm * BM + wr * 64 + fr, col0 = u.pn * BM + wc * 32 + 4 * fq;
        u32x2v bcur[2][2], bnxt[2][2];
#pragma unroll
        for (int bj = 0; bj < 2; ++bj)
#pragma unroll
            for (int n = 0; n < 2; ++n) bcur[bj][n] = *(const PG8_GAS u32x2v*)(XB + (size_t)row0 * 1024 + col0 + bj * HALF + n * 16);
#pragma unroll
        for (int g = 0; g < 8; ++g) { const int ai = g >> 2, m = g & 3; const int row = row0 + ai * HALF + m * 16; const size_t off = (size_t)row * 1024 + col0; float ss = 0.f;
            if (g < 7) { const int rown = row0 + ((g + 1) >> 2) * HALF + ((g + 1) & 3) * 16;
#pragma unroll
                for (int bj = 0; bj < 2; ++bj)
#pragma unroll
                    for (int n = 0; n < 2; ++n) bnxt[bj][n] = *(const PG8_GAS u32x2v*)(XB + (size_t)rown * 1024 + col0 + bj * HALF + n * 16); }
#pragma unroll
            for (int bj = 0; bj < 2; ++bj)
#pragma unroll
                for (int n = 0; n < 2; ++n) { const u32x2v bw = bcur[bj][n];
                    const f32x4 b = (f32x4){__builtin_bit_cast(float, bw.x << 16), __builtin_bit_cast(float, bw.x & 0xffff0000u), __builtin_bit_cast(float, bw.y << 16), __builtin_bit_cast(float, bw.y & 0xffff0000u)};
                    const f32x4 o = b + acc[ai][bj][m][n] * alpha; u32x2v w; w.x = cvt_pk_bf16(o[0], o[1]); w.y = cvt_pk_bf16(o[2], o[3]); *(PG8_GAS u32x2v*)(XB + off + bj * HALF + n * 16) = w;
                    const float r0 = __builtin_bit_cast(float, w.x << 16), r1 = __builtin_bit_cast(float, w.x & 0xffff0000u), r2 = __builtin_bit_cast(float, w.y << 16), r3 = __builtin_bit_cast(float, w.y & 0xffff0000u);
                    ss += (r0 * r0 + r1 * r1) + (r2 * r2 + r3 * r3); }
            ss += __shfl_xor(ss, 16); ss += __shfl_xor(ss, 32);
            if (fq == 0 && alpha != 0.f) __hip_atomic_fetch_add(ssq + row, ssq_fix(ss), __ATOMIC_RELAXED, __HIP_MEMORY_SCOPE_AGENT);
#pragma unroll
            for (int bj = 0; bj < 2; ++bj)
#pragma unroll
                for (int n = 0; n < 2; ++n) bcur[bj][n] = bnxt[bj][n];
            asm volatile("" ::: "memory"); }
    }
};

template <class Epi, class Sched, bool ALIGN_EPI = false, bool SP2 = false>
__device__ __forceinline__ void gemm_phase(PG8_LAS unsigned char* lds, const Gemm g, const Sched& S, const Epi& E) {
    int tid_l = threadIdx.x; asm volatile("" : "+v"(tid_l));
    const int tid = tid_l, wid = __builtin_amdgcn_readfirstlane(tid >> 6), lane = tid & 63, wr = wid >> 2, wc = wid & 3, fr = lane & 15, fq = lane >> 4;
    const int K = g.K, nt = K / BK;
    unsigned voffA[2], voffB[2];
#pragma unroll
    for (int i = 0; i < 2; ++i) { int R, C; stage_rc(tid * 16 + i * 8192, R, C); const int Rb = Epi::PERM ? ((R & ~31) + perm32(R & 31)) : R;
        voffA[i] = (unsigned)(R * K + C) * 2u; voffB[i] = (unsigned)(Rb * K + C) * 2u; }
    const size_t kstep = (size_t)(BK * 2);
    const size_t hstep = (size_t)HALF * K * 2;
    const size_t tstep = 2 * hstep;
    const unsigned ldsw = (unsigned)wid * 1024u;
    const int aoff = lds_byte(wr * 64 + fr, fq * 8), boff = lds_byte(wc * 32 + fr, fq * 8);
#define PG8_SA(b, h) (((b) * 2 + (h)) * HTB)
#define PG8_SB(b, h) ((4 + (b) * 2 + (h)) * HTB)
#define PG8_STAGE(bufoff, gbase, voff) do { _Pragma("unroll") for (int _i = 0; _i < 2; ++_i) \
        __builtin_amdgcn_global_load_lds((const unsigned*)((const char*)(gbase) + (voff)[_i]), (PG8_LAS unsigned*)(lds + (bufoff) + ldsw + _i * 8192), 16, 0, 0); } while (0)
#define PG8_LDA(dst, b, h) do { _Pragma("unroll") for (int m = 0; m < 4; ++m) _Pragma("unroll") for (int k = 0; k < 2; ++k) dst[m][k] = *(const PG8_LAS bf16x8*)(lds + PG8_SA(b, h) + aoff + m * 2048 + k * 1024); } while (0)
#define PG8_LDB(dst, b, h) do { _Pragma("unroll") for (int n = 0; n < 2; ++n) _Pragma("unroll") for (int k = 0; k < 2; ++k) dst[n][k] = *(const PG8_LAS bf16x8*)(lds + PG8_SB(b, h) + boff + n * 2048 + k * 1024); } while (0)
#define PG8_MMA(ai, bj, At, Bt) do { __builtin_amdgcn_s_setprio(1); _Pragma("unroll") for (int m = 0; m < 4; ++m) _Pragma("unroll") for (int n = 0; n < 2; ++n) _Pragma("unroll") for (int k = 0; k < 2; ++k) \
        acc[ai][bj][m][n] = __builtin_amdgcn_mfma_f32_16x16x32_bf16(Bt[n][k], At[m][k], acc[ai][bj][m][n], 0, 0, 0); __builtin_amdgcn_s_setprio(0); } while (0)
#define PG8_WAIT_V(n) asm volatile("s_waitcnt vmcnt(" #n ")" ::: "memory")
#define PG8_WAIT_L(n) asm volatile("s_waitcnt lgkmcnt(" #n ")" ::: "memory")
#define PG8_BAR __builtin_amdgcn_s_barrier()
#define PG8_SCHED __builtin_amdgcn_sched_barrier(0)
    Unit cur, nxt; int ui = 0;
    if (!S.next(0, cur)) return;
    f32x4 acc[2][2][4][2];
#pragma unroll
    for (int a = 0; a < 2; ++a)
#pragma unroll
        for (int b = 0; b < 2; ++b)
#pragma unroll
            for (int m = 0; m < 4; ++m)
#pragma unroll
                for (int n = 0; n < 2; ++n) acc[a][b][m][n] = (f32x4){0.f, 0.f, 0.f, 0.f};
    bf16x8 At[4][2], B0[2][2], B1[2][2];
    const char* cA = (const char*)g.A + (size_t)cur.pm * tstep; const char* cB = (const char*)g.Bt + (size_t)cur.pn * tstep;
    S.a_ready(cur);
    if constexpr (SP2) {
        PG8_STAGE(PG8_SB(0, 0), cB, voffB); PG8_STAGE(PG8_SB(0, 1), cB + hstep, voffB); PG8_STAGE(PG8_SA(0, 0), cA, voffA); PG8_STAGE(PG8_SA(0, 1), cA + hstep, voffA);
        if (wr == 1) PG8_BAR;
        PG8_WAIT_V(2); PG8_BAR;
        PG8_STAGE(PG8_SB(1, 0), cB + kstep, voffB); PG8_STAGE(PG8_SA(1, 0), cA + kstep, voffA); PG8_STAGE(PG8_SB(1, 1), cB + hstep + kstep, voffB);
        PG8_WAIT_V(6); PG8_BAR;
    } else {
        PG8_STAGE(PG8_SB(0, 0), cB, voffB); PG8_STAGE(PG8_SA(0, 0), cA, voffA); PG8_STAGE(PG8_SB(0, 1), cB + hstep, voffB); PG8_STAGE(PG8_SA(0, 1), cA + hstep, voffA);
        if (wr == 1) PG8_BAR;
        PG8_WAIT_V(4); PG8_BAR;
        PG8_STAGE(PG8_SB(1, 0), cB + kstep, voffB); PG8_STAGE(PG8_SA(1, 0), cA + kstep, voffA); PG8_STAGE(PG8_SB(1, 1), cB + hstep + kstep, voffB);
        PG8_WAIT_V(6); PG8_BAR;
    }
    for (;;) {
        const bool has_next = S.next(ui + 1, nxt);
        const char* nA = has_next ? (const char*)g.A + (size_t)nxt.pm * tstep : cA; const char* nB = has_next ? (const char*)g.Bt + (size_t)nxt.pn * tstep : cB;
        for (int t = 0; t < nt; t += 2) {
            const bool last = (t == nt - 2);
            const char* a1 = cA + (size_t)(t + 1) * kstep;
            const char* a2 = last ? nA : cA + (size_t)(t + 2) * kstep; const char* b2 = last ? nB : cB + (size_t)(t + 2) * kstep;
            const char* a3 = a2 + kstep; const char* b3 = b2 + kstep;
            if (last && has_next) S.a_ready(nxt);
            if constexpr (SP2) {
            PG8_LDB(B0, 0, 0); PG8_LDB(B1, 0, 1); PG8_SCHED; PG8_LDA(At, 0, 0); PG8_STAGE(PG8_SA(1, 1), a1 + hstep, voffA);
            PG8_WAIT_V(8); PG8_WAIT_L(0); PG8_BAR; PG8_MMA(0, 0, At, B0); PG8_MMA(0, 1, At, B1); PG8_BAR; PG8_SCHED;
            PG8_LDA(At, 0, 1); PG8_STAGE(PG8_SB(0, 0), b2, voffB); PG8_STAGE(PG8_SB(0, 1), b2 + hstep, voffB); PG8_STAGE(PG8_SA(0, 0), a2, voffA);
            PG8_WAIT_V(8); PG8_WAIT_L(0); PG8_BAR; PG8_MMA(1, 0, At, B0); PG8_MMA(1, 1, At, B1); PG8_BAR; PG8_SCHED;
            PG8_LDB(B0, 1, 0); PG8_LDB(B1, 1, 1); PG8_SCHED; PG8_LDA(At, 1, 0); PG8_STAGE(PG8_SA(0, 1), a2 + hstep, voffA);
            PG8_WAIT_V(8); PG8_WAIT_L(0); PG8_BAR; PG8_MMA(0, 0, At, B0); PG8_MMA(0, 1, At, B1); PG8_BAR; PG8_SCHED;
            PG8_LDA(At, 1, 1); PG8_STAGE(PG8_SB(1, 0), b3, voffB); PG8_STAGE(PG8_SB(1, 1), b3 + hstep, voffB); PG8_STAGE(PG8_SA(1, 0), a3, voffA);
            PG8_WAIT_V(8); PG8_WAIT_L(0); PG8_BAR; PG8_MMA(1, 0, At, B0); PG8_MMA(1, 1, At, B1); PG8_BAR; PG8_SCHED;
            } else {
            PG8_LDB(B0, 0, 0); PG8_SCHED; PG8_LDA(At, 0, 0); PG8_STAGE(PG8_SA(1, 1), a1 + hstep, voffA);
            PG8_WAIT_L(8); PG8_BAR; PG8_WAIT_L(0); PG8_MMA(0, 0, At, B0); PG8_BAR; PG8_SCHED;
            PG8_LDB(B1, 0, 1); PG8_STAGE(PG8_SB(0, 0), b2, voffB);
            PG8_BAR; PG8_WAIT_L(0); PG8_MMA(0, 1, At, B1); PG8_BAR;
            PG8_LDA(At, 0, 1); PG8_STAGE(PG8_SA(0, 0), a2, voffA);
            PG8_BAR; PG8_WAIT_L(0); PG8_MMA(1, 0, At, B0); PG8_BAR; PG8_SCHED;
            PG8_STAGE(PG8_SB(0, 1), b2 + hstep, voffB);
            PG8_WAIT_V(6); PG8_BAR; PG8_MMA(1, 1, At, B1); PG8_BAR;
            PG8_LDB(B0, 1, 0); PG8_SCHED; PG8_LDA(At, 1, 0); PG8_STAGE(PG8_SA(0, 1), a2 + hstep, voffA);
            PG8_WAIT_L(8); PG8_BAR; PG8_WAIT_L(0); PG8_MMA(0, 0, At, B0); PG8_BAR; PG8_SCHED;
            PG8_LDB(B1, 1, 1); PG8_STAGE(PG8_SB(1, 0), b3, voffB);
            PG8_BAR; PG8_WAIT_L(0); PG8_MMA(0, 1, At, B1); PG8_BAR;
            PG8_LDA(At, 1, 1); PG8_STAGE(PG8_SA(1, 0), a3, voffA);
            PG8_BAR; PG8_WAIT_L(0); PG8_MMA(1, 0, At, B0); PG8_BAR; PG8_SCHED;
            PG8_STAGE(PG8_SB(1, 1), b3 + hstep, voffB);
            PG8_WAIT_V(6); PG8_BAR; PG8_MMA(1, 1, At, B1); PG8_BAR;
            }
        }
        if constexpr (ALIGN_EPI) { if (wr == 0) PG8_BAR; }
        if constexpr (!Epi::AFTER_DRAIN) { E(acc, cur, wr, wc, fr, fq); S.done(cur); }
        if (!has_next) break;
#pragma unroll
        for (int a = 0; a < 2; ++a)
#pragma unroll
            for (int b = 0; b < 2; ++b)
#pragma unroll
                for (int m = 0; m < 4; ++m)
#pragma unroll
                    for (int n = 0; n < 2; ++n) acc[a][b][m][n] = (f32x4){0.f, 0.f, 0.f, 0.f};
        cur = nxt; cA = nA; cB = nB; ++ui;
        if constexpr (ALIGN_EPI) { if (wr == 1) PG8_BAR; }
    }
    PG8_WAIT_V(0);
    if constexpr (!ALIGN_EPI) { if (wr == 0) PG8_BAR; }
    PG8_BAR;
    if constexpr (Epi::AFTER_DRAIN) { E.fused(acc, cur, wr, wc, fr, fq, lds, wid, lane); S.done(cur); }
#undef PG8_SA
#undef PG8_SB
#undef PG8_STAGE
#undef PG8_LDA
#undef PG8_LDB
#undef PG8_MMA
#undef PG8_WAIT_V
#undef PG8_WAIT_L
#undef PG8_BAR
#undef PG8_SCHED
}
}

#define GAS __attribute__((address_space(1)))
#define LAS __attribute__((address_space(3)))
typedef unsigned short bf16;
typedef unsigned v4u __attribute__((ext_vector_type(4)));
typedef float f32x4 __attribute__((ext_vector_type(4)));
typedef short bf16x8 __attribute__((ext_vector_type(8)));
typedef GAS unsigned gu32;
typedef GAS unsigned long long gu64;
#define RLX_AGENT __ATOMIC_RELAXED, __HIP_MEMORY_SCOPE_AGENT
#define LDS_WAIT() asm volatile("s_waitcnt lgkmcnt(0)" ::: "memory")
#define VM_WAIT() asm volatile("s_waitcnt vmcnt(0)" ::: "memory")
__device__ __forceinline__ unsigned long long rt() { return __builtin_amdgcn_s_memrealtime(); }
typedef float f32x2_t __attribute__((ext_vector_type(2))); typedef __bf16 bf16x2_t __attribute__((ext_vector_type(2)));
__device__ __forceinline__ unsigned pk2(float lo, float hi) { const f32x2_t v = {lo, hi}; return __builtin_bit_cast(unsigned, __builtin_convertvector(v, bf16x2_t)); }
__device__ __forceinline__ unsigned f2bf(float f) { return pk2(f, f) & 0xffffu; }
#define XB_TMO      128
#define XB_XCNT(j)  (256  + 64 * (j))
#define XB_XSUB(j)  (1280 + 64 * (j))
#define XB_XGEN(j)  (2304 + 64 * (j))
#define XB_TOP      3328
#define XB_TOPGEN   3392
#define XCD_BAR_WORDS 3456
#define XB_SPIN_CAP (1u << 18)

__device__ __forceinline__ unsigned xb_ld(unsigned* p)              { return __hip_atomic_load(p, __ATOMIC_RELAXED, __HIP_MEMORY_SCOPE_AGENT); }
__device__ __forceinline__ unsigned xb_add(unsigned* p, unsigned v) { return __hip_atomic_fetch_add(p, v, __ATOMIC_RELAXED, __HIP_MEMORY_SCOPE_AGENT); }
__device__ __forceinline__ unsigned xb_xcc_id() { return (unsigned)__builtin_amdgcn_s_getreg((3 << 11) | 20) & 0xFu; }
#define XB_SPIN(cond, bar) do { unsigned _sp = 0; while (cond) { __builtin_amdgcn_s_sleep(1); \
    if ((++_sp & 255u) == 0u) { if (xb_ld(&(bar)[XB_TMO])) break; if (_sp > XB_SPIN_CAP) { atomicAdd(&(bar)[XB_TMO], 1u); break; } } } } while (0)

struct XcdBarrier {
    unsigned* bar; unsigned x;
    volatile LAS unsigned* st;
};

__device__ __forceinline__ XcdBarrier xcd_barrier_post(unsigned* bar, volatile LAS unsigned* st) {
    XcdBarrier b; b.bar = bar; b.x = xb_xcc_id(); b.st = st;
    if (threadIdx.x == 0) (void)xb_add(&bar[XB_XCNT(b.x)], 1u);
    return b;
}
__device__ __forceinline__ void xcd_barrier_complete(unsigned* bar, unsigned x, unsigned& nloc, unsigned& nx) {
    const unsigned G = gridDim.x * gridDim.y * gridDim.z;
    unsigned sum, cnt, mine, sp = 0u;
    for (;;) {
        sum = 0u; cnt = 0u; mine = 0u;
#pragma unroll 1
        for (unsigned j = 0; j < 16; ++j) { const unsigned c = xb_ld(&bar[XB_XCNT(j)]); sum += c; cnt += (c > 0u) ? 1u : 0u; mine = (j == x) ? c : mine; }
        if (sum == G) break;
        __builtin_amdgcn_s_sleep(1);
        if ((++sp & 255u) == 0u) { if (xb_ld(&bar[XB_TMO])) break; if (sp > XB_SPIN_CAP) { atomicAdd(&bar[XB_TMO], 1u); break; } }
    }
    nloc = mine > 0u ? mine : 1u; nx = cnt > 0u ? cnt : 1u;
}

__device__ __forceinline__ void xcd_barrier(const XcdBarrier& b) {
    asm volatile("s_waitcnt vmcnt(0)" ::: "memory");
    __syncthreads();
    if (threadIdx.x == 0) {
        unsigned* bar = b.bar;
        __builtin_amdgcn_s_waitcnt(0);
        unsigned nloc = b.st[0], nx = b.st[1];
        if (nloc == 0u) { xcd_barrier_complete(bar, b.x, nloc, nx); b.st[0] = nloc; b.st[1] = nx; }
        const unsigned old = xb_add(&bar[XB_XSUB(b.x)], 1u);
        const unsigned gen = old / nloc;
        if (old + 1u == (gen + 1u) * nloc) {
            __builtin_amdgcn_fence(__ATOMIC_RELEASE, "agent");
            asm volatile("s_waitcnt vmcnt(0)" ::: "memory");
            const unsigned og = xb_add(&bar[XB_TOP], 1u);
            const unsigned tg = og / nx;
            if (og + 1u == (tg + 1u) * nx) xb_add(&bar[XB_TOPGEN], 1u);
            else XB_SPIN(xb_ld(&bar[XB_TOPGEN]) == tg, bar);
            __builtin_amdgcn_fence(__ATOMIC_ACQUIRE, "agent");
            xb_add(&bar[XB_XGEN(b.x)], 1u);
            asm volatile("s_waitcnt vmcnt(0)" ::: "memory");
        } else {
            XB_SPIN(xb_ld(&bar[XB_XGEN(b.x)]) == gen, bar);
            __builtin_amdgcn_fence(__ATOMIC_ACQUIRE, "agent");
            asm volatile("s_waitcnt vmcnt(0)" ::: "memory");
        }
    }
    __syncthreads();
}
constexpr int BATCH = 8, SEQ = 2048, D = 1024, M = BATCH * SEQ, FF = 2816;
constexpr int RW_COLS = 1792, EV_IN = 3328, OD_IN = 4096;
constexpr int NWAVES = 8, NTHREADS = NWAVES * 64;
constexpr int N_IN = 26;
constexpr size_t MiB = 1u << 20;
constexpr size_t WS_CTL = 0, CTL_ZERO_BYTES = 3 * MiB;
constexpr size_t OS_HSS = 32 * MiB;
constexpr size_t OS_WC = 56 * MiB;
constexpr size_t OS_IKH = 0, OS_IRH = 40 * MiB, WS_IAH = 36 * MiB, WS_IKT_LO = 3 * MiB, WS_IKT_HI = 48 * MiB;
constexpr size_t OS_RN = 36 * MiB;
constexpr size_t OS_RST = 33 * MiB, OS_ZERO_BEGIN = 32 * MiB, OS_ZERO_BYTES = 3 * MiB;
constexpr size_t WS_SSQ = 2 * MiB;
#define SSQ_SLOT(k) WSP(pg8::ssq_t, WS_SSQ + (size_t)(k) * M * 8)
constexpr size_t WS_W = 3 * MiB;
constexpr size_t W_UP_BYTES = (size_t)2 * FF * D * 2, W_DN_BYTES = (size_t)D * FF * 2;
constexpr size_t WS_WUP = WS_W, WS_WDN = WS_WUP + 4 * W_UP_BYTES, WS_WEVIN = WS_WDN + 4 * W_DN_BYTES, WS_WEVOUT = WS_WEVIN + (size_t)EV_IN * D * 2,
                 WS_WODIN = WS_WEVOUT + (size_t)D * D * 2, WS_WODOUT = WS_WODIN + (size_t)OD_IN * D * 2, WS_WEND = WS_WODOUT + (size_t)D * D * 2;
constexpr size_t WS_KMEAN = 128 * 1024;
constexpr size_t WS_LW2 = 88 * MiB - 512 * 1024, WS_LA2 = WS_LW2 + 64 * 1024, WS_LG2 = WS_LA2 + 64 * 1024;
constexpr size_t WS_XB = 88 * MiB;
constexpr size_t WS_H = 120 * MiB;
constexpr size_t WS_PR = 120 * MiB, WS_QB = 176 * MiB, WS_KB = 192 * MiB, WS_VB = 208 * MiB, WS_Y = 224 * MiB;
constexpr size_t OS_RE = 0, OS_RA = 16 * MiB, WS_YRAW = WS_QB;
constexpr size_t WS_GM = WS_KB;
constexpr size_t WS_HQ = 120 * MiB, WS_HF = 152 * MiB, WS_HI = 184 * MiB, WS_HG = 216 * MiB;
constexpr size_t OS_KT2 = 0;
constexpr size_t WS_RB = 248 * MiB;
constexpr size_t WS_DRY = 250 * MiB;
constexpr size_t WS_END = 256 * MiB;
static_assert(WS_WEND <= WS_LW2 && WS_LG2 + 128 * 1024 <= WS_XB && WS_H + (size_t)M * FF * 2 <= WS_Y + 0 * MiB + 32 * MiB && WS_PR + (size_t)M * RW_COLS * 2 <= WS_QB && WS_Y + (size_t)M * D * 2 <= WS_END && WS_HG + (size_t)M * D * 2 <= WS_END, "d_ws map");
constexpr int CW_BAR = 4096;
constexpr int RING_BYTES = 131072, LDSCTL_OFF = RING_BYTES, MISC_OFF = LDSCTL_OFF + 320, LDS_BYTES = 147456;

__device__ __forceinline__ float bf2f(bf16 v) { return __builtin_bit_cast(float, (unsigned)v << 16); }
__device__ __forceinline__ float sigm(float x) { return 1.0f / (1.0f + __expf(-x)); }
__device__ __forceinline__ float sigmf(float x) { return __builtin_amdgcn_rcpf(1.0f + __builtin_amdgcn_exp2f(-1.4426950408889634f * x)); }
__device__ __forceinline__ float wave_sum(float v) {
#pragma unroll
    for (int o = 1; o < 64; o <<= 1) v += __shfl_xor(v, o);
    return v;
}
__device__ __forceinline__ float wave_max(float v) {
#pragma unroll
    for (int o = 1; o < 64; o <<= 1) v = fmaxf(v, __shfl_xor(v, o));
    return v;
}

typedef float f32x4v __attribute__((ext_vector_type(4)));
typedef float f32x16 __attribute__((ext_vector_type(16)));
typedef unsigned v2u __attribute__((ext_vector_type(2)));
typedef float v2f __attribute__((ext_vector_type(2)));
#define LDS_BARRIER() do { asm volatile("s_waitcnt lgkmcnt(0)" ::: "memory"); __builtin_amdgcn_s_barrier(); asm volatile("" ::: "memory"); } while (0)
__device__ __forceinline__ long long fx20(float v) { return (long long)llrintf(v * 1073741824.0f); }
__device__ __forceinline__ float unfx20(long long v) { return (float)v * (1.0f / 1073741824.0f); }
struct Frame {
    LAS unsigned char* lds; volatile LAS unsigned* MISC; gu32* ctl;
    int tid, lane, wave, vcu, G;
    GAS float* out; GAS unsigned char* ws;
};
#define WSP(T, off) ((GAS T*)(F.ws + (off)))
#define OSP(T, off) ((GAS T*)((GAS unsigned char*)F.out + (off)))
constexpr int PTAB_OFF = LDSCTL_OFF + 1024;
__device__ __forceinline__ const GAS float* inp(const Frame& F, int i) {
    const unsigned long long v = ((const LAS unsigned long long*)(F.lds + PTAB_OFF))[i];
    const unsigned lo = __builtin_amdgcn_readfirstlane((unsigned)v), hi = __builtin_amdgcn_readfirstlane((unsigned)(v >> 32));
    return (const GAS float*)(((unsigned long long)hi << 32) | lo);
}
__device__ __forceinline__ bool in_range(int k, int lo, int hi) { asm volatile("" : "+s"(lo), "+s"(hi)); return lo <= k && k < hi; }
#define PHASE_FRAME(FP) Frame FP = F0; asm volatile("" : "+v"(FP.tid), "+v"(FP.lane)); asm volatile("" : "+s"(FP.wave), "+s"(FP.vcu), "+s"(FP.G), "+s"(FP.ws), "+s"(FP.out))
struct Args { const float* in[N_IN]; float* out; unsigned char* ws; int ph_lo, ph_hi, li, pad; };

__device__ __forceinline__ void transpose_item(const GAS float* W, int K, int N, const GAS float* gain, GAS bf16* WT, int mode, LAS float* scr, int item, int lane) {
    const int nblk = N / 32, kb = item / nblk, nb = item % nblk, k0 = 64 * kb, n0 = 32 * nb;
    float wv[32];
#pragma unroll
    for (int i = 0; i < 32; ++i) wv[i] = W[(size_t)(k0 + 2 * i + (lane >> 5)) * N + n0 + (lane & 31)];
    if (gain) { const float g0 = gain[k0 + lane];
#pragma unroll
        for (int i = 0; i < 32; ++i) wv[i] *= __shfl(g0, 2 * i + (lane >> 5)); }
#pragma unroll
    for (int i = 0; i < 32; ++i) scr[(2 * i + (lane >> 5)) * 33 + (lane & 31)] = wv[i];
    LDS_WAIT(); asm volatile("" ::: "memory");
    const int c = lane & 7; const int rbase = (mode == 0) ? n0 : (n0 + 128 * (n0 >> 7) + (mode == 2 ? 128 : 0));
#pragma unroll
    for (int j = 0; j < 4; ++j) { const int n = (lane >> 3) + 8 * j; const LAS float* s = scr + (8 * c) * 33 + n;
        v4u o; o.x = pk2(s[0 * 33], s[1 * 33]); o.y = pk2(s[2 * 33], s[3 * 33]); o.z = pk2(s[4 * 33], s[5 * 33]); o.w = pk2(s[6 * 33], s[7 * 33]);
        *(GAS v4u*)(WT + (size_t)(rbase + n) * K + k0 + 8 * c) = o; }
    LDS_WAIT(); asm volatile("" ::: "memory");
}
constexpr int I_FF = (D / 64) * (FF / 32), I_EVIN = (D / 64) * (EV_IN / 32), I_OUT = (D / 64) * (D / 32), I_ODIN = (D / 64) * (OD_IN / 32);
constexpr int CV_G1 = 2 * I_FF, CV_G2 = CV_G1 + I_FF + I_EVIN + I_OUT, CV_G3 = CV_G2 + 4 * I_FF, CV_G4 = CV_G3 + 2 * I_FF + I_OUT + I_ODIN / 2, CV_G5 = CV_G4 + I_ODIN / 2 + 2 * I_FF, CV_END = CV_G5 + I_FF;
static_assert(CV_END == 12 * I_FF + I_EVIN + 2 * I_OUT + I_ODIN, "conversion item count");
__device__ __forceinline__ void convert_ffn(Frame& F, int f, int which  , int item, LAS float* scr) {
    const int l = f >> 1, second = f & 1; const GAS float* gain = inp(F, 1) + (size_t)(l * 3 + (second ? 2 : 0)) * D;
    if (which == 0) transpose_item((second ? inp(F, 5) : inp(F, 2)) + (size_t)l * D * FF, D, FF, gain, WSP(bf16, WS_WUP + f * W_UP_BYTES), 1, scr, item, F.lane);
    else if (which == 1) transpose_item((second ? inp(F, 6) : inp(F, 3)) + (size_t)l * D * FF, D, FF, gain, WSP(bf16, WS_WUP + f * W_UP_BYTES), 2, scr, item, F.lane);
    else transpose_item((second ? inp(F, 7) : inp(F, 4)) + (size_t)l * FF * D, FF, D, nullptr, WSP(bf16, WS_WDN + f * W_DN_BYTES), 0, scr, item, F.lane);
}
__device__ __forceinline__ void convert_items(Frame& F, int first, int last, int rank, int nranks) {
    LAS float* scr = (LAS float*)(F.lds + F.wave * 16384);
    for (int it = first + rank; it < last; it += nranks) {
        int r = it;
        if (r < CV_G1) { convert_ffn(F, 0, r / I_FF, r % I_FF, scr); continue; } r -= CV_G1;
        if (r < I_FF) { convert_ffn(F, 0, 2, r, scr); continue; } r -= I_FF;
        if (r < I_EVIN) { transpose_item(inp(F, 8), D, EV_IN, inp(F, 1) + 1 * D, WSP(bf16, WS_WEVIN), 0, scr, r, F.lane); continue; } r -= I_EVIN;
        if (r < I_OUT) { transpose_item(inp(F, 9), D, D, nullptr, WSP(bf16, WS_WEVOUT), 0, scr, r, F.lane); continue; } r -= I_OUT;
        if (r < 3 * I_FF) { convert_ffn(F, 1, r / I_FF, r % I_FF, scr); continue; } r -= 3 * I_FF;
        if (r < 2 * I_FF) { convert_ffn(F, 2, r / I_FF, r % I_FF, scr); continue; } r -= 2 * I_FF;
        if (r < I_FF) { convert_ffn(F, 2, 2, r, scr); continue; } r -= I_FF;
        if (r < I_OUT) { transpose_item(inp(F, 22), D, D, nullptr, WSP(bf16, WS_WODOUT), 0, scr, r, F.lane); continue; } r -= I_OUT;
        if (r < I_ODIN) { transpose_item(inp(F, 21), D, OD_IN, inp(F, 1) + 4 * D, WSP(bf16, WS_WODIN), 0, scr, r, F.lane); continue; } r -= I_ODIN;
        convert_ffn(F, 3, r / I_FF, r % I_FF, scr);
    }
}
__device__ __forceinline__ void prologue_phase(Frame& F) {
    const int gw = F.vcu * NWAVES + F.wave, NGW = F.G * NWAVES;
    convert_items(F, 0, CV_G1, gw, NGW);
    {
        const GAS float* w2 = inp(F, 12); const GAS float* a2 = inp(F, 14); const GAS float* g2 = inp(F, 15); GAS bf16* lw = WSP(bf16, WS_LW2); GAS bf16* la = WSP(bf16, WS_LA2); GAS bf16* lg = WSP(bf16, WS_LG2);
        for (int i = gw * 64 + F.lane; i < 512 * 64; i += NGW * 64) { const int n = i >> 6, k = i & 63; lw[i] = (bf16)f2bf(w2[k * 512 + n]); la[i] = (bf16)f2bf(a2[k * 512 + n]); }
        for (int i = gw * 64 + F.lane; i < 512 * 128; i += NGW * 64) { const int n = i >> 7, k = i & 127; lg[i] = (bf16)f2bf(g2[k * 512 + n]); } }
    const GAS float* x = inp(F, 0); GAS bf16* XB = WSP(bf16, WS_XB); GAS pg8::ssq_t* ssq = SSQ_SLOT(0);
    for (int m = gw; m < M; m += NGW) {
        const GAS f32x4* xr = (const GAS f32x4*)(x + (size_t)m * D) + F.lane; f32x4 v[4]; float s = 0.f;
#pragma unroll
        for (int j = 0; j < 4; ++j) { v[j] = xr[64 * j]; s += (v[j].x * v[j].x + v[j].y * v[j].y) + (v[j].z * v[j].z + v[j].w * v[j].w); }
        s = wave_sum(s);
        GAS unsigned long long* o8 = (GAS unsigned long long*)(XB + (size_t)m * D) + F.lane;
#pragma unroll
        for (int j = 0; j < 4; ++j) o8[64 * j] = (unsigned long long)pk2(v[j].x, v[j].y) | ((unsigned long long)pk2(v[j].z, v[j].w) << 32);
        if (F.lane == 0) ssq[m] = pg8::ssq_fix(s);
    }
}

__device__ __forceinline__ float dpp_add16(float v) {
    v += __builtin_bit_cast(float, __builtin_amdgcn_mov_dpp(__builtin_bit_cast(int, v), 0xB1, 0xF, 0xF, true));
    v += __builtin_bit_cast(float, __builtin_amdgcn_mov_dpp(__builtin_bit_cast(int, v), 0x4E, 0xF, 0xF, true));
    v += __builtin_bit_cast(float, __builtin_amdgcn_mov_dpp(__builtin_bit_cast(int, v), 0x141, 0xF, 0xF, true));
    v += __builtin_bit_cast(float, __builtin_amdgcn_mov_dpp(__builtin_bit_cast(int, v), 0x140, 0xF, 0xF, true));
    return v;
}
__device__ __forceinline__ float bflo(unsigned w) { return __builtin_bit_cast(float, w << 16); }
__device__ __forceinline__ float bfhi(unsigned w) { return __builtin_bit_cast(float, w & 0xffff0000u); }
__device__ __forceinline__ float bfel(const v4u v, int e) { const unsigned w = (e >> 1) == 0 ? v.x : (e >> 1) == 1 ? v.y : (e >> 1) == 2 ? v.z : v.w; return (e & 1) ? bfhi(w) : bflo(w); }
__device__ __forceinline__ void unpack8(const v4u v, float (&o)[8]) { o[0] = bflo(v.x); o[1] = bfhi(v.x); o[2] = bflo(v.y); o[3] = bfhi(v.y); o[4] = bflo(v.z); o[5] = bfhi(v.z); o[6] = bflo(v.w); o[7] = bfhi(v.w); }
constexpr int LO_PITCH = 528;
__device__ __forceinline__ void rwkv_lora_unit(Frame& F, int u) {
    const int tid = F.tid, lane = F.lane, w = F.wave, r16 = lane & 15, g4 = lane >> 4; LAS unsigned char* L = F.lds;
    const GAS bf16* PR = WSP(bf16, WS_PR); GAS bf16* RE = OSP(bf16, OS_RE); GAS bf16* RA = OSP(bf16, OS_RA); GAS bf16* Y = WSP(bf16, WS_Y);
    const GAS bf16* LW = WSP(bf16, WS_LW2); const GAS bf16* LA = WSP(bf16, WS_LA2); const GAS bf16* LG = WSP(bf16, WS_LG2);
    const GAS float* mu = inp(F, 10); const GAS float* w0 = inp(F, 11); const GAS float* a0 = inp(F, 13);
    const int m0 = u * 64;
    const int t = tid >> 3; const size_t row = (size_t)m0 + t; const bool hp = ((m0 + t) & (SEQ - 1)) != 0; const size_t rowp = hp ? row - 1 : row;
    __syncthreads();
    {   const int c0 = (tid & 7) * 32; v4u cur[4], prv[4];
#pragma unroll
        for (int q = 0; q < 4; ++q) { cur[q] = *(const GAS v4u*)(PR + row * RW_COLS + 1536 + c0 + 8 * q); prv[q] = *(const GAS v4u*)(PR + rowp * RW_COLS + 1536 + c0 + 8 * q); }
#pragma unroll
        for (int q = 0; q < 4; ++q) { const int c = c0 + 8 * q; float cf[8], pf[8]; unpack8(cur[q], cf); unpack8(hp ? prv[q] : v4u{0u, 0u, 0u, 0u}, pf); float o[8];
#pragma unroll
            for (int e = 0; e < 8; ++e) { float v = cf[e] + (pf[e] - cf[e]) * mu[1536 + c + e]; if (c < 64) v = 1.0f - 2.0f * __builtin_amdgcn_rcpf(1.0f + __builtin_amdgcn_exp2f(2.8853900817779268f * v)); else if (c >= 128) v = sigmf(v); o[e] = v; }
            *(LAS v4u*)(L + t * LO_PITCH + c * 2) = v4u{pk2(o[0], o[1]), pk2(o[2], o[3]), pk2(o[4], o[5]), pk2(o[6], o[7])}; } }
    {
        const int hh = tid & 7; const GAS float* k_k = inp(F, 16); GAS float* RN = OSP(float, OS_RN); float ss = 0.f; v4u cur[8], prv[8];
#pragma unroll
        for (int q = 0; q < 8; ++q) { const int cc = hh * 64 + 8 * q; cur[q] = *(const GAS v4u*)(PR + row * RW_COLS + 512 + cc); prv[q] = *(const GAS v4u*)(PR + rowp * RW_COLS + 512 + cc); }
#pragma unroll
        for (int q = 0; q < 8; ++q) { const int cc = hh * 64 + 8 * q;
#pragma unroll
            for (int e = 0; e < 8; ++e) { const float kc = bfel(cur[q], e), kp = hp ? bfel(prv[q], e) : 0.f; const float kk = (kc + (kp - kc) * mu[512 + cc + e]) * k_k[cc + e]; ss += kk * kk; } }
        RN[row * 8 + hh] = 1.0f / sqrtf(fmaxf(ss, 1e-24f)); }
    asm volatile("" ::: "memory");
    bf16x8 bw[4][2], ba[4][2], bg[4][4]; f32x4v biw[4], bia[4];
#pragma unroll
    for (int ntl = 0; ntl < 4; ++ntl) { const int n = 16 * (4 * w + ntl) + r16, n4 = 16 * (4 * w + ntl) + 4 * g4;
#pragma unroll
        for (int kk = 0; kk < 2; ++kk) { bw[ntl][kk] = *(const GAS bf16x8*)(LW + (size_t)n * 64 + 32 * kk + 8 * g4); ba[ntl][kk] = *(const GAS bf16x8*)(LA + (size_t)n * 64 + 32 * kk + 8 * g4); }
        biw[ntl] = *(const GAS f32x4v*)(w0 + n4); bia[ntl] = *(const GAS f32x4v*)(a0 + n4); }
    __syncthreads();
#define LO_PROD(KK, KOFF, BF, ...) do { _Pragma("unroll") for (int ntl = 0; ntl < 4; ++ntl) { const int n4 = 16 * (4 * w + ntl) + 4 * g4; _Pragma("unroll") for (int mt = 0; mt < 4; ++mt) { f32x4v acc = f32x4v{0.f, 0.f, 0.f, 0.f}; \
        _Pragma("unroll") for (int kk = 0; kk < (KK); ++kk) { const bf16x8 af = *(const LAS bf16x8*)(L + (16 * mt + r16) * LO_PITCH + ((KOFF) + 32 * kk + 8 * g4) * 2); acc = __builtin_amdgcn_mfma_f32_16x16x32_bf16(BF[ntl][kk], af, acc, 0, 0, 0); } \
        const size_t orow = (size_t)m0 + 16 * mt + r16; __VA_ARGS__; } } } while (0)
    LO_PROD(2, 0, bw, { const f32x4v x = acc + biw[ntl]; *(GAS v2u*)(RE + orow * 512 + n4) = v2u{pk2(0.6065306597126334f * sigmf(x[0]), 0.6065306597126334f * sigmf(x[1])), pk2(0.6065306597126334f * sigmf(x[2]), 0.6065306597126334f * sigmf(x[3]))}; });
#pragma unroll
    for (int ntl = 0; ntl < 2; ++ntl) { const int n = 16 * (4 * w + ntl) + r16;
#pragma unroll
        for (int kk = 0; kk < 4; ++kk) bg[ntl][kk] = *(const GAS bf16x8*)(LG + (size_t)n * 128 + 32 * kk + 8 * g4); }
    LO_PROD(2, 64, ba, { const f32x4v x = acc + bia[ntl]; *(GAS v2u*)(RA + orow * 512 + n4) = v2u{pk2(sigmf(x[0]), sigmf(x[1])), pk2(sigmf(x[2]), sigmf(x[3]))}; });
#pragma unroll
    for (int ntl = 2; ntl < 4; ++ntl) { const int n = 16 * (4 * w + ntl) + r16;
#pragma unroll
        for (int kk = 0; kk < 4; ++kk) bg[ntl][kk] = *(const GAS bf16x8*)(LG + (size_t)n * 128 + 32 * kk + 8 * g4); }
    LO_PROD(4, 128, bg, { *(GAS v2u*)(Y + orow * 1024 + n4) = v2u{pk2(acc[0], acc[1]), pk2(acc[2], acc[3])}; });
#undef LO_PROD
}
constexpr int GR_P = 128, GR_BUF = 32 * GR_P, GR_AF = 0, GR_WAVE = 4 * GR_BUF;
static_assert(8 * GR_WAVE <= RING_BYTES && 32 * 33 * 4 + 3 * 2560 <= GR_WAVE, "gram LDS");
__device__ __forceinline__ void rwkv_gram_phase(Frame& F) {
    const int lane = F.lane, r16 = lane & 15, g4 = lane >> 4; LAS unsigned char* Lw = F.lds + F.wave * GR_WAVE; LAS float* Af = (LAS float*)(Lw + GR_AF);
    const GAS bf16* PR = WSP(bf16, WS_PR); const GAS bf16* RE = OSP(bf16, OS_RE); const GAS bf16* RA = OSP(bf16, OS_RA); const GAS float* RN = OSP(float, OS_RN); GAS v4u* GM = WSP(v4u, WS_GM); GAS float* WCg = OSP(float, OS_WC);
    GAS bf16* IKH = OSP(bf16, OS_IKH); GAS bf16* IRH = OSP(bf16, OS_IRH); GAS bf16* IAH = WSP(bf16, WS_IAH);
    const GAS float* mu = inp(F, 10); const GAS float* k_k = inp(F, 16); const GAS float* k_a = inp(F, 17);
    const int gw = F.vcu * NWAVES + F.wave, NGW = F.G * NWAVES;
    for (int u = gw; u < 64 * 64; u += NGW) { const int bh = u >> 6, c = u & 63, b = bh >> 3, h = bh & 7, gc = h * 64 + lane; const size_t row0 = (size_t)b * SEQ + c * 32;
        const float mr = mu[gc], mk = mu[512 + gc], ckk = k_k[gc], cka = k_a[gc];
        bf16x8 fKh[2][2], fAh[2][2], fKt[2][2], fRh[2][2];
        {   float cs = 0.f, rprev = 0.f, kprev = 0.f; if (c > 0) { rprev = bf2f(PR[(row0 - 1) * RW_COLS + gc]); kprev = bf2f(PR[(row0 - 1) * RW_COLS + 512 + gc]); }
            unsigned short lr[8], lk[8], le[8], la[8], nr[8], nk[8], ne[8], na[8];
#pragma unroll
            for (int i = 0; i < 8; ++i) { const size_t row = row0 + i; lr[i] = PR[row * RW_COLS + gc]; lk[i] = PR[row * RW_COLS + 512 + gc]; le[i] = RE[row * 512 + gc]; la[i] = RA[row * 512 + gc]; }
#pragma unroll 1
            for (int tb = 0; tb < 32; tb += 8) {
                if (tb + 8 < 32) {
#pragma unroll
                    for (int i = 0; i < 8; ++i) { const size_t row = row0 + tb + 8 + i; nr[i] = PR[row * RW_COLS + gc]; nk[i] = PR[row * RW_COLS + 512 + gc]; ne[i] = RE[row * 512 + gc]; na[i] = RA[row * 512 + gc]; } }
#pragma unroll
                for (int i = 0; i < 8; ++i) { const int t = tb + i; const size_t row = row0 + t; const float rc = bf2f(lr[i]), kc = bf2f(lk[i]), e = bf2f(le[i]), a = bf2f(la[i]);
                    const float r = rc + (rprev - rc) * mr, kx = kc + (kprev - kc) * mk; rprev = rc; kprev = kc;
                    const float kk = kx * ckk * RN[row * 8 + h];
                    const float wm = __expf(-cs); cs += e; const float wt = __expf(-cs), iw = __builtin_amdgcn_rcpf(wt);
                    if (t == 31) WCg[(size_t)u * 64 + lane] = wt;
                    LAS unsigned char* im = Lw + t * GR_P + lane * 2;
                    *(LAS unsigned short*)(im) = (unsigned short)f2bf(kk * wm); *(LAS unsigned short*)(im + GR_BUF) = (unsigned short)f2bf(kk * a * iw);
                    *(LAS unsigned short*)(im + 2 * GR_BUF) = (unsigned short)f2bf(kx * (1.0f + (a - 1.0f) * cka) * iw); *(LAS unsigned short*)(im + 3 * GR_BUF) = (unsigned short)f2bf(r * wt); }
#pragma unroll
                for (int i = 0; i < 8; ++i) { lr[i] = nr[i]; lk[i] = nk[i]; le[i] = ne[i]; la[i] = na[i]; }
            }
            asm volatile("s_waitcnt lgkmcnt(0)" ::: "memory");
#pragma unroll
            for (int mt = 0; mt < 2; ++mt)
#pragma unroll
                for (int kk2 = 0; kk2 < 2; ++kk2) { const LAS unsigned char* fp = Lw + (16 * mt + r16) * GR_P + (32 * kk2 + 8 * g4) * 2;
                    fKh[mt][kk2] = *(const LAS bf16x8*)(fp); fAh[mt][kk2] = *(const LAS bf16x8*)(fp + GR_BUF); fKt[mt][kk2] = *(const LAS bf16x8*)(fp + 2 * GR_BUF); fRh[mt][kk2] = *(const LAS bf16x8*)(fp + 3 * GR_BUF); }
            asm volatile("s_waitcnt lgkmcnt(0)" ::: "memory");
            {
                GAS bf16* IKT = (b < 5) ? WSP(bf16, WS_IKT_LO) : WSP(bf16, WS_IKT_HI); const int tq = lane >> 3, k8 = (lane & 7) * 8;
#pragma unroll 1
                for (int q = 0; q < 4; ++q) { const int t = q * 8 + tq; const LAS unsigned char* ip = Lw + t * GR_P + k8 * 2; const size_t go = (row0 + t) * 512 + h * 64 + k8;
                    const v4u i0 = *(const LAS v4u*)(ip), i1 = *(const LAS v4u*)(ip + GR_BUF), i2 = *(const LAS v4u*)(ip + 2 * GR_BUF), i3 = *(const LAS v4u*)(ip + 3 * GR_BUF);
                    *(GAS v4u*)(IKH + go) = i0; *(GAS v4u*)(IAH + go) = i1; *(GAS v4u*)(IKT + go) = i2; *(GAS v4u*)(IRH + go) = i3; }
                asm volatile("s_waitcnt lgkmcnt(0)" ::: "memory"); }
        }
        f32x4v gA[2][2], gB[2][2], gRA[2][2], gRK[2][2];
#pragma unroll
        for (int mt = 0; mt < 2; ++mt)
#pragma unroll
            for (int st = 0; st < 2; ++st) { f32x4v z = f32x4v{0.f, 0.f, 0.f, 0.f}; gA[mt][st] = z; gB[mt][st] = z; gRA[mt][st] = z; gRK[mt][st] = z;
#pragma unroll
                for (int kk = 0; kk < 2; ++kk) { gA[mt][st] = __builtin_amdgcn_mfma_f32_16x16x32_bf16(fKh[mt][kk], fAh[st][kk], gA[mt][st], 0, 0, 0); gB[mt][st] = __builtin_amdgcn_mfma_f32_16x16x32_bf16(fKh[mt][kk], fKt[st][kk], gB[mt][st], 0, 0, 0);
                    gRA[mt][st] = __builtin_amdgcn_mfma_f32_16x16x32_bf16(fRh[mt][kk], fAh[st][kk], gRA[mt][st], 0, 0, 0); gRK[mt][st] = __builtin_amdgcn_mfma_f32_16x16x32_bf16(fRh[mt][kk], fKt[st][kk], gRK[mt][st], 0, 0, 0); } }
#pragma unroll
        for (int mt = 0; mt < 2; ++mt)
#pragma unroll
            for (int st = 0; st < 2; ++st)
#pragma unroll
                for (int rg = 0; rg < 4; ++rg) { const int t = 16 * mt + 4 * g4 + rg, s_ = 16 * st + r16; Af[t * 33 + s_] = (s_ < t) ? gA[mt][st][rg] : 0.f; }
        asm volatile("s_waitcnt lgkmcnt(0)" ::: "memory");
        float Tc[32]; const int j = lane & 31;
#pragma unroll
        for (int t = 0; t < 32; ++t) { float acc[4] = {(t == j) ? 1.0f : 0.f, 0.f, 0.f, 0.f};
#pragma unroll
            for (int s_ = 0; s_ < t; ++s_) acc[s_ & 3] -= Af[t * 33 + s_] * Tc[s_];
            Tc[t] = (acc[0] + acc[1]) + (acc[2] + acc[3]); }
        LAS unsigned char* I0 = Lw, * I1 = Lw + 2560, * I2 = Lw + 5120;
        if (lane < 32) {
#pragma unroll
            for (int t = 0; t < 32; ++t) *(LAS unsigned short*)(I0 + t * 80 + j * 2) = (unsigned short)f2bf(Tc[t]); }
#define GR_CW(IMG, G, STRICT) do { _Pragma("unroll") for (int mt = 0; mt < 2; ++mt) _Pragma("unroll") for (int st = 0; st < 2; ++st) _Pragma("unroll") for (int rg = 0; rg < 4; ++rg) { const int t = 16 * mt + 4 * g4 + rg, s_ = 16 * st + r16; \
            *(LAS unsigned short*)(IMG + t * 80 + s_ * 2) = (unsigned short)f2bf(((STRICT) ? (s_ < t) : (s_ <= t)) ? G[mt][st][rg] : 0.f); } } while (0)
        GR_CW(I1, gB, true); GR_CW(I2, gRA, false);
        asm volatile("s_waitcnt lgkmcnt(0)" ::: "memory");
        GAS v4u* gm = GM + (size_t)u * 512 + lane;
#pragma unroll
        for (int mt = 0; mt < 2; ++mt) { const LAS unsigned char* rT = I0 + (16 * mt + r16) * 80, * rB = I1 + (16 * mt + r16) * 80, * rR = I2 + (16 * mt + r16) * 80;
            const v2u t0 = *(const LAS v2u*)(rT + (4 * g4) * 2), t1 = *(const LAS v2u*)(rT + (16 + 4 * g4) * 2); gm[(0 * 2 + mt) * 64] = v4u{t0.x, t0.y, t1.x, t1.y};
            gm[(1 * 2 + mt) * 64] = *(const LAS v4u*)(rB + (8 * g4) * 2);
            const v2u a0 = *(const LAS v2u*)(rR + (4 * g4) * 2), a1 = *(const LAS v2u*)(rR + (16 + 4 * g4) * 2); gm[(2 * 2 + mt) * 64] = v4u{a0.x, a0.y, a1.x, a1.y}; }
        asm volatile("s_waitcnt lgkmcnt(0)" ::: "memory");
        GR_CW(I0, gRK, false);
        asm volatile("s_waitcnt lgkmcnt(0)" ::: "memory");
#pragma unroll
        for (int mt = 0; mt < 2; ++mt) gm[(3 * 2 + mt) * 64] = *(const LAS v4u*)(I0 + (16 * mt + r16) * 80 + (8 * g4) * 2);
        asm volatile("s_waitcnt lgkmcnt(0)" ::: "memory");
#undef GR_CW
    }
}
constexpr int CS_KH = 0, CS_RH = CS_KH + 32 * 144, CS_AT = CS_RH + 32 * 144, CS_KT = CS_AT + 64 * 80, CS_VT = CS_KT + 64 * 80, CS_WC = CS_VT + 16 * 80, CS_YR = CS_WC + 256, CS_BUF = CS_YR + 32 * 16 * 4;
static_assert(2 * CS_BUF <= RING_BYTES && CS_AT % 16 == 0 && CS_VT % 16 == 0 && CS_WC % 16 == 0 && CS_YR % 16 == 0 && CS_BUF % 16 == 0, "chunk scan LDS");
__device__ __forceinline__ bf16x8 pack8(const f32x4v a, const f32x4v b) { const v4u w = v4u{pk2(a[0], a[1]), pk2(a[2], a[3]), pk2(b[0], b[1]), pk2(b[2], b[3])}; return __builtin_bit_cast(bf16x8, w); }
__device__ __forceinline__ bf16x8 cat8(const v2u a, const v2u b) { const v4u w = v4u{a.x, a.y, b.x, b.y}; return __builtin_bit_cast(bf16x8, w); }
template <bool DRY = false, bool NOPROD = false> __device__ __forceinline__ void rwkv_cscan_unit(Frame& F, int u) {
    const int tid = F.tid, lane = F.lane, w = F.wave, r16 = lane & 15, g4 = lane >> 4; LAS unsigned char* L = F.lds;
    const int ch = u >> 2, rg = u & 3, b = ch >> 3, h = ch & 7; const size_t rowbase = (size_t)b * SEQ;
    const GAS bf16* PR = WSP(bf16, WS_PR); const GAS v4u* GM = WSP(v4u, WS_GM); GAS bf16* YRAW = WSP(bf16, WS_YRAW); GAS long long* RST = OSP(long long, OS_RST);
    const GAS float* WCg = OSP(float, OS_WC); const GAS bf16* IKH = OSP(bf16, OS_IKH); const GAS bf16* IRH = OSP(bf16, OS_IRH); const GAS bf16* IAH = WSP(bf16, WS_IAH);
    const GAS bf16* IKT = (b < 5) ? WSP(bf16, WS_IKT_LO) : WSP(bf16, WS_IKT_HI);
#define CS_T16(DST, V, C8, T_) do { _Pragma("unroll") for (int e = 0; e < 8; ++e) *(LAS unsigned short*)((DST) + ((C8) + e) * 80 + (T_) * 2) = (unsigned short)(((V)[e >> 1]) >> (16 * (e & 1))); } while (0)
#define CS_CL(CC) ((CC) < 63 ? (CC) : 63)
#define CS_FLUSH(CC) do { const int t0f_ = (CC) * 32; const LAS float* yr_ = (const LAS float*)(L + ((CC) & 1) * CS_BUF + CS_YR); \
        { const int t_ = lane >> 1, hf_ = lane & 1; const LAS float* p_ = yr_ + t_ * 16 + hf_ * 8; const f32x4v a_ = *(const LAS f32x4v*)p_, b_ = *(const LAS f32x4v*)(p_ + 4); \
            *(GAS v4u*)(YRAW + (rowbase + t0f_ + t_) * 512 + h * 64 + rg * 16 + hf_ * 8) = v4u{pk2(a_[0], a_[1]), pk2(a_[2], a_[3]), pk2(b_[0], b_[1]), pk2(b_[2], b_[3])}; \
            float s1_ = (a_[0] + a_[1]) + (a_[2] + a_[3]) + (b_[0] + b_[1]) + (b_[2] + b_[3]); float s2_ = (a_[0] * a_[0] + a_[1] * a_[1]) + (a_[2] * a_[2] + a_[3] * a_[3]) + (b_[0] * b_[0] + b_[1] * b_[1]) + (b_[2] * b_[2] + b_[3] * b_[3]); \
            s1_ += __shfl_xor(s1_, 1); s2_ += __shfl_xor(s2_, 1); \
            if (hf_ == 0 && !DRY) { GAS long long* st_ = RST + ((rowbase + t0f_ + t_) * 8 + h) * 2; __hip_atomic_fetch_add(st_, fx20(s1_), __ATOMIC_RELAXED, __HIP_MEMORY_SCOPE_AGENT); __hip_atomic_fetch_add(st_ + 1, fx20(s2_), __ATOMIC_RELAXED, __HIP_MEMORY_SCOPE_AGENT); } } \
    } while (0)
    __syncthreads();
    if (w == 0) {
        f32x4v S[4]; S[0] = f32x4v{0.f, 0.f, 0.f, 0.f}; S[1] = S[0]; S[2] = S[0]; S[3] = S[0];
        v4u gTa[2], gBa[2], gRAa[2], gRKa[2];
#define CS_GM(CC, G) do { const GAS v4u* gm_ = GM + ((size_t)ch * 64 + (CC)) * 512 + lane; gT##G[0] = gm_[0]; gT##G[1] = gm_[64]; gB##G[0] = gm_[128]; gB##G[1] = gm_[192]; gRA##G[0] = gm_[256]; gRA##G[1] = gm_[320]; gRK##G[0] = gm_[384]; gRK##G[1] = gm_[448]; } while (0)
        CS_GM(0, a);
        LDS_BARRIER();
#define CS_CONS(c, G) do { \
            const LAS unsigned char* B = L + ((c) & 1) * CS_BUF; \
            const bf16x8 fT0 = __builtin_bit_cast(bf16x8, gT##G[0]), fT1 = __builtin_bit_cast(bf16x8, gT##G[1]), fB0 = __builtin_bit_cast(bf16x8, gB##G[0]), fB1 = __builtin_bit_cast(bf16x8, gB##G[1]); \
            const bf16x8 fRA0 = __builtin_bit_cast(bf16x8, gRA##G[0]), fRA1 = __builtin_bit_cast(bf16x8, gRA##G[1]), fRK0 = __builtin_bit_cast(bf16x8, gRK##G[0]), fRK1 = __builtin_bit_cast(bf16x8, gRK##G[1]); \
            CS_GM(CS_CL((c) + 1), G); \
            const bf16x8 sB0 = pack8(S[0], S[1]), sB1 = pack8(S[2], S[3]); \
            const bf16x8 vB = *(const LAS bf16x8*)(B + CS_VT + r16 * 80 + 16 * g4); \
            f32x4v X[2], Y[2]; \
            _Pragma("unroll") \
            for (int mt = 0; mt < 2; ++mt) { const LAS unsigned char* kr = B + CS_KH + (16 * mt + r16) * 144 + 8 * g4; const LAS unsigned char* rr = B + CS_RH + (16 * mt + r16) * 144 + 8 * g4; \
                const bf16x8 k0 = cat8(*(const LAS v2u*)(kr), *(const LAS v2u*)(kr + 32)), k1 = cat8(*(const LAS v2u*)(kr + 64), *(const LAS v2u*)(kr + 96)); \
                const bf16x8 q0 = cat8(*(const LAS v2u*)(rr), *(const LAS v2u*)(rr + 32)), q1 = cat8(*(const LAS v2u*)(rr + 64), *(const LAS v2u*)(rr + 96)); \
                f32x4v x = f32x4v{0.f, 0.f, 0.f, 0.f}; x = __builtin_amdgcn_mfma_f32_16x16x32_bf16(k0, sB0, x, 0, 0, 0); x = __builtin_amdgcn_mfma_f32_16x16x32_bf16(k1, sB1, x, 0, 0, 0); \
                X[mt] = __builtin_amdgcn_mfma_f32_16x16x32_bf16(mt ? fB1 : fB0, vB, x, 0, 0, 0); \
                f32x4v y = f32x4v{0.f, 0.f, 0.f, 0.f}; y = __builtin_amdgcn_mfma_f32_16x16x32_bf16(q0, sB0, y, 0, 0, 0); y = __builtin_amdgcn_mfma_f32_16x16x32_bf16(q1, sB1, y, 0, 0, 0); \
                Y[mt] = __builtin_amdgcn_mfma_f32_16x16x32_bf16(mt ? fRK1 : fRK0, vB, y, 0, 0, 0); } \
            const bf16x8 xB = pack8(X[0], X[1]); \
            const f32x4v z = f32x4v{0.f, 0.f, 0.f, 0.f}; \
            const f32x4v U0 = -__builtin_amdgcn_mfma_f32_16x16x32_bf16(fT0, xB, z, 0, 0, 0), U1 = -__builtin_amdgcn_mfma_f32_16x16x32_bf16(fT1, xB, z, 0, 0, 0); \
            const bf16x8 uB = pack8(U0, U1); \
            Y[0] = __builtin_amdgcn_mfma_f32_16x16x32_bf16(fRA0, uB, Y[0], 0, 0, 0); Y[1] = __builtin_amdgcn_mfma_f32_16x16x32_bf16(fRA1, uB, Y[1], 0, 0, 0); \
            _Pragma("unroll") \
            for (int kt = 0; kt < 4; ++kt) { const LAS unsigned char* ar = B + CS_AT + (16 * kt + r16) * 80 + 8 * g4; const bf16x8 af = cat8(*(const LAS v2u*)(ar), *(const LAS v2u*)(ar + 32)); \
                const bf16x8 kf = *(const LAS bf16x8*)(B + CS_KT + (16 * kt + r16) * 80 + 16 * g4); const f32x4v wc = *(const LAS f32x4v*)(B + CS_WC + (16 * kt + 4 * g4) * 4); \
                f32x4v acc = __builtin_amdgcn_mfma_f32_16x16x32_bf16(af, uB, S[kt], 0, 0, 0); acc = __builtin_amdgcn_mfma_f32_16x16x32_bf16(kf, vB, acc, 0, 0, 0); S[kt] = acc * wc; } \
            LAS float* yr = (LAS float*)(L + ((c) & 1) * CS_BUF + CS_YR); \
            _Pragma("unroll") \
            for (int mt = 0; mt < 2; ++mt) \
            _Pragma("unroll") \
                for (int rg_ = 0; rg_ < 4; ++rg_) yr[(16 * mt + 4 * g4 + rg_) * 16 + r16] = Y[mt][rg_]; \
        LDS_BARRIER(); \
    } while (0)
#pragma unroll 1
        for (int c2 = 0; c2 < 64; c2 += 2) { CS_CONS(c2, a); CS_CONS(c2 + 1, a); }
#undef CS_CONS
#undef CS_GM
    } else if (w == 1) {
        LDS_BARRIER();
#pragma unroll 1
        for (int c = 0; c < 64; ++c) { if (c >= 1) CS_FLUSH(c - 1); LDS_BARRIER(); }
        CS_FLUSH(63);
    } else if (w == 2) {
        const int t8 = lane >> 3, c8 = (lane & 7) * 8; const GAS bf16* src = IKT + (rowbase + t8) * 512 + h * 64 + c8; v4u qa[4], qb[4];
#define CS_LOAD(CC, Q) do { const GAS bf16* p_ = src + (size_t)CS_CL(CC) * (32 * 512); _Pragma("unroll") for (int it_ = 0; it_ < 4; ++it_) q##Q[it_] = *(const GAS v4u*)(p_ + it_ * (8 * 512)); } while (0)
#define CS_PREP(CC, Q) do { LAS unsigned char* B_ = L + ((CC) & 1) * CS_BUF; _Pragma("unroll") for (int it_ = 0; it_ < 4; ++it_) CS_T16(B_ + CS_KT, q##Q[it_], c8, 8 * it_ + t8); } while (0)
#define CS_PROD(c, Q) do { if (!NOPROD) { CS_PREP((c) + 1, Q); CS_LOAD((c) + 3, Q); } LDS_BARRIER(); } while (0)
        CS_LOAD(0, a); CS_PREP(0, a); CS_LOAD(1, b); CS_LOAD(2, a);
        LDS_BARRIER();
#pragma unroll 1
        for (int c2 = 0; c2 < 64; c2 += 2) { CS_PROD(c2, b); CS_PROD(c2 + 1, a); }
#undef CS_LOAD
#undef CS_PREP
    } else if (w == 3) {
        const int t_ = lane >> 1, hf = (lane & 1) * 8, vcol = h * 64 + rg * 16 + hf; const GAS float* mu = inp(F, 10); float cB[8];
#pragma unroll
        for (int e = 0; e < 8; ++e) cB[e] = mu[1024 + vcol + e];
        const GAS bf16* src = PR + (rowbase + t_) * RW_COLS + 1024 + vcol; v4u qa[2], qb[2];
#define CS_LOAD(CC, Q) do { const GAS bf16* p_ = src + (size_t)CS_CL(CC) * (32 * RW_COLS); q##Q[0] = *(const GAS v4u*)(p_); q##Q[1] = *(const GAS v4u*)(p_ - ((CS_CL(CC) * 32 + t_ > 0) ? RW_COLS : 0)); } while (0)
#define CS_PREP(CC, Q) do { LAS unsigned char* B_ = L + ((CC) & 1) * CS_BUF; const bool first_ = ((CC) * 32 + t_ == 0); \
            _Pragma("unroll") for (int e = 0; e < 8; ++e) { const float vc_ = bfel(q##Q[0], e), vp_ = first_ ? 0.f : bfel(q##Q[1], e); *(LAS unsigned short*)(B_ + CS_VT + (hf + e) * 80 + t_ * 2) = (unsigned short)f2bf(vc_ + (vp_ - vc_) * cB[e]); } } while (0)
        CS_LOAD(0, a); CS_PREP(0, a); CS_LOAD(1, b); CS_LOAD(2, a);
        LDS_BARRIER();
#pragma unroll 1
        for (int c2 = 0; c2 < 64; c2 += 2) { CS_PROD(c2, b); CS_PROD(c2 + 1, a); }
#undef CS_LOAD
#undef CS_PREP
    } else {
        const int ptid = tid & 255, pt = ptid >> 3, c8 = (ptid & 7) * 8; const size_t o0 = (rowbase + pt) * 512 + h * 64 + c8; const GAS float* wsrc = WCg + (size_t)ch * 64 * 64 + (ptid & 63);
        v4u qa[3], qb[3]; float qwa, qwb;
#define CS_LOAD(CC, Q) do { const size_t o_ = o0 + (size_t)CS_CL(CC) * (32 * 512); q##Q[0] = *(const GAS v4u*)(IKH + o_); q##Q[1] = *(const GAS v4u*)(IRH + o_); q##Q[2] = *(const GAS v4u*)(IAH + o_); qw##Q = wsrc[CS_CL(CC) * 64]; } while (0)
#define CS_PREP(CC, Q) do { LAS unsigned char* B_ = L + ((CC) & 1) * CS_BUF; *(LAS v4u*)(B_ + CS_KH + pt * 144 + c8 * 2) = q##Q[0]; *(LAS v4u*)(B_ + CS_RH + pt * 144 + c8 * 2) = q##Q[1]; CS_T16(B_ + CS_AT, q##Q[2], c8, pt); \
            if (ptid < 64) *(LAS float*)(B_ + CS_WC + ptid * 4) = qw##Q; } while (0)
        CS_LOAD(0, a); CS_PREP(0, a); CS_LOAD(1, b); CS_LOAD(2, a);
        LDS_BARRIER();
#pragma unroll 1
        for (int c2 = 0; c2 < 64; c2 += 2) { CS_PROD(c2, b); CS_PROD(c2 + 1, a); }
#undef CS_LOAD
#undef CS_PREP
#undef CS_PROD
    }
#undef CS_FLUSH
#undef CS_T16
#undef CS_CL
}
template <bool DRY = false, bool NOPROD = false> __device__ __forceinline__ void rwkv_cscan_phase(Frame& F) {
    for (int u = F.vcu; u < 256; u += F.G) rwkv_cscan_unit<DRY, NOPROD>(F, u);
}
__device__ __forceinline__ void rwkv_post_phase(Frame& F) {
    const int gw = F.vcu * NWAVES + F.wave, NGW = F.G * NWAVES, lane = F.lane, c = lane * 8, hh = lane >> 3;
    const GAS bf16* PR = WSP(bf16, WS_PR); const GAS bf16* RA = OSP(bf16, OS_RA); const GAS bf16* YRAW = WSP(bf16, WS_YRAW); const GAS long long* RST = OSP(long long, OS_RST); GAS bf16* Y = WSP(bf16, WS_Y);
    const GAS float* mu = inp(F, 10); const GAS float* k_a = inp(F, 17); const GAS float* r_k = inp(F, 18); const GAS float* lnw = inp(F, 19); const GAS float* lnb = inp(F, 20);
    float mur[8], muk[8], muv[8], cka[8], crk[8], clw[8], clb[8];
#pragma unroll
    for (int e = 0; e < 8; ++e) { mur[e] = mu[c + e]; muk[e] = mu[512 + c + e]; muv[e] = mu[1024 + c + e]; cka[e] = k_a[c + e]; crk[e] = r_k[c + e]; clw[e] = lnw[c + e]; clb[e] = lnb[c + e]; }
    for (int m0 = gw; m0 < M; m0 += 2 * NGW) {
        v4u rc_[2], kc_[2], vc_[2], rp_[2], kp_[2], vp_[2], av_[2], gv_[2], yv_[2]; long long s1_[2], s2_[2];
#pragma unroll
        for (int k = 0; k < 2; ++k) { const int mk = m0 + k * NGW, m = mk < M ? mk : M - 1; const size_t row = (size_t)m, rowp = (m & (SEQ - 1)) != 0 ? row - 1 : row;
            rc_[k] = *(const GAS v4u*)(PR + row * RW_COLS + c); kc_[k] = *(const GAS v4u*)(PR + row * RW_COLS + 512 + c); vc_[k] = *(const GAS v4u*)(PR + row * RW_COLS + 1024 + c);
            rp_[k] = *(const GAS v4u*)(PR + rowp * RW_COLS + c); kp_[k] = *(const GAS v4u*)(PR + rowp * RW_COLS + 512 + c); vp_[k] = *(const GAS v4u*)(PR + rowp * RW_COLS + 1024 + c);
            av_[k] = *(const GAS v4u*)(RA + row * 512 + c); gv_[k] = *(const GAS v4u*)(Y + row * 1024 + c); yv_[k] = *(const GAS v4u*)(YRAW + row * 512 + c);
            s1_[k] = RST[(row * 8 + hh) * 2]; s2_[k] = RST[(row * 8 + hh) * 2 + 1]; }
#pragma unroll
        for (int k = 0; k < 2; ++k) { const int m = m0 + k * NGW; if (m < M) { const size_t row = (size_t)m; const bool hp = (m & (SEQ - 1)) != 0; const v4u z = v4u{0u, 0u, 0u, 0u};
            float rc[8], rp[8], kc[8], kp[8], vc[8], vp[8], aa[8], gg[8], yy[8]; unpack8(rc_[k], rc); unpack8(hp ? rp_[k] : z, rp); unpack8(kc_[k], kc); unpack8(hp ? kp_[k] : z, kp); unpack8(vc_[k], vc); unpack8(hp ? vp_[k] : z, vp); unpack8(av_[k], aa); unpack8(gv_[k], gg); unpack8(yv_[k], yy);
            float vs[8]; float bon = 0.f;
#pragma unroll
            for (int e = 0; e < 8; ++e) { const float r = rc[e] + (rp[e] - rc[e]) * mur[e], kx = kc[e] + (kp[e] - kc[e]) * muk[e]; vs[e] = vc[e] + (vp[e] - vc[e]) * muv[e]; bon += r * (kx * (1.0f + (aa[e] - 1.0f) * cka[e])) * crk[e]; }
            bon += __shfl_xor(bon, 1); bon += __shfl_xor(bon, 2); bon += __shfl_xor(bon, 4);
            const float s1 = unfx20(s1_[k]), s2 = unfx20(s2_[k]); const float mean = s1 * (1.0f / 64.0f), var = fmaxf(s2 * (1.0f / 64.0f) - mean * mean, 0.f), rs = 1.0f / sqrtf(var + 64e-5f);
            float o[8];
#pragma unroll
            for (int e = 0; e < 8; ++e) o[e] = ((yy[e] - mean) * rs * clw[e] + clb[e] + bon * vs[e]) * gg[e];
            *(GAS v4u*)(Y + row * 1024 + c) = v4u{pk2(o[0], o[1]), pk2(o[2], o[3]), pk2(o[4], o[5]), pk2(o[6], o[7])}; } }
    }
}
__device__ __forceinline__ void lora_kmean_phase(Frame& F) {
    for (int u = F.vcu; u < 256; u += F.G) rwkv_lora_unit(F, u);
}

__device__ __forceinline__ int crow(int r, int hi) { return (r & 3) + 8 * (r >> 2) + 4 * hi; }
constexpr int MO_ROWB = 144;
constexpr int MO_BUF = 2 * 64 * MO_ROWB;
constexpr int MO_KM = 40960;
static_assert(2 * MO_BUF <= MO_KM && MO_KM + 2048 <= RING_BYTES, "MoBA LDS");
__device__ __forceinline__ void moba_unit(Frame& F, int b, int h, int qb) {
    const int tid = F.tid, lane = F.lane, wid = F.wave, r32 = lane & 31, hi = lane >> 5;
    const GAS bf16* QB = WSP(bf16, WS_QB); const GAS bf16* KB = WSP(bf16, WS_KB); const GAS bf16* VB = WSP(bf16, WS_VB); GAS bf16* Y = WSP(bf16, WS_Y); const GAS float* km = WSP(float, WS_KMEAN);
    const size_t rowbase = (size_t)b * SEQ; const int qpos = qb * 256 + wid * 32 + r32; const float NEG = -INFINITY;
    bf16x8 qr[4]; { const GAS bf16* qp = QB + (rowbase + qpos) * 512 + h * 64 + hi * 8;
#pragma unroll
        for (int d0 = 0; d0 < 4; ++d0) qr[d0] = *(const GAS bf16x8*)(qp + d0 * 16); }
    unsigned sel = 0u;
    if (qb > 0) {
        LAS float* KM = (LAS float*)(F.lds + MO_KM);
        __syncthreads();
        KM[tid] = km[(size_t)(b * 8 + h) * 8 * 64 + tid];
        __syncthreads();
        float gate[7];
#pragma unroll
        for (int n = 0; n < 7; ++n) { float g = 0.f;
            if (n < qb) { const LAS float* kp = KM + n * 64 + hi * 8;
#pragma unroll
                for (int d0 = 0; d0 < 4; ++d0) { const f32x4v k0 = *(const LAS f32x4v*)(kp + d0 * 16), k1 = *(const LAS f32x4v*)(kp + d0 * 16 + 4);
#pragma unroll
                    for (int j = 0; j < 4; ++j) { g += bf2f((bf16)qr[d0][j]) * k0[j]; g += bf2f((bf16)qr[d0][4 + j]) * k1[j]; } }
                g += __shfl_xor(g, 32); }
            gate[n] = (n < qb) ? g : NEG; }
        const int nsel = qb < 3 ? qb : 3;
#pragma unroll
        for (int s = 0; s < 3; ++s) { int best = 0; float bv = NEG; bool have = false;
#pragma unroll
            for (int n = 0; n < 7; ++n) { const bool ok = (n < qb) && !((sel >> n) & 1u) && (!have || gate[n] > bv); if (ok) { best = n; bv = gate[n]; have = true; } }
            if (s < nsel) sel |= 1u << best; }
    }
    const float C2 = 0.125f * 1.4426950408889634f, sl2 = exp2f(-(float)(h + 1)) * 1.4426950408889634f;
    const int NT = 4 * (qb + 1);
    f32x16 abias[2];
#pragma unroll
    for (int kb = 0; kb < 2; ++kb)
#pragma unroll
        for (int r = 0; r < 16; ++r) abias[kb][r] = sl2 * (float)(32 * kb + crow(r, hi));
    const GAS bf16* kg = KB + (rowbase + (tid >> 3)) * 512 + h * 64 + (tid & 7) * 8; const GAS bf16* vg = VB + (rowbase + lane) * 512 + h * 64 + wid * 8;
    const int kdst = (tid >> 3) * MO_ROWB + (tid & 7) * 16, vdst = 64 * MO_ROWB + (wid * 8) * MO_ROWB + lane * 2;
    f32x16 o[2]; o[0] = f32x16{}; o[1] = f32x16{}; float mrun = NEG, lrun = 0.f;
    v4u kreg, vreg;
    { const int kb0 = (4 * qb) * 64; kreg = *(const GAS v4u*)(kg + (size_t)kb0 * 512); vreg = *(const GAS v4u*)(vg + (size_t)kb0 * 512); }
    __syncthreads();
    { LAS unsigned char* B0 = F.lds; *(LAS v4u*)(B0 + kdst) = kreg; const unsigned w[4] = {vreg.x, vreg.y, vreg.z, vreg.w};
#pragma unroll
        for (int e = 0; e < 8; ++e) *(LAS unsigned short*)(B0 + vdst + e * MO_ROWB) = (unsigned short)((e & 1) ? (w[e >> 1] >> 16) : (w[e >> 1] & 0xffffu)); }
    __syncthreads();
    for (int it = 0; it < NT; ++it) {
        const int tk = (it < 4) ? 4 * qb + it : it - 4, kb0 = tk * 64, nb = tk >> 2;
        if (it + 1 < NT) { const int tn = (it + 1 < 4) ? 4 * qb + it + 1 : it - 3; kreg = *(const GAS v4u*)(kg + (size_t)tn * 64 * 512); vreg = *(const GAS v4u*)(vg + (size_t)tn * 64 * 512); }
        LAS unsigned char* Kb = F.lds + (it & 1) * MO_BUF; LAS unsigned char* Vb = Kb + 64 * MO_ROWB;
        const bool row_ok = (nb == qb) || ((sel >> nb) & 1u);
        f32x16 p[2];
#pragma unroll
        for (int kb = 0; kb < 2; ++kb) { p[kb] = f32x16{};
#pragma unroll
            for (int d0 = 0; d0 < 4; ++d0) { const bf16x8 a = *(const LAS bf16x8*)(Kb + (32 * kb + r32) * MO_ROWB + (d0 * 16 + hi * 8) * 2); p[kb] = __builtin_amdgcn_mfma_f32_32x32x16_bf16(a, qr[d0], p[kb], 0, 0, 0); } }
        float rmax = NEG; const float off = row_ok ? sl2 * (float)(kb0 - qpos) : NEG;
        p[0] = p[0] * C2 + (abias[0] + off); p[1] = p[1] * C2 + (abias[1] + off);
        if (nb == qb) {
#pragma unroll
            for (int kb = 0; kb < 2; ++kb)
#pragma unroll
                for (int r = 0; r < 16; ++r) { const int kpos = kb0 + 32 * kb + crow(r, hi); if (kpos > qpos) p[kb][r] = NEG; }
        }
        {   const f32x16 mx = __builtin_elementwise_max(p[0], p[1]);
#pragma unroll
            for (int r = 0; r < 16; ++r) rmax = fmaxf(rmax, mx[r]); }
        rmax = fmaxf(rmax, __shfl_xor(rmax, 32));
        const float mnew = fmaxf(mrun, rmax), alpha = __builtin_amdgcn_exp2f(mrun - mnew); mrun = mnew; lrun *= alpha;
        if (__any(alpha != 1.0f)) {
#pragma unroll
            for (int r = 0; r < 16; ++r) { o[0][r] *= alpha; o[1][r] *= alpha; } }
        p[0] = p[0] - mnew; p[1] = p[1] - mnew;
#pragma unroll
        for (int kb = 0; kb < 2; ++kb)
#pragma unroll
            for (int r = 0; r < 16; ++r) p[kb][r] = __builtin_amdgcn_exp2f(p[kb][r]);
        {   const f32x16 sv = p[0] + p[1]; float psum = 0.f;
#pragma unroll
            for (int r = 0; r < 16; ++r) psum += sv[r];
            lrun += psum; }
#pragma unroll
        for (int kb = 0; kb < 2; ++kb)
#pragma unroll
            for (int s2 = 0; s2 < 2; ++s2) { v4u pw; pw.x = pg8::cvt_pk_bf16(p[kb][8 * s2 + 0], p[kb][8 * s2 + 1]); pw.y = pg8::cvt_pk_bf16(p[kb][8 * s2 + 2], p[kb][8 * s2 + 3]);
                pw.z = pg8::cvt_pk_bf16(p[kb][8 * s2 + 4], p[kb][8 * s2 + 5]); pw.w = pg8::cvt_pk_bf16(p[kb][8 * s2 + 6], p[kb][8 * s2 + 7]);
                const bf16x8 pb = __builtin_bit_cast(bf16x8, pw); const int k0 = 32 * kb + 16 * s2 + 4 * hi;
#pragma unroll
                for (int db = 0; db < 2; ++db) { const LAS unsigned char* vp = Vb + (32 * db + r32) * MO_ROWB + k0 * 2;
                    const v2u lo = *(const LAS v2u*)vp, hi8 = *(const LAS v2u*)(vp + 16); const v4u av = {lo.x, lo.y, hi8.x, hi8.y};
                    o[db] = __builtin_amdgcn_mfma_f32_32x32x16_bf16(__builtin_bit_cast(bf16x8, av), pb, o[db], 0, 0, 0); } }
        if (it + 1 < NT) { LAS unsigned char* B1 = F.lds + ((it + 1) & 1) * MO_BUF; *(LAS v4u*)(B1 + kdst) = kreg; const unsigned w[4] = {vreg.x, vreg.y, vreg.z, vreg.w};
#pragma unroll
            for (int e = 0; e < 8; ++e) *(LAS unsigned short*)(B1 + vdst + e * MO_ROWB) = (unsigned short)((e & 1) ? (w[e >> 1] >> 16) : (w[e >> 1] & 0xffffu)); }
        __syncthreads();
    }
    lrun += __shfl_xor(lrun, 32); const float inv = 1.0f / lrun;
    GAS bf16* yp = Y + (rowbase + qpos) * 1024 + 512 + h * 64 + 4 * hi;
#pragma unroll
    for (int db = 0; db < 2; ++db)
#pragma unroll
        for (int g = 0; g < 4; ++g) *(GAS v2u*)(yp + 32 * db + 8 * g) = v2u{pk2(o[db][4 * g] * inv, o[db][4 * g + 1] * inv), pk2(o[db][4 * g + 2] * inv, o[db][4 * g + 3] * inv)};
}
__device__ __forceinline__ void moba_phase(Frame& F) {
    for (int u = F.vcu; u < 256; u += F.G) { const int bh = u >> 2, pr = u & 3; moba_unit(F, bh >> 3, bh & 7, pr); moba_unit(F, bh >> 3, bh & 7, 7 - pr); }
}

constexpr int HG_PQ = 272, HG_PS = 144;
constexpr int HG_QT = 0, HG_KT = HG_QT + 64 * HG_PQ, HG_KTT = HG_KT + 64 * HG_PQ, HG_IT = HG_KTT + 128 * HG_PS, HG_ST = HG_IT + 32 * HG_PS, HG_AS = HG_ST + 32 * HG_PQ, HG_TOT = HG_AS + 64 * HG_PS, HG_END = HG_TOT + 8 * 128 * 4;
constexpr int HG_OB = 81920, HG_POB = 80;
static_assert(HG_END <= HG_OB && HG_OB + 512 * HG_POB <= RING_BYTES, "HGRN2 LDS");
static_assert(HG_END <= RING_BYTES, "hgrn LDS");
__device__ __forceinline__ void hgrn_prep_phase(Frame& F) {
    const int tid = F.tid; LAS float* TOT = (LAS float*)(F.lds + HG_TOT);
    GAS bf16* HQ = WSP(bf16, WS_HQ); GAS bf16* HF = WSP(bf16, WS_HF); GAS bf16* KT2 = OSP(bf16, OS_KT2); GAS float* RB = WSP(float, WS_RB);
    const GAS float* lbl = inp(F, 24); const int kp = tid & 63, tq = tid >> 6;
    unsigned fr_n[8], qr_n[8];
#define HP_LOAD(U) do { const int u_ = (U); const int gc_ = ((u_ >> 5) & 7) * 128 + 2 * kp; const size_t r0_ = (size_t)(u_ >> 8) * SEQ + (u_ & 31) * 64 + 8 * tq; \
        _Pragma("unroll") for (int i = 0; i < 8; ++i) { fr_n[i] = *(const GAS unsigned*)(HF + (r0_ + i) * 1024 + gc_); qr_n[i] = *(const GAS unsigned*)(HQ + (r0_ + i) * 1024 + gc_); } } while (0)
    if (F.vcu < 2048) HP_LOAD(F.vcu);
    for (int u = F.vcu; u < 2048; u += F.G) {
        const int h = (u >> 5) & 7, gc = h * 128 + 2 * kp; const size_t r0 = (size_t)(u >> 8) * SEQ + (u & 31) * 64 + 8 * tq;
        const float lb0 = __builtin_amdgcn_rcpf(1.0f + __expf(lbl[gc] - lbl[1024 + gc])), lb1 = __builtin_amdgcn_rcpf(1.0f + __expf(lbl[gc + 1] - lbl[1024 + gc + 1]));
        float qv[8][2], kd[8][2], bl[8][2]; float run0 = 0.f, run1 = 0.f;
#pragma unroll
        for (int i = 0; i < 8; ++i) { const float s0 = sigmf(bflo(fr_n[i])), s1 = sigmf(bfhi(fr_n[i]));
            kd[i][0] = (1.0f - lb0) * (1.0f - s0); kd[i][1] = (1.0f - lb1) * (1.0f - s1); qv[i][0] = bflo(qr_n[i]); qv[i][1] = bfhi(qr_n[i]);
            run0 += __logf(lb0 + (1.0f - lb0) * s0); run1 += __logf(lb1 + (1.0f - lb1) * s1); bl[i][0] = run0; bl[i][1] = run1; }
        LDS_BARRIER();
        *(LAS v2f*)(TOT + tq * 128 + 2 * kp) = v2f{run0, run1};
        LDS_BARRIER();
        if (u + F.G < 2048) HP_LOAD(u + F.G);
        float off0 = 0.f, off1 = 0.f, rr0 = 0.f, rr1 = 0.f, bb0 = 0.f, bb1 = 0.f;
#pragma unroll
        for (int q = 0; q < 8; ++q) { const v2f tv = *(const LAS v2f*)(TOT + q * 128 + 2 * kp); if (q < tq) { off0 += tv[0]; off1 += tv[1]; } if (q < 4) { rr0 += tv[0]; rr1 += tv[1]; } bb0 += tv[0]; bb1 += tv[1]; }
        unsigned kw0[4], kw1[4];
#pragma unroll
        for (int i = 0; i < 8; ++i) { const float e0 = __expf(bl[i][0] + off0 - rr0), e1 = __expf(bl[i][1] + off1 - rr1);
            *(GAS unsigned*)(HQ + (r0 + i) * 1024 + gc) = pk2(qv[i][0] * e0, qv[i][1] * e1);
            const unsigned kk = pk2(kd[i][0] * __builtin_amdgcn_rcpf(e0), kd[i][1] * __builtin_amdgcn_rcpf(e1)); *(GAS unsigned*)(HF + (r0 + i) * 1024 + gc) = kk;
            if (i & 1) { kw0[i >> 1] |= kk << 16; kw1[i >> 1] |= kk & 0xffff0000u; } else { kw0[i >> 1] = kk & 0xffffu; kw1[i >> 1] = kk >> 16; } }
        GAS bf16* kt = KT2 + ((size_t)u * 128 + 2 * kp) * 64 + 8 * tq; *(GAS v4u*)kt = v4u{kw0[0], kw0[1], kw0[2], kw0[3]}; *(GAS v4u*)(kt + 64) = v4u{kw1[0], kw1[1], kw1[2], kw1[3]};
        if (tq == 0) { *(GAS v2f*)(RB + (size_t)u * 256 + 2 * kp) = v2f{rr0, rr1}; *(GAS v2f*)(RB + (size_t)u * 256 + 128 + 2 * kp) = v2f{bb0, bb1}; }
    }
#undef HP_LOAD
}
template <bool DRY> __device__ __forceinline__ void hgrn_unit(Frame& F, int b, int h, int vq) {
    const int tid = F.tid, lane = F.lane, w = F.wave, r16 = lane & 15, g4 = lane >> 4;
    LAS unsigned char* L = F.lds;
    const GAS bf16* HQ = WSP(bf16, WS_HQ); const GAS bf16* HF = WSP(bf16, WS_HF); GAS bf16* HI = WSP(bf16, WS_HI); GAS long long* HSS = OSP(long long, OS_HSS); const GAS bf16* KT2 = OSP(bf16, OS_KT2); const GAS float* RB = WSP(float, WS_RB);
    const size_t rowbase = (size_t)b * SEQ; const int ubase = (b * 8 + h) * 32;
    f32x4v S[2]; S[0] = f32x4v{0.f, 0.f, 0.f, 0.f}; S[1] = S[0];
    __syncthreads();
    for (int i = tid; i < 64 * HG_PS / 4; i += NTHREADS) ((LAS unsigned*)(L + HG_AS))[i] = 0u;
    const int tr = w >> 1, vc = w & 1;
    v4u q0A, q1A, k0A, k1A, t0A, t1A, q0B, q1B, k0B, k1B, t0B, t1B, rbA, rbB; v2u iiA, iiB;
#define HS_LOAD(C, q0_, q1_, k0_, k1_, t0_, t1_, ii_, rb_) do { const size_t row_ = rowbase + (size_t)(C) * 64 + (tid >> 3); const GAS bf16* qp_ = HQ + row_ * 1024 + h * 128 + (tid & 7) * 16; const GAS bf16* kp_ = HF + row_ * 1024 + h * 128 + (tid & 7) * 16; \
        q0_ = *(const GAS v4u*)qp_; q1_ = *(const GAS v4u*)(qp_ + 8); k0_ = *(const GAS v4u*)kp_; k1_ = *(const GAS v4u*)(kp_ + 8); \
        const GAS bf16* tp_ = KT2 + ((size_t)(ubase + (C)) * 128 + (tid >> 2)) * 64 + (tid & 3) * 16; t0_ = *(const GAS v4u*)tp_; t1_ = *(const GAS v4u*)(tp_ + 8); \
        ii_ = *(const GAS v2u*)(HI + row_ * 1024 + h * 128 + vq * 32 + (tid & 7) * 4); \
        rb_ = *(const GAS v4u*)(RB + (size_t)(ubase + (C)) * 256 + (tid & 63) * 4); } while (0)
#define HS_CHUNK(CC, q0_, q1_, k0_, k1_, t0_, t1_, ii_, rb_, rbn_) do { \
        LDS_BARRIER(); \
        const f32x4v rv_ = *(const LAS f32x4v*)(L + HG_TOT + ((CC) & 1) * 1024 + (16 * w + 4 * g4) * 4), bv_ = *(const LAS f32x4v*)(L + HG_TOT + ((CC) & 1) * 1024 + 512 + (16 * w + 4 * g4) * 4); \
        {   LAS unsigned char* qd = L + HG_QT + (tid >> 3) * HG_PQ + (tid & 7) * 32; *(LAS v4u*)qd = q0_; *(LAS v4u*)(qd + 16) = q1_; \
            LAS unsigned char* kd_ = L + HG_KT + (tid >> 3) * HG_PQ + (tid & 7) * 32; *(LAS v4u*)kd_ = k0_; *(LAS v4u*)(kd_ + 16) = k1_; \
            LAS unsigned char* td = L + HG_KTT + (tid >> 2) * HG_PS + (tid & 3) * 32; *(LAS v4u*)td = t0_; *(LAS v4u*)(td + 16) = t1_; \
            LAS unsigned char* id = L + HG_IT + ((tid & 7) * 4) * HG_PS + (tid >> 3) * 2; \
            *(LAS unsigned short*)(id) = (unsigned short)(ii_.x & 0xffffu); *(LAS unsigned short*)(id + HG_PS) = (unsigned short)(ii_.x >> 16); *(LAS unsigned short*)(id + 2 * HG_PS) = (unsigned short)(ii_.y & 0xffffu); *(LAS unsigned short*)(id + 3 * HG_PS) = (unsigned short)(ii_.y >> 16); } \
        HS_LOAD(((CC) + 2 < 32 ? (CC) + 2 : 31), q0_, q1_, k0_, k1_, t0_, t1_, ii_, rb_);         \
        float e63[4], e63r[4]; \
        {   float er[4]; \
_Pragma("unroll") \
            for (int rg = 0; rg < 4; ++rg) { er[rg] = __expf(rv_[rg]); e63[rg] = __expf(bv_[rg]); e63r[rg] = __expf(bv_[rg] - rv_[rg]); } \
_Pragma("unroll") \
            for (int cc = 0; cc < 2; ++cc) *(LAS v2u*)(L + HG_ST + (16 * cc + r16) * HG_PQ + (16 * w + 4 * g4) * 2) = v2u{pk2(S[cc][0] * er[0], S[cc][1] * er[1]), pk2(S[cc][2] * er[2], S[cc][3] * er[3])}; } \
        LDS_BARRIER(); \
        f32x4v oacc = f32x4v{0.f, 0.f, 0.f, 0.f}; \
        {   bf16x8 qa[4]; \
_Pragma("unroll") \
            for (int kk = 0; kk < 4; ++kk) qa[kk] = *(const LAS bf16x8*)(L + HG_QT + (16 * tr + r16) * HG_PQ + (32 * kk + 8 * g4) * 2); \
_Pragma("unroll") \
            for (int cc = 0; cc < 2; ++cc) { const int tc = 2 * vc + cc; \
                if (tc <= tr) { f32x4v acc = f32x4v{0.f, 0.f, 0.f, 0.f}; \
_Pragma("unroll") \
                    for (int kk = 0; kk < 4; ++kk) { const bf16x8 kb = *(const LAS bf16x8*)(L + HG_KT + (16 * tc + r16) * HG_PQ + (32 * kk + 8 * g4) * 2); acc = __builtin_amdgcn_mfma_f32_16x16x32_bf16(qa[kk], kb, acc, 0, 0, 0); } \
_Pragma("unroll") \
                    for (int rg = 0; rg < 4; ++rg) { const int t = 16 * tr + 4 * g4 + rg, s_ = 16 * tc + r16; *(LAS unsigned short*)(L + HG_AS + t * HG_PS + s_ * 2) = (unsigned short)f2bf(s_ <= t ? acc[rg] : 0.f); } } } \
_Pragma("unroll") \
            for (int kk = 0; kk < 4; ++kk) { const bf16x8 sb = *(const LAS bf16x8*)(L + HG_ST + (16 * vc + r16) * HG_PQ + (32 * kk + 8 * g4) * 2); oacc = __builtin_amdgcn_mfma_f32_16x16x32_bf16(qa[kk], sb, oacc, 0, 0, 0); } \
        } \
        f32x4v dS[2]; \
_Pragma("unroll") \
        for (int cc = 0; cc < 2; ++cc) { dS[cc] = f32x4v{0.f, 0.f, 0.f, 0.f}; \
_Pragma("unroll") \
            for (int kk = 0; kk < 2; ++kk) { const bf16x8 ka = *(const LAS bf16x8*)(L + HG_KTT + (16 * w + r16) * HG_PS + (32 * kk + 8 * g4) * 2); const bf16x8 ib = *(const LAS bf16x8*)(L + HG_IT + (16 * cc + r16) * HG_PS + (32 * kk + 8 * g4) * 2); \
                dS[cc] = __builtin_amdgcn_mfma_f32_16x16x32_bf16(ka, ib, dS[cc], 0, 0, 0); } } \
_Pragma("unroll") \
        for (int cc = 0; cc < 2; ++cc) \
_Pragma("unroll") \
            for (int rg = 0; rg < 4; ++rg) S[cc][rg] = e63[rg] * S[cc][rg] + e63r[rg] * dS[cc][rg]; \
        LDS_BARRIER(); \
        if (tid < 64) *(LAS v4u*)(L + HG_TOT + (((CC) + 1) & 1) * 1024 + tid * 16) = rbn_;                    \
_Pragma("unroll") \
        for (int kk = 0; kk < 2; ++kk) { const bf16x8 aa = *(const LAS bf16x8*)(L + HG_AS + (16 * tr + r16) * HG_PS + (32 * kk + 8 * g4) * 2); const bf16x8 ib = *(const LAS bf16x8*)(L + HG_IT + (16 * vc + r16) * HG_PS + (32 * kk + 8 * g4) * 2); \
            oacc = __builtin_amdgcn_mfma_f32_16x16x32_bf16(aa, ib, oacc, 0, 0, 0); } \
_Pragma("unroll") \
        for (int rg = 0; rg < 4; ++rg) *(LAS unsigned short*)(L + HG_OB + (((CC) & 7) * 64 + 16 * tr + 4 * g4 + rg) * HG_POB + (16 * vc + r16) * 2) = (unsigned short)f2bf(oacc[rg]); \
    } while (0)
    HS_LOAD(0, q0A, q1A, k0A, k1A, t0A, t1A, iiA, rbA);
    HS_LOAD(1, q0B, q1B, k0B, k1B, t0B, t1B, iiB, rbB);
    if (tid < 64) *(LAS v4u*)(L + HG_TOT + tid * 16) = rbA;
#pragma unroll
    for (int blk = 0; blk < 4; ++blk) {
#pragma unroll 1
        for (int c = 8 * blk; c < 8 * blk + 8; c += 2) {
            HS_CHUNK(c, q0A, q1A, k0A, k1A, t0A, t1A, iiA, rbA, rbB);
            HS_CHUNK(c + 1, q0B, q1B, k0B, k1B, t0B, t1B, iiB, rbB, rbA);
        }
        LDS_BARRIER();
        {
            const size_t row = rowbase + (size_t)blk * 512 + tid; const LAS unsigned char* op = L + HG_OB + tid * HG_POB; float ss = 0.f;
            GAS bf16* dst = (DRY ? WSP(bf16, WS_DRY) : HI) + (DRY ? (row & 2047) : row) * 1024 + h * 128 + vq * 32;
#pragma unroll
            for (int q = 0; q < 4; ++q) { const v4u v = *(const LAS v4u*)(op + 16 * q); *(GAS v4u*)(dst + 8 * q) = v;
#pragma unroll
                for (int e = 0; e < 8; ++e) { const float x = bfel(v, e); ss += x * x; } }
            if (!DRY) __hip_atomic_fetch_add(HSS + row * 8 + h, fx20(ss), __ATOMIC_RELAXED, __HIP_MEMORY_SCOPE_AGENT);
            __builtin_amdgcn_s_waitcnt(0x0F70);
        }
    }
#undef HS_CHUNK
#undef HS_LOAD
}
template <bool DRY> __device__ __forceinline__ void hgrn_phase(Frame& F) {
    for (int u = F.vcu; u < 256; u += F.G) hgrn_unit<DRY>(F, u >> 5, (u >> 2) & 7, u & 3);
}
__device__ __forceinline__ void hgrn_post_phase(Frame& F) {
    const int gw = F.vcu * NWAVES + F.wave, NGW = F.G * NWAVES, c0 = F.lane * 8; GAS bf16* HI = WSP(bf16, WS_HI); const GAS bf16* HG = WSP(bf16, WS_HG); const GAS long long* HSS = OSP(long long, OS_HSS); const GAS float* nw = inp(F, 23);
    float nwv[2][8];
#pragma unroll
    for (int j = 0; j < 2; ++j)
#pragma unroll
        for (int e = 0; e < 8; ++e) nwv[j][e] = nw[c0 + 512 * j + e];
    for (int m0 = gw; m0 < M; m0 += 4 * NGW) { v4u ov[4][2], gv[4][2]; long long hs[4][2];
#pragma unroll
        for (int k = 0; k < 4; ++k) { const int mk = m0 + k * NGW, m = mk < M ? mk : M - 1;
#pragma unroll
            for (int j = 0; j < 2; ++j) { const int c = c0 + 512 * j; hs[k][j] = HSS[(size_t)m * 8 + (c >> 7)]; ov[k][j] = *(const GAS v4u*)(HI + (size_t)m * 1024 + c); gv[k][j] = *(const GAS v4u*)(HG + (size_t)m * 1024 + c); } }
#pragma unroll
        for (int k = 0; k < 4; ++k) { const int m = m0 + k * NGW; if (m < M) {
#pragma unroll
            for (int j = 0; j < 2; ++j) { const int c = c0 + 512 * j; const float rs = 1.0f / sqrtf(unfx20(hs[k][j]) * (1.0f / 128.0f) + 1e-6f);
                const unsigned ow[4] = {ov[k][j].x, ov[k][j].y, ov[k][j].z, ov[k][j].w}, gw4[4] = {gv[k][j].x, gv[k][j].y, gv[k][j].z, gv[k][j].w}; unsigned rw[4];
#pragma unroll
                for (int e = 0; e < 4; ++e) { const float o0 = __builtin_bit_cast(float, ow[e] << 16), o1 = __builtin_bit_cast(float, ow[e] & 0xffff0000u), g0 = __builtin_bit_cast(float, gw4[e] << 16), g1 = __builtin_bit_cast(float, gw4[e] & 0xffff0000u);
                    rw[e] = pk2(o0 * rs * nwv[j][2 * e] * sigmf(g0), o1 * rs * nwv[j][2 * e + 1] * sigmf(g1)); }
                *(GAS v4u*)(HI + (size_t)m * 1024 + c) = v4u{rw[0], rw[1], rw[2], rw[3]}; } } }
    }
}

__device__ __forceinline__ void final_phase(Frame& F) {
    const int gw = F.vcu * NWAVES + F.wave, NGW = F.G * NWAVES, c0 = F.lane * 8; const GAS float* fg = inp(F, 25); const GAS pg8::ssq_t* ssq = SSQ_SLOT(6); const GAS bf16* XB = WSP(bf16, WS_XB);
    f32x4 g[2][2];
#pragma unroll
    for (int j = 0; j < 2; ++j) { g[j][0] = *(const GAS f32x4*)(fg + c0 + 512 * j); g[j][1] = *(const GAS f32x4*)(fg + c0 + 512 * j + 4); }
    for (int m0 = gw; m0 < M; m0 += 4 * NGW) { v4u xr[4][2]; pg8::ssq_t sq[4];
#pragma unroll
        for (int k = 0; k < 4; ++k) { const int mk = m0 + k * NGW, m = mk < M ? mk : M - 1; sq[k] = ssq[m];
#pragma unroll
            for (int j = 0; j < 2; ++j) xr[k][j] = *(const GAS v4u*)(XB + (size_t)m * D + c0 + 512 * j); }
#pragma unroll
        for (int k = 0; k < 4; ++k) { const int m = m0 + k * NGW; if (m < M) { const float rs = pg8::ssq_to_rstd(sq[k]);
#pragma unroll
            for (int j = 0; j < 2; ++j) { float xv[8]; unpack8(xr[k][j], xv); GAS f32x4* o = (GAS f32x4*)(F.out + (size_t)m * D + c0 + 512 * j);
                o[0] = (f32x4){xv[0] * rs * g[j][0][0], xv[1] * rs * g[j][0][1], xv[2] * rs * g[j][0][2], xv[3] * rs * g[j][0][3]}; o[1] = (f32x4){xv[4] * rs * g[j][1][0], xv[5] * rs * g[j][1][1], xv[6] * rs * g[j][1][2], xv[7] * rs * g[j][1][3]}; } } }
    }
}

#ifndef PROBE_DBL
#define PROBE_DBL 0
#endif
#ifndef MK_N_LAUNCHES
#define MK_N_LAUNCHES 1
#endif
constexpr int NPHASE = 17;
__global__ void __launch_bounds__(NTHREADS, 2) hyb_fwd(Args args) {
    extern __shared__ __attribute__((aligned(16))) unsigned char lds[];
    Frame F0;
    F0.lds = (LAS unsigned char*)lds; F0.MISC = (volatile LAS unsigned*)(F0.lds + MISC_OFF);
    F0.tid = threadIdx.x; F0.lane = F0.tid & 63; F0.wave = __builtin_amdgcn_readfirstlane(F0.tid >> 6);
    F0.G = gridDim.x; { const int bx = blockIdx.x; F0.vcu = (F0.G % 8 == 0) ? (bx % 8) * (F0.G / 8) + bx / 8 : bx; }
    F0.out = (GAS float*)args.out; F0.ws = (GAS unsigned char*)args.ws; F0.ctl = (gu32*)(args.ws + WS_CTL);
    for (int u = F0.tid; u < (LDS_BYTES - LDSCTL_OFF) / 4; u += NTHREADS) ((LAS unsigned*)(F0.lds + LDSCTL_OFF))[u] = 0u;
    __syncthreads();
    if (F0.tid == 0) {
#pragma unroll
        for (int i = 0; i < N_IN; ++i) ((LAS unsigned long long*)(F0.lds + PTAB_OFF))[i] = (unsigned long long)args.in[i]; }
    __syncthreads();
    XcdBarrier bar; bar.bar = (unsigned*)(F0.ctl + CW_BAR); bar.x = 0; bar.st = nullptr;
    if (MK_N_LAUNCHES == 1) bar = xcd_barrier_post((unsigned*)(F0.ctl + CW_BAR), F0.MISC + 8);
    const int lo = args.ph_lo, hi = args.ph_hi;
#define IN(k) (MK_N_LAUNCHES == 1 || in_range((k), lo, hi))
#define GBAR() do { asm volatile("" : "+s"(bar.bar), "+s"(bar.x)); xcd_barrier(bar); } while (0)
#define SEAM(k) do { if (MK_N_LAUNCHES == 1) GBAR(); } while (0)
    if (IN(0)) { if (PROBE_DBL & 1) { { PHASE_FRAME(F); prologue_phase(F); } GBAR(); } PHASE_FRAME(F); prologue_phase(F); SEAM(0); }
#pragma unroll
    for (int f = 0; f < 4; ++f) {
        const int pu = (f == 0) ? 1 : (f == 1) ? 7 : (f == 2) ? 9 : 14;
        if (IN(pu)) { PHASE_FRAME(F);
            pg8::Gemm g{(const bf16*)WSP(bf16, WS_XB), (const bf16*)WSP(bf16, WS_WUP + f * W_UP_BYTES), M, 2 * FF, D}; pg8::StaticOrder S; S.init(M, 2 * FF, F.G, (int)blockIdx.x);
            pg8::EpiSwiglu E{WSP(bf16, WS_H), FF, SSQ_SLOT((f == 0) ? 0 : (f == 1) ? 2 : (f == 2) ? 3 : 5)};
            if (PROBE_DBL & (2 | 128)) { pg8::gemm_phase<pg8::EpiSwiglu, pg8::StaticOrder, true, true>(F.lds, g, S, E); GBAR(); }
            pg8::gemm_phase<pg8::EpiSwiglu, pg8::StaticOrder, true, true>(F.lds, g, S, E);
            {
                constexpr int UP_IDLE0 = (M / 256) * (2 * FF / 256) % 256; static_assert(UP_IDLE0 == 128, "idle tail of the up GEMM");
                if ((int)blockIdx.x >= UP_IDLE0 && F.G == 256) { const int rk = ((int)blockIdx.x - UP_IDLE0) * NWAVES + F.wave, nr = (256 - UP_IDLE0) * NWAVES;
                    if (f == 0) convert_items(F, CV_G1, CV_G2, rk, nr); else if (f == 1) convert_items(F, CV_G3, CV_G4, rk, nr); else if (f == 2) convert_items(F, CV_G4, CV_G5, rk, nr); else convert_items(F, CV_G5, CV_END, rk, nr); }
                else if (F.G != 256) { const int gw_ = (int)blockIdx.x * NWAVES + F.wave, nr_ = F.G * NWAVES;
                    if (f == 0) convert_items(F, CV_G1, CV_G2, gw_, nr_); else if (f == 1) convert_items(F, CV_G3, CV_G4, gw_, nr_); else if (f == 2) convert_items(F, CV_G4, CV_G5, gw_, nr_); else convert_items(F, CV_G5, CV_END, gw_, nr_); } }
            SEAM(pu);
        }
        if (IN(pu + 1)) { PHASE_FRAME(F);
            pg8::Gemm g{(const bf16*)WSP(bf16, WS_H), (const bf16*)WSP(bf16, WS_WDN + f * W_DN_BYTES), M, D, FF}; pg8::StaticOrder S; S.init(M, D, F.G, (int)blockIdx.x);
            pg8::EpiResid E{WSP(bf16, WS_XB), SSQ_SLOT((f == 0) ? 1 : (f == 1) ? 3 : (f == 2) ? 4 : 6), 0.5f};
            if (PROBE_DBL & (2 | 256)) { pg8::EpiResid E0 = E; E0.alpha = 0.f; pg8::gemm_phase<pg8::EpiResid, pg8::StaticOrder, true, true>(F.lds, g, S, E0); GBAR(); }
            pg8::gemm_phase<pg8::EpiResid, pg8::StaticOrder, true, true>(F.lds, g, S, E);
            SEAM(pu + 1);
        }
        if (f == 0) {
            if (IN(3)) { PHASE_FRAME(F);
                pg8::Gemm g{(const bf16*)WSP(bf16, WS_XB), (const bf16*)WSP(bf16, WS_WEVIN), M, EV_IN, D}; pg8::StaticOrder S; S.init(M, EV_IN, F.G, (int)blockIdx.x);
                pg8::EpiProj E{WSP(bf16, WS_PR), RW_COLS, RW_COLS / 256, WSP(bf16, WS_QB), 512, 2, (size_t)M * 512, SSQ_SLOT(1), WSP(float, WS_KMEAN), RW_COLS / 256 + 2};
                if (PROBE_DBL & (2 | 512)) { pg8::EpiProj E0 = E; E0.kmean = nullptr; pg8::gemm_phase<pg8::EpiProj, pg8::StaticOrder, true, true>(F.lds, g, S, E0); GBAR(); }
                pg8::gemm_phase<pg8::EpiProj, pg8::StaticOrder, true, true>(F.lds, g, S, E);
                {
                    if ((int)blockIdx.x >= 64 && F.G == 256) convert_items(F, CV_G2, CV_G3, ((int)blockIdx.x - 64) * NWAVES + F.wave, 192 * NWAVES);
                    else if (F.G != 256) convert_items(F, CV_G2, CV_G3, (int)blockIdx.x * NWAVES + F.wave, F.G * NWAVES); }
                SEAM(3);
            }
                        if (IN(5)) { if (PROBE_DBL & 4) { { PHASE_FRAME(F); lora_kmean_phase(F); } GBAR(); } { PHASE_FRAME(F); lora_kmean_phase(F); } if (PROBE_DBL & 8) { { PHASE_FRAME(F); moba_phase(F); } GBAR(); } { PHASE_FRAME(F); moba_phase(F); } if (MK_N_LAUNCHES == 1) GBAR(); if (PROBE_DBL & 4096) { { PHASE_FRAME(F); rwkv_gram_phase(F); } GBAR(); } { PHASE_FRAME(F); rwkv_gram_phase(F); } GBAR(); if (PROBE_DBL & 16) { { PHASE_FRAME(F); rwkv_cscan_phase<true, false>(F); } GBAR(); } if (PROBE_DBL & 8192) { { PHASE_FRAME(F); rwkv_cscan_phase<true, true>(F); } GBAR(); } { PHASE_FRAME(F); rwkv_cscan_phase(F); } if (MK_N_LAUNCHES == 1) GBAR(); { PHASE_FRAME(F); rwkv_post_phase(F); } SEAM(5); }
            if (IN(6)) { PHASE_FRAME(F);
                pg8::Gemm g{(const bf16*)WSP(bf16, WS_Y), (const bf16*)WSP(bf16, WS_WEVOUT), M, D, D}; pg8::StaticOrder S; S.init(M, D, F.G, (int)blockIdx.x);
                pg8::EpiResid E{WSP(bf16, WS_XB), SSQ_SLOT(2), 1.0f};
                if (PROBE_DBL & (2 | 256)) { pg8::EpiResid E0 = E; E0.alpha = 0.f; pg8::gemm_phase<pg8::EpiResid, pg8::StaticOrder, true, true>(F.lds, g, S, E0); GBAR(); }
                pg8::gemm_phase<pg8::EpiResid, pg8::StaticOrder, true, true>(F.lds, g, S, E);
                SEAM(6);
            }
        }
        if (f == 2) {
            if (IN(11)) { PHASE_FRAME(F);
                pg8::Gemm g{(const bf16*)WSP(bf16, WS_XB), (const bf16*)WSP(bf16, WS_WODIN), M, OD_IN, D}; pg8::StaticOrder S; S.init(M, OD_IN, F.G, (int)blockIdx.x);
                pg8::EpiProj E{nullptr, 0, 0, WSP(bf16, WS_HQ), 1024, 4, (size_t)M * 1024, SSQ_SLOT(4), nullptr, 0};
                if (PROBE_DBL & (2 | 512)) { pg8::EpiProj E0 = E; E0.kmean = nullptr; pg8::gemm_phase<pg8::EpiProj, pg8::StaticOrder, true, true>(F.lds, g, S, E0); GBAR(); }
                pg8::gemm_phase<pg8::EpiProj, pg8::StaticOrder, true, true>(F.lds, g, S, E);
                SEAM(11);
            }
            if (IN(12)) { { PHASE_FRAME(F); hgrn_prep_phase(F); } GBAR(); if (PROBE_DBL & 32) { { PHASE_FRAME(F); hgrn_phase<true>(F); } GBAR(); } { PHASE_FRAME(F); hgrn_phase<false>(F); } if (MK_N_LAUNCHES == 1) GBAR(); { PHASE_FRAME(F); hgrn_post_phase(F); } SEAM(12); }
            if (IN(13)) { PHASE_FRAME(F);
                pg8::Gemm g{(const bf16*)WSP(bf16, WS_HI), (const bf16*)WSP(bf16, WS_WODOUT), M, D, D}; pg8::StaticOrder S; S.init(M, D, F.G, (int)blockIdx.x);
                pg8::EpiResid E{WSP(bf16, WS_XB), SSQ_SLOT(5), 1.0f};
                if (PROBE_DBL & (2 | 256)) { pg8::EpiResid E0 = E; E0.alpha = 0.f; pg8::gemm_phase<pg8::EpiResid, pg8::StaticOrder, true, true>(F.lds, g, S, E0); GBAR(); }
                pg8::gemm_phase<pg8::EpiResid, pg8::StaticOrder, true, true>(F.lds, g, S, E);
                SEAM(13);
            }
        }
    }
    if (PROBE_DBL & 64) { for (int i_ = 0; i_ < 20; ++i_) GBAR(); }
    if (IN(16)) { PHASE_FRAME(F); final_phase(F); }
#undef IN
#undef SEAM
}

extern "C" void kernel_launch(void* const* d_in, const int* in_sizes, int n_in, void* d_out, int out_size, void* d_ws, size_t ws_size, hipStream_t stream) {
    static int grid = 0;
    if (grid == 0) {
        if (n_in != N_IN || in_sizes[0] != M * D || out_size != M * D || ws_size < WS_END) { fprintf(stderr, "kernel_launch: unexpected shapes (n_in %d in0 %d out %d ws %zu); nothing launched\n", n_in, n_in > 0 ? in_sizes[0] : -1, out_size, ws_size); grid = -1; return; }
        int dev = 0, cus = 0, per_cu = 0;
        if (hipGetDevice(&dev) != hipSuccess || hipDeviceGetAttribute(&cus, hipDeviceAttributeMultiprocessorCount, dev) != hipSuccess) { grid = -1; return; }
        if (hipFuncSetAttribute((const void*)hyb_fwd, hipFuncAttributeMaxDynamicSharedMemorySize, LDS_BYTES) != hipSuccess) { fprintf(stderr, "kernel_launch: hipFuncSetAttribute failed\n"); grid = -1; return; }
        if (hipOccupancyMaxActiveBlocksPerMultiprocessor(&per_cu, (const void*)hyb_fwd, NTHREADS, LDS_BYTES) != hipSuccess || per_cu < 1) { fprintf(stderr, "kernel_launch: occupancy query says %d\n", per_cu); }
        (void)hipGetLastError();
        grid = cus;
    }
    if (grid < 0) return;
    if (hipMemsetAsync((char*)d_ws + WS_CTL, 0, CTL_ZERO_BYTES, stream) != hipSuccess) return;
    if (hipMemsetAsync((char*)d_out + OS_ZERO_BEGIN, 0, OS_ZERO_BYTES, stream) != hipSuccess) return;
    Args a{};
    for (int i = 0; i < N_IN; ++i) a.in[i] = (const float*)d_in[i];
    a.out = (float*)d_out; a.ws = (unsigned char*)d_ws;
    if (MK_N_LAUNCHES == 1) { a.ph_lo = 0; a.ph_hi = NPHASE; a.li = 0; hipLaunchKernelGGL(hyb_fwd, dim3(grid), dim3(NTHREADS), LDS_BYTES, stream, a); }
    else for (int li = 0; li < NPHASE; ++li) { a.ph_lo = li; a.ph_hi = li + 1; a.li = 0; hipLaunchKernelGGL(hyb_fwd, dim3(grid), dim3(NTHREADS), LDS_BYTES, stream, a); }
}
```

```cpp
#include <hip/hip_runtime.h>
#include <cstdio>
#include <cstdint>
namespace pg8 {
#define PG8_LAS __attribute__((address_space(3)))
typedef unsigned short bf16_t;
typedef short bf16x8 __attribute__((ext_vector_type(8)));
typedef float f32x4 __attribute__((ext_vector_type(4)));
typedef unsigned u32x4 __attribute__((ext_vector_type(4)));
constexpr int BM = 256, BK = 64, HALF = 128, HTB = HALF * BK * 2  , STAGE_BYTES = 8 * HTB, NXCD = 8, WGM = 8;

__host__ __device__ __forceinline__ int lds_byte(int r, int c) { const int st = (r >> 4) * 2 + (c >> 5), rr = r & 15, cc = c & 31, ob = rr * 64 + cc * 2; return st * 1024 + (ob ^ (((ob >> 9) & 1) << 5)); }
__host__ __device__ __forceinline__ void stage_rc(int b, int& R, int& C) { const int st = b / 1024, sb = b % 1024, swz = sb ^ (((sb >> 9) & 1) << 5); R = (st >> 1) * 16 + swz / 64; C = (st & 1) * 32 + (swz % 64) / 2; }
__host__ __device__ __forceinline__ int perm32(int rho) { const int n = rho >> 4, i = rho & 15; return 8 * (i >> 2) + 4 * n + (i & 3); }

struct Unit { int pm, pn; };
struct Gemm { const bf16_t* A; const bf16_t* Bt; int M, N, K; };

struct StaticOrder {
    int nM, nN, nwg, G, c;
    __host__ __device__ void init(int M, int N, int G_, int c_) { nM = M / BM; nN = N / BM; nwg = nM * nN; G = G_; c = c_; }
    __host__ __device__ bool next(int i, Unit& u) const {
        const long L = (long)i * G + c; if (L >= nwg) return false;
        int wgid = (int)L; { const int q = nwg / NXCD, r = nwg % NXCD, xcd = wgid % NXCD, off = wgid / NXCD; wgid = (xcd < r ? xcd * (q + 1) : r * (q + 1) + (xcd - r) * q) + off; }
        const int nig = WGM * nN, gid = wgid / nig, fm = gid * WGM, gsz = (nM - fm) < WGM ? (nM - fm) : WGM;
        u.pm = fm + ((wgid % nig) % gsz); u.pn = (wgid % nig) / gsz; return true;
    }
    __device__ __forceinline__ void a_ready(const Unit&) const {}
    __device__ __forceinline__ void done(const Unit&) const {}
};

__device__ __forceinline__ unsigned cvt_pk_bf16(float lo, float hi) { unsigned r; asm volatile("v_cvt_pk_bf16_f32 %0, %1, %2" : "=v"(r) : "v"(lo), "v"(hi)); return r; }
typedef float f32x2 __attribute__((ext_vector_type(2)));
#define PG8_GAS __attribute__((address_space(1)))
typedef unsigned long long ssq_t;
__device__ __forceinline__ float ssq_to_rstd(ssq_t v) { return __builtin_amdgcn_rsqf((float)v * (1.0f / (16777216.0f * 1024.0f)) + 1e-6f); }
__device__ __forceinline__ ssq_t ssq_fix(float s) { return (ssq_t)(s * 16777216.0f + 0.5f); }
__device__ __forceinline__ float row_rstd(const PG8_GAS ssq_t* ssq, int row) { return ssq_to_rstd(ssq[row]); }
__device__ __forceinline__ float silu_f(float x) { return x * __builtin_amdgcn_rcpf(1.0f + __builtin_amdgcn_exp2f(-1.4426950408889634f * x)); }
struct EpiSwiglu {
    static constexpr bool PERM = true, AFTER_DRAIN = false;
    PG8_GAS bf16_t* H; int ldh; const PG8_GAS ssq_t* ssq;
    __device__ __forceinline__ void operator()(const f32x4 (&acc)[2][2][4][2], const Unit& u, int wr, int wc, int fr, int fq) const {
        const int row0 = u.pm * BM + wr * 64 + fr, col0 = u.pn * HALF + wc * 32 + 8 * fq; ssq_t rsv[2][4];
#pragma unroll
        for (int ai = 0; ai < 2; ++ai)
#pragma unroll
            for (int m = 0; m < 4; ++m) rsv[ai][m] = ssq[row0 + ai * HALF + m * 16];
#pragma unroll
        for (int ai = 0; ai < 2; ++ai)
#pragma unroll
            for (int m = 0; m < 4; ++m) { const int row = row0 + ai * HALF + m * 16; const float rs = ssq_to_rstd(rsv[ai][m]), cexp = -1.4426950408889634f * rs, rs2 = rs * rs;
                typedef float v2f_ __attribute__((ext_vector_type(2))); u32x4 w; unsigned wv[4];
#pragma unroll
                for (int p = 0; p < 4; ++p) { const f32x4 gq = acc[ai][0][m][p >> 1], uq = acc[ai][1][m][p >> 1]; const v2f_ g = {gq[2 * (p & 1)], gq[2 * (p & 1) + 1]}, u = {uq[2 * (p & 1)], uq[2 * (p & 1) + 1]};
                    const v2f_ t = g * cexp; v2f_ d = {__builtin_amdgcn_exp2f(t.x), __builtin_amdgcn_exp2f(t.y)}; d = d + 1.0f; const v2f_ r = {__builtin_amdgcn_rcpf(d.x), __builtin_amdgcn_rcpf(d.y)};
                    const v2f_ o = (g * u) * (r * rs2); wv[p] = cvt_pk_bf16(o.x, o.y); }
                w.x = wv[0]; w.y = wv[1]; w.z = wv[2]; w.w = wv[3];
                *(PG8_GAS u32x4*)(H + (size_t)row * ldh + col0) = w; }
    }
};
struct EpiProj {
    static constexpr bool PERM = true, AFTER_DRAIN = false;
    PG8_GAS bf16_t* OA; int ldA; int ntA; PG8_GAS bf16_t* OB; int ldB; int tpB; size_t strideB; const PG8_GAS ssq_t* ssq; PG8_GAS float* kmean; int kt0;
    __device__ __forceinline__ void operator()(const f32x4 (&acc)[2][2][4][2], const Unit& u, int wr, int wc, int fr, int fq) const {
        const int row0 = u.pm * BM + wr * 64 + fr; PG8_GAS bf16_t* base; int ld, colt; f32x4 cs[2][2]; const bool km = kmean != nullptr && (unsigned)(u.pn - kt0) < 2u;
#pragma unroll
        for (int bj = 0; bj < 2; ++bj) { cs[bj][0] = (f32x4){0.f, 0.f, 0.f, 0.f}; cs[bj][1] = cs[bj][0]; }
        if (u.pn < ntA) { base = OA; ld = ldA; colt = u.pn * BM; } else { const int q = u.pn - ntA, t = q / tpB; base = OB + (size_t)t * strideB; ld = ldB; colt = (q - t * tpB) * BM; }
        const int col0 = colt + wc * 32 + 8 * fq; ssq_t rsv[2][4];
#pragma unroll
        for (int ai = 0; ai < 2; ++ai)
#pragma unroll
            for (int m = 0; m < 4; ++m) rsv[ai][m] = ssq[row0 + ai * HALF + m * 16];
#pragma unroll
        for (int ai = 0; ai < 2; ++ai)
#pragma unroll
            for (int m = 0; m < 4; ++m) { const int row = row0 + ai * HALF + m * 16; const float rs = ssq_to_rstd(rsv[ai][m]); PG8_GAS bf16_t* rowp = base + (size_t)row * ld + col0;
#pragma unroll
                for (int bj = 0; bj < 2; ++bj) { const f32x4 v0 = acc[ai][bj][m][0] * rs, v1 = acc[ai][bj][m][1] * rs; cs[bj][0] += v0; cs[bj][1] += v1;
                    u32x4 w; w.x = cvt_pk_bf16(v0[0], v0[1]); w.y = cvt_pk_bf16(v0[2], v0[3]); w.z = cvt_pk_bf16(v1[0], v1[1]); w.w = cvt_pk_bf16(v1[2], v1[3]);
                    *(PG8_GAS u32x4*)(rowp + bj * HALF) = w; } }
        if (km) {
            const int ck0 = (u.pn - kt0) * BM + wc * 32 + 8 * fq; PG8_GAS float* kb = kmean + (size_t)((u.pm >> 3) * 8) * 8 * 64 + (size_t)(u.pm & 7) * 64;
#pragma unroll
            for (int bj = 0; bj < 2; ++bj)
#pragma unroll
                for (int n = 0; n < 2; ++n)
#pragma unroll
                    for (int e = 0; e < 4; ++e) { float v = cs[bj][n][e]; v += __shfl_xor(v, 1); v += __shfl_xor(v, 2); v += __shfl_xor(v, 4); v += __shfl_xor(v, 8);
                        if (fr == 0) { const int ck = ck0 + bj * HALF + 4 * n + e; __builtin_amdgcn_global_atomic_fadd_f32(kb + (size_t)(ck >> 6) * 8 * 64 + (ck & 63), v * (1.0f / 256.0f)); } } }
    }
};
struct EpiResid {
    static constexpr bool PERM = false, AFTER_DRAIN = false;
    PG8_GAS bf16_t* XB; PG8_GAS ssq_t* ssq; float alpha;
    __device__ __forceinline__ void operator()(const f32x4 (&acc)[2][2][4][2], const Unit& u, int wr, int wc, int fr, int fq) const {
        typedef unsigned u32x2v __attribute__((ext_vector_type(2)));
        const int row0 = u.pm * BM + wr * 64 + fr, col0 = u.pn * BM + wc * 32 + 4 * fq;
        u32x2v bcur[2][2], bnxt[2][2];
#pragma unroll
        for (int bj = 0; bj < 2; ++bj)
#pragma unroll
            for (int n = 0; n < 2; ++n) bcur[bj][n] = *(const PG8_GAS u32x2v*)(XB + (size_t)row0 * 1024 + col0 + bj * HALF + n * 16);
#pragma unroll
        for (int g = 0; g < 8; ++g) { const int ai = g >> 2, m = g & 3; const int row = row0 + ai * HALF + m * 16; const size_t off = (size_t)row * 1024 + col0; float ss = 0.f;
            if (g < 7) { const int rown = row0 + ((g + 1) >> 2) * HALF + ((g + 1) & 3) * 16;
#pragma unroll
                for (int bj = 0; bj < 2; ++bj)
#pragma unroll
                    for (int n = 0; n < 2; ++n) bnxt[bj][n] = *(const PG8_GAS u32x2v*)(XB + (size_t)rown * 1024 + col0 + bj * HALF + n * 16); }
#pragma unroll
            for (int bj = 0; bj < 2; ++bj)
#pragma unroll
                for (int n = 0; n < 2; ++n) { const u32x2v bw = bcur[bj][n];
                    const f32x4 b = (f32x4){__builtin_bit_cast(float, bw.x << 16), __builtin_bit_cast(float, bw.x & 0xffff0000u), __builtin_bit_cast(float, bw.y << 16), __builtin_bit_cast(float, bw.y & 0xffff0000u)};
                    const f32x4 o = b + acc[ai][bj][m][n] * alpha; u32x2v w; w.x = cvt_pk_bf16(o[0], o[1]); w.y = cvt_pk_bf16(o[2], o[3]); *(PG8_GAS u32x2v*)(XB + off + bj * HALF + n * 16) = w;
                    const float r0 = __builtin_bit_cast(float, w.x << 16), r1 = __builtin_bit_cast(float, w.x & 0xffff0000u), r2 = __builtin_bit_cast(float, w.y << 16), r3 = __builtin_bit_cast(float, w.y & 0xffff0000u);
                    ss += (r0 * r0 + r1 * r1) + (r2 * r2 + r3 * r3); }
            ss += __shfl_xor(ss, 16); ss += __shfl_xor(ss, 32);
            if (fq == 0 && alpha != 0.f) __hip_atomic_fetch_add(ssq + row, ssq_fix(ss), __ATOMIC_RELAXED, __HIP_MEMORY_SCOPE_AGENT);
#pragma unroll
            for (int bj = 0; bj < 2; ++bj)
#pragma unroll
                for (int n = 0; n < 2; ++n) bcur[bj][n] = bnxt[bj][n];
            asm volatile("" ::: "memory"); }
    }
};

template <class Epi, class Sched, bool ALIGN_EPI = false, bool SP2 = false>
__device__ __forceinline__ void gemm_phase(PG8_LAS unsigned char* lds, const Gemm g, const Sched& S, const Epi& E) {
    int tid_l = threadIdx.x; asm volatile("" : "+v"(tid_l));
    const int tid = tid_l, wid = __builtin_amdgcn_readfirstlane(tid >> 6), lane = tid & 63, wr = wid >> 2, wc = wid & 3, fr = lane & 15, fq = lane >> 4;
    const int K = g.K, nt = K / BK;
    unsigned voffA[2], voffB[2];
#pragma unroll
    for (int i = 0; i < 2; ++i) { int R, C; stage_rc(tid * 16 + i * 8192, R, C); const int Rb = Epi::PERM ? ((R & ~31) + perm32(R & 31)) : R;
        voffA[i] = (unsigned)(R * K + C) * 2u; voffB[i] = (unsigned)(Rb * K + C) * 2u; }
    const size_t kstep = (size_t)(BK * 2);
    const size_t hstep = (size_t)HALF * K * 2;
    const size_t tstep = 2 * hstep;
    const unsigned ldsw = (unsigned)wid * 1024u;
    const int aoff = lds_byte(wr * 64 + fr, fq * 8), boff = lds_byte(wc * 32 + fr, fq * 8);
#define PG8_SA(b, h) (((b) * 2 + (h)) * HTB)
#define PG8_SB(b, h) ((4 + (b) * 2 + (h)) * HTB)
#define PG8_STAGE(bufoff, gbase, voff) do { _Pragma("unroll") for (int _i = 0; _i < 2; ++_i) \
        __builtin_amdgcn_global_load_lds((const unsigned*)((const char*)(gbase) + (voff)[_i]), (PG8_LAS unsigned*)(lds + (bufoff) + ldsw + _i * 8192), 16, 0, 0); } while (0)
#define PG8_LDA(dst, b, h) do { _Pragma("unroll") for (int m = 0; m < 4; ++m) _Pragma("unroll") for (int k = 0; k < 2; ++k) dst[m][k] = *(const PG8_LAS bf16x8*)(lds + PG8_SA(b, h) + aoff + m * 2048 + k * 1024); } while (0)
#define PG8_LDB(dst, b, h) do { _Pragma("unroll") for (int n = 0; n < 2; ++n) _Pragma("unroll") for (int k = 0; k < 2; ++k) dst[n][k] = *(const PG8_LAS bf16x8*)(lds + PG8_SB(b, h) + boff + n * 2048 + k * 1024); } while (0)
#define PG8_MMA(ai, bj, At, Bt) do { __builtin_amdgcn_s_setprio(1); _Pragma("unroll") for (int m = 0; m < 4; ++m) _Pragma("unroll") for (int n = 0; n < 2; ++n) _Pragma("unroll") for (int k = 0; k < 2; ++k) \
        acc[ai][bj][m][n] = __builtin_amdgcn_mfma_f32_16x16x32_bf16(Bt[n][k], At[m][k], acc[ai][bj][m][n], 0, 0, 0); __builtin_amdgcn_s_setprio(0); } while (0)
#define PG8_WAIT_V(n) asm volatile("s_waitcnt vmcnt(" #n ")" ::: "memory")
#define PG8_WAIT_L(n) asm volatile("s_waitcnt lgkmcnt(" #n ")" ::: "memory")
#define PG8_BAR __builtin_amdgcn_s_barrier()
#define PG8_SCHED __builtin_amdgcn_sched_barrier(0)
    Unit cur, nxt; int ui = 0;
    if (!S.next(0, cur)) return;
    f32x4 acc[2][2][4][2];
#pragma unroll
    for (int a = 0; a < 2; ++a)
#pragma unroll
        for (int b = 0; b < 2; ++b)
#pragma unroll
            for (int m = 0; m < 4; ++m)
#pragma unroll
                for (int n = 0; n < 2; ++n) acc[a][b][m][n] = (f32x4){0.f, 0.f, 0.f, 0.f};
    bf16x8 At[4][2], B0[2][2], B1[2][2];
    const char* cA = (const char*)g.A + (size_t)cur.pm * tstep; const char* cB = (const char*)g.Bt + (size_t)cur.pn * tstep;
    S.a_ready(cur);
    if constexpr (SP2) {
        PG8_STAGE(PG8_SB(0, 0), cB, voffB); PG8_STAGE(PG8_SB(0, 1), cB + hstep, voffB); PG8_STAGE(PG8_SA(0, 0), cA, voffA); PG8_STAGE(PG8_SA(0, 1), cA + hstep, voffA);
        if (wr == 1) PG8_BAR;
        PG8_WAIT_V(2); PG8_BAR;
        PG8_STAGE(PG8_SB(1, 0), cB + kstep, voffB); PG8_STAGE(PG8_SA(1, 0), cA + kstep, voffA); PG8_STAGE(PG8_SB(1, 1), cB + hstep + kstep, voffB);
        PG8_WAIT_V(6); PG8_BAR;
    } else {
        PG8_STAGE(PG8_SB(0, 0), cB, voffB); PG8_STAGE(PG8_SA(0, 0), cA, voffA); PG8_STAGE(PG8_SB(0, 1), cB + hstep, voffB); PG8_STAGE(PG8_SA(0, 1), cA + hstep, voffA);
        if (wr == 1) PG8_BAR;
        PG8_WAIT_V(4); PG8_BAR;
        PG8_STAGE(PG8_SB(1, 0), cB + kstep, voffB); PG8_STAGE(PG8_SA(1, 0), cA + kstep, voffA); PG8_STAGE(PG8_SB(1, 1), cB + hstep + kstep, voffB);
        PG8_WAIT_V(6); PG8_BAR;
    }
    for (;;) {
        const bool has_next = S.next(ui + 1, nxt);
        const char* nA = has_next ? (const char*)g.A + (size_t)nxt.pm * tstep : cA; const char* nB = has_next ? (const char*)g.Bt + (size_t)nxt.pn * tstep : cB;
        for (int t = 0; t < nt; t += 2) {
            const bool last = (t == nt - 2);
            const char* a1 = cA + (size_t)(t + 1) * kstep;
            const char* a2 = last ? nA : cA + (size_t)(t + 2) * kstep; const char* b2 = last ? nB : cB + (size_t)(t + 2) * kstep;
            const char* a3 = a2 + kstep; const char* b3 = b2 + kstep;
            if (last && has_next) S.a_ready(nxt);
            if constexpr (SP2) {
            PG8_LDB(B0, 0, 0); PG8_LDB(B1, 0, 1); PG8_SCHED; PG8_LDA(At, 0, 0); PG8_STAGE(PG8_SA(1, 1), a1 + hstep, voffA);
            PG8_WAIT_V(8); PG8_WAIT_L(0); PG8_BAR; PG8_MMA(0, 0, At, B0); PG8_MMA(0, 1, At, B1); PG8_BAR; PG8_SCHED;
            PG8_LDA(At, 0, 1); PG8_STAGE(PG8_SB(0, 0), b2, voffB); PG8_STAGE(PG8_SB(0, 1), b2 + hstep, voffB); PG8_STAGE(PG8_SA(0, 0), a2, voffA);
            PG8_WAIT_V(8); PG8_WAIT_L(0); PG8_BAR; PG8_MMA(1, 0, At, B0); PG8_MMA(1, 1, At, B1); PG8_BAR; PG8_SCHED;
            PG8_LDB(B0, 1, 0); PG8_LDB(B1, 1, 1); PG8_SCHED; PG8_LDA(At, 1, 0); PG8_STAGE(PG8_SA(0, 1), a2 + hstep, voffA);
            PG8_WAIT_V(8); PG8_WAIT_L(0); PG8_BAR; PG8_MMA(0, 0, At, B0); PG8_MMA(0, 1, At, B1); PG8_BAR; PG8_SCHED;
            PG8_LDA(At, 1, 1); PG8_STAGE(PG8_SB(1, 0), b3, voffB); PG8_STAGE(PG8_SB(1, 1), b3 + hstep, voffB); PG8_STAGE(PG8_SA(1, 0), a3, voffA);
            PG8_WAIT_V(8); PG8_WAIT_L(0); PG8_BAR; PG8_MMA(1, 0, At, B0); PG8_MMA(1, 1, At, B1); PG8_BAR; PG8_SCHED;
            } else {
            PG8_LDB(B0, 0, 0); PG8_SCHED; PG8_LDA(At, 0, 0); PG8_STAGE(PG8_SA(1, 1), a1 + hstep, voffA);
            PG8_WAIT_L(8); PG8_BAR; PG8_WAIT_L(0); PG8_MMA(0, 0, At, B0); PG8_BAR; PG8_SCHED;
            PG8_LDB(B1, 0, 1); PG8_STAGE(PG8_SB(0, 0), b2, voffB);
            PG8_BAR; PG8_WAIT_L(0); PG8_MMA(0, 1, At, B1); PG8_BAR;
            PG8_LDA(At, 0, 1); PG8_STAGE(PG8_SA(0, 0), a2, voffA);
            PG8_BAR; PG8_WAIT_L(0); PG8_MMA(1, 0, At, B0); PG8_BAR; PG8_SCHED;
            PG8_STAGE(PG8_SB(0, 1), b2 + hstep, voffB);
            PG8_WAIT_V(6); PG8_BAR; PG8_MMA(1, 1, At, B1); PG8_BAR;
            PG8_LDB(B0, 1, 0); PG8_SCHED; PG8_LDA(At, 1, 0); PG8_STAGE(PG8_SA(0, 1), a2 + hstep, voffA);
            PG8_WAIT_L(8); PG8_BAR; PG8_WAIT_L(0); PG8_MMA(0, 0, At, B0); PG8_BAR; PG8_SCHED;
            PG8_LDB(B1, 1, 1); PG8_STAGE(PG8_SB(1, 0), b3, voffB);
            PG8_BAR; PG8_WAIT_L(0); PG8_MMA(0, 1, At, B1); PG8_BAR;
            PG8_LDA(At, 1, 1); PG8_STAGE(PG8_SA(1, 0), a3, voffA);
            PG8_BAR; PG8_WAIT_L(0); PG8_MMA(1, 0, At, B0); PG8_BAR; PG8_SCHED;
            PG8_STAGE(PG8_SB(1, 1), b3 + hstep, voffB);
            PG8_WAIT_V(6); PG8_BAR; PG8_MMA(1, 1, At, B1); PG8_BAR;
            }
        }
        if constexpr (ALIGN_EPI) { if (wr == 0) PG8_BAR; }
        if constexpr (!Epi::AFTER_DRAIN) { E(acc, cur, wr, wc, fr, fq); S.done(cur); }
        if (!has_next) break;
#pragma unroll
        for (int a = 0; a < 2; ++a)
#pragma unroll
            for (int b = 0; b < 2; ++b)
#pragma unroll
                for (int m = 0; m < 4; ++m)
#pragma unroll
                    for (int n = 0; n < 2; ++n) acc[a][b][m][n] = (f32x4){0.f, 0.f, 0.f, 0.f};
        cur = nxt; cA = nA; cB = nB; ++ui;
        if constexpr (ALIGN_EPI) { if (wr == 1) PG8_BAR; }
    }
    PG8_WAIT_V(0);
    if constexpr (!ALIGN_EPI) { if (wr == 0) PG8_BAR; }
    PG8_BAR;
    if constexpr (Epi::AFTER_DRAIN) { E.fused(acc, cur, wr, wc, fr, fq, lds, wid, lane); S.done(cur); }
#undef PG8_SA
#undef PG8_SB
#undef PG8_STAGE
#undef PG8_LDA
#undef PG8_LDB
#undef PG8_MMA
#undef PG8_WAIT_V
#undef PG8_WAIT_L
#undef PG8_BAR
#undef PG8_SCHED
}
}

#define GAS __attribute__((address_space(1)))
#define LAS __attribute__((address_space(3)))
typedef unsigned short bf16;
typedef unsigned v4u __attribute__((ext_vector_type(4)));
typedef float f32x4 __attribute__((ext_vector_type(4)));
typedef short bf16x8 __attribute__((ext_vector_type(8)));
typedef GAS unsigned gu32;
typedef GAS unsigned long long gu64;
#define RLX_AGENT __ATOMIC_RELAXED, __HIP_MEMORY_SCOPE_AGENT
#define LDS_WAIT() asm volatile("s_waitcnt lgkmcnt(0)" ::: "memory")
#define VM_WAIT() asm volatile("s_waitcnt vmcnt(0)" ::: "memory")
__device__ __forceinline__ unsigned long long rt() { return __builtin_amdgcn_s_memrealtime(); }
typedef float f32x2_t __attribute__((ext_vector_type(2))); typedef __bf16 bf16x2_t __attribute__((ext_vector_type(2)));
__device__ __forceinline__ unsigned pk2(float lo, float hi) { const f32x2_t v = {lo, hi}; return __builtin_bit_cast(unsigned, __builtin_convertvector(v, bf16x2_t)); }
__device__ __forceinline__ unsigned f2bf(float f) { return pk2(f, f) & 0xffffu; }
#define XB_TMO      128
#define XB_XCNT(j)  (256  + 64 * (j))
#define XB_XSUB(j)  (1280 + 64 * (j))
#define XB_XGEN(j)  (2304 + 64 * (j))
#define XB_TOP      3328
#define XB_TOPGEN   3392
#define XCD_BAR_WORDS 3456
#define XB_SPIN_CAP (1u << 18)

__device__ __forceinline__ unsigned xb_ld(unsigned* p)              { return __hip_atomic_load(p, __ATOMIC_RELAXED, __HIP_MEMORY_SCOPE_AGENT); }
__device__ __forceinline__ unsigned xb_add(unsigned* p, unsigned v) { return __hip_atomic_fetch_add(p, v, __ATOMIC_RELAXED, __HIP_MEMORY_SCOPE_AGENT); }
__device__ __forceinline__ unsigned xb_xcc_id() { return (unsigned)__builtin_amdgcn_s_getreg((3 << 11) | 20) & 0xFu; }
#define XB_SPIN(cond, bar) do { unsigned _sp = 0; while (cond) { __builtin_amdgcn_s_sleep(1); \
    if ((++_sp & 255u) == 0u) { if (xb_ld(&(bar)[XB_TMO])) break; if (_sp > XB_SPIN_CAP) { atomicAdd(&(bar)[XB_TMO], 1u); break; } } } } while (0)

struct XcdBarrier {
    unsigned* bar; unsigned x;
    volatile LAS unsigned* st;
};

__device__ __forceinline__ XcdBarrier xcd_barrier_post(unsigned* bar, volatile LAS unsigned* st) {
    XcdBarrier b; b.bar = bar; b.x = xb_xcc_id(); b.st = st;
    if (threadIdx.x == 0) (void)xb_add(&bar[XB_XCNT(b.x)], 1u);
    return b;
}
__device__ __forceinline__ void xcd_barrier_complete(unsigned* bar, unsigned x, unsigned& nloc, unsigned& nx) {
    const unsigned G = gridDim.x * gridDim.y * gridDim.z;
    unsigned sum, cnt, mine, sp = 0u;
    for (;;) {
        sum = 0u; cnt = 0u; mine = 0u;
#pragma unroll 1
        for (unsigned j = 0; j < 16; ++j) { const unsigned c = xb_ld(&bar[XB_XCNT(j)]); sum += c; cnt += (c > 0u) ? 1u : 0u; mine = (j == x) ? c : mine; }
        if (sum == G) break;
        __builtin_amdgcn_s_sleep(1);
        if ((++sp & 255u) == 0u) { if (xb_ld(&bar[XB_TMO])) break; if (sp > XB_SPIN_CAP) { atomicAdd(&bar[XB_TMO], 1u); break; } }
    }
    nloc = mine > 0u ? mine : 1u; nx = cnt > 0u ? cnt : 1u;
}

__device__ __forceinline__ void xcd_barrier(const XcdBarrier& b) {
    asm volatile("s_waitcnt vmcnt(0)" ::: "memory");
    __syncthreads();
    if (threadIdx.x == 0) {
        unsigned* bar = b.bar;
        __builtin_amdgcn_s_waitcnt(0);
        unsigned nloc = b.st[0], nx = b.st[1];
        if (nloc == 0u) { xcd_barrier_complete(bar, b.x, nloc, nx); b.st[0] = nloc; b.st[1] = nx; }
        const unsigned old = xb_add(&bar[XB_XSUB(b.x)], 1u);
        const unsigned gen = old / nloc;
        if (old + 1u == (gen + 1u) * nloc) {
            __builtin_amdgcn_fence(__ATOMIC_RELEASE, "agent");
            asm volatile("s_waitcnt vmcnt(0)" ::: "memory");
            const unsigned og = xb_add(&bar[XB_TOP], 1u);
            const unsigned tg = og / nx;
            if (og + 1u == (tg + 1u) * nx) xb_add(&bar[XB_TOPGEN], 1u);
            else XB_SPIN(xb_ld(&bar[XB_TOPGEN]) == tg, bar);
            __builtin_amdgcn_fence(__ATOMIC_ACQUIRE, "agent");
            xb_add(&bar[XB_XGEN(b.x)], 1u);
            asm volatile("s_waitcnt vmcnt(0)" ::: "memory");
        } else {
            XB_SPIN(xb_ld(&bar[XB_XGEN(b.x)]) == gen, bar);
            __builtin_amdgcn_fence(__ATOMIC_ACQUIRE, "agent");
            asm volatile("s_waitcnt vmcnt(0)" ::: "memory");
        }
    }
    __syncthreads();
}
constexpr int BATCH = 8, SEQ = 2048, D = 1024, M = BATCH * SEQ, FF = 2816;
constexpr int RW_COLS = 1792, EV_IN = 3328, OD_IN = 4096;
constexpr int NWAVES = 8, NTHREADS = NWAVES * 64;
constexpr int N_IN = 26;
constexpr size_t MiB = 1u << 20;
constexpr size_t WS_CTL = 0, CTL_ZERO_BYTES = 3 * MiB;
constexpr size_t OS_HSS = 32 * MiB;
constexpr size_t OS_WC = 56 * MiB;
constexpr size_t OS_IKH = 0, OS_IRH = 40 * MiB, WS_IAH = 36 * MiB, WS_IKT_LO = 3 * MiB, WS_IKT_HI = 48 * MiB;
constexpr size_t OS_RN = 36 * MiB;
constexpr size_t OS_RST = 33 * MiB, OS_ZERO_BEGIN = 32 * MiB, OS_ZERO_BYTES = 3 * MiB;
constexpr size_t WS_SSQ = 2 * MiB;
#define SSQ_SLOT(k) WSP(pg8::ssq_t, WS_SSQ + (size_t)(k) * M * 8)
constexpr size_t WS_W = 3 * MiB;
constexpr size_t W_UP_BYTES = (size_t)2 * FF * D * 2, W_DN_BYTES = (size_t)D * FF * 2;
constexpr size_t WS_WUP = WS_W, WS_WDN = WS_WUP + 4 * W_UP_BYTES, WS_WEVIN = WS_WDN + 4 * W_DN_BYTES, WS_WEVOUT = WS_WEVIN + (size_t)EV_IN * D * 2,
                 WS_WODIN = WS_WEVOUT + (size_t)D * D * 2, WS_WODOUT = WS_WODIN + (size_t)OD_IN * D * 2, WS_WEND = WS_WODOUT + (size_t)D * D * 2;
constexpr size_t WS_KMEAN = 128 * 1024;
constexpr size_t WS_LW2 = 88 * MiB - 512 * 1024, WS_LA2 = WS_LW2 + 64 * 1024, WS_LG2 = WS_LA2 + 64 * 1024;
constexpr size_t WS_XB = 88 * MiB;
constexpr size_t WS_H = 120 * MiB;
constexpr size_t WS_PR = 120 * MiB, WS_QB = 176 * MiB, WS_KB = 192 * MiB, WS_VB = 208 * MiB, WS_Y = 224 * MiB;
constexpr size_t OS_RE = 0, OS_RA = 16 * MiB, WS_YRAW = WS_QB;
constexpr size_t WS_GM = WS_KB;
constexpr size_t WS_HQ = 120 * MiB, WS_HF = 152 * MiB, WS_HI = 184 * MiB, WS_HG = 216 * MiB;
constexpr size_t OS_KT2 = 0;
constexpr size_t WS_RB = 248 * MiB;
constexpr size_t WS_DRY = 250 * MiB;
constexpr size_t WS_END = 256 * MiB;
static_assert(WS_WEND <= WS_LW2 && WS_LG2 + 128 * 1024 <= WS_XB && WS_H + (size_t)M * FF * 2 <= WS_Y + 0 * MiB + 32 * MiB && WS_PR + (size_t)M * RW_COLS * 2 <= WS_QB && WS_Y + (size_t)M * D * 2 <= WS_END && WS_HG + (size_t)M * D * 2 <= WS_END, "d_ws map");
constexpr int CW_BAR = 4096;
constexpr int RING_BYTES = 131072, LDSCTL_OFF = RING_BYTES, MISC_OFF = LDSCTL_OFF + 320, LDS_BYTES = 147456;

__device__ __forceinline__ float bf2f(bf16 v) { return __builtin_bit_cast(float, (unsigned)v << 16); }
__device__ __forceinline__ float sigm(float x) { return 1.0f / (1.0f + __expf(-x)); }
__device__ __forceinline__ float sigmf(float x) { return __builtin_amdgcn_rcpf(1.0f + __builtin_amdgcn_exp2f(-1.4426950408889634f * x)); }
__device__ __forceinline__ float wave_sum(float v) {
#pragma unroll
    for (int o = 1; o < 64; o <<= 1) v += __shfl_xor(v, o);
    return v;
}
__device__ __forceinline__ float wave_max(float v) {
#pragma unroll
    for (int o = 1; o < 64; o <<= 1) v = fmaxf(v, __shfl_xor(v, o));
    return v;
}

typedef float f32x4v __attribute__((ext_vector_type(4)));
typedef float f32x16 __attribute__((ext_vector_type(16)));
typedef unsigned v2u __attribute__((ext_vector_type(2)));
typedef float v2f __attribute__((ext_vector_type(2)));
#define LDS_BARRIER() do { asm volatile("s_waitcnt lgkmcnt(0)" ::: "memory"); __builtin_amdgcn_s_barrier(); asm volatile("" ::: "memory"); } while (0)
__device__ __forceinline__ long long fx20(float v) { return (long long)llrintf(v * 1073741824.0f); }
__device__ __forceinline__ float unfx20(long long v) { return (float)v * (1.0f / 1073741824.0f); }
struct Frame {
    LAS unsigned char* lds; volatile LAS unsigned* MISC; gu32* ctl;
    int tid, lane, wave, vcu, G;
    GAS float* out; GAS unsigned char* ws;
};
#define WSP(T, off) ((GAS T*)(F.ws + (off)))
#define OSP(T, off) ((GAS T*)((GAS unsigned char*)F.out + (off)))
constexpr int PTAB_OFF = LDSCTL_OFF + 1024;
__device__ __forceinline__ const GAS float* inp(const Frame& F, int i) {
    const unsigned long long v = ((const LAS unsigned long long*)(F.lds + PTAB_OFF))[i];
    const unsigned lo = __builtin_amdgcn_readfirstlane((unsigned)v), hi = __builtin_amdgcn_readfirstlane((unsigned)(v >> 32));
    return (const GAS float*)(((unsigned long long)hi << 32) | lo);
}
__device__ __forceinline__ bool in_range(int k, int lo, int hi) { asm volatile("" : "+s"(lo), "+s"(hi)); return lo <= k && k < hi; }
#define PHASE_FRAME(FP) Frame FP = F0; asm volatile("" : "+v"(FP.tid), "+v"(FP.lane)); asm volatile("" : "+s"(FP.wave), "+s"(FP.vcu), "+s"(FP.G), "+s"(FP.ws), "+s"(FP.out))
struct Args { const float* in[N_IN]; float* out; unsigned char* ws; int ph_lo, ph_hi, li, pad; };

__device__ __forceinline__ void transpose_item(const GAS float* W, int K, int N, const GAS float* gain, GAS bf16* WT, int mode, LAS float* scr, int item, int lane) {
    const int nblk = N / 32, kb = item / nblk, nb = item % nblk, k0 = 64 * kb, n0 = 32 * nb;
    float wv[32];
#pragma unroll
    for (int i = 0; i < 32; ++i) wv[i] = W[(size_t)(k0 + 2 * i + (lane >> 5)) * N + n0 + (lane & 31)];
    if (gain) { const float g0 = gain[k0 + lane];
#pragma unroll
        for (int i = 0; i < 32; ++i) wv[i] *= __shfl(g0, 2 * i + (lane >> 5)); }
#pragma unroll
    for (int i = 0; i < 32; ++i) scr[(2 * i + (lane >> 5)) * 33 + (lane & 31)] = wv[i];
    LDS_WAIT(); asm volatile("" ::: "memory");
    const int c = lane & 7; const int rbase = (mode == 0) ? n0 : (n0 + 128 * (n0 >> 7) + (mode == 2 ? 128 : 0));
#pragma unroll
    for (int j = 0; j < 4; ++j) { const int n = (lane >> 3) + 8 * j; const LAS float* s = scr + (8 * c) * 33 + n;
        v4u o; o.x = pk2(s[0 * 33], s[1 * 33]); o.y = pk2(s[2 * 33], s[3 * 33]); o.z = pk2(s[4 * 33], s[5 * 33]); o.w = pk2(s[6 * 33], s[7 * 33]);
        *(GAS v4u*)(WT + (size_t)(rbase + n) * K + k0 + 8 * c) = o; }
    LDS_WAIT(); asm volatile("" ::: "memory");
}
constexpr int I_FF = (D / 64) * (FF / 32), I_EVIN = (D / 64) * (EV_IN / 32), I_OUT = (D / 64) * (D / 32), I_ODIN = (D / 64) * (OD_IN / 32);
constexpr int CV_G1 = 2 * I_FF, CV_G2 = CV_G1 + I_FF + I_EVIN + I_OUT, CV_G3 = CV_G2 + 4 * I_FF, CV_G4 = CV_G3 + 2 * I_FF + I_OUT + I_ODIN / 2, CV_G5 = CV_G4 + I_ODIN / 2 + 2 * I_FF, CV_END = CV_G5 + I_FF;
static_assert(CV_END == 12 * I_FF + I_EVIN + 2 * I_OUT + I_ODIN, "conversion item count");
__device__ __forceinline__ void convert_ffn(Frame& F, int f, int which  , int item, LAS float* scr) {
    const int l = f >> 1, second = f & 1; const GAS float* gain = inp(F, 1) + (size_t)(l * 3 + (second ? 2 : 0)) * D;
    if (which == 0) transpose_item((second ? inp(F, 5) : inp(F, 2)) + (size_t)l * D * FF, D, FF, gain, WSP(bf16, WS_WUP + f * W_UP_BYTES), 1, scr, item, F.lane);
    else if (which == 1) transpose_item((second ? inp(F, 6) : inp(F, 3)) + (size_t)l * D * FF, D, FF, gain, WSP(bf16, WS_WUP + f * W_UP_BYTES), 2, scr, item, F.lane);
    else transpose_item((second ? inp(F, 7) : inp(F, 4)) + (size_t)l * FF * D, FF, D, nullptr, WSP(bf16, WS_WDN + f * W_DN_BYTES), 0, scr, item, F.lane);
}
__device__ __forceinline__ void convert_items(Frame& F, int first, int last, int rank, int nranks) {
    LAS float* scr = (LAS float*)(F.lds + F.wave * 16384);
    for (int it = first + rank; it < last; it += nranks) {
        int r = it;
        if (r < CV_G1) { convert_ffn(F, 0, r / I_FF, r % I_FF, scr); continue; } r -= CV_G1;
        if (r < I_FF) { convert_ffn(F, 0, 2, r, scr); continue; } r -= I_FF;
        if (r < I_EVIN) { transpose_item(inp(F, 8), D, EV_IN, inp(F, 1) + 1 * D, WSP(bf16, WS_WEVIN), 0, scr, r, F.lane); continue; } r -= I_EVIN;
        if (r < I_OUT) { transpose_item(inp(F, 9), D, D, nullptr, WSP(bf16, WS_WEVOUT), 0, scr, r, F.lane); continue; } r -= I_OUT;
        if (r < 3 * I_FF) { convert_ffn(F, 1, r / I_FF, r % I_FF, scr); continue; } r -= 3 * I_FF;
        if (r < 2 * I_FF) { convert_ffn(F, 2, r / I_FF, r % I_FF, scr); continue; } r -= 2 * I_FF;
        if (r < I_FF) { convert_ffn(F, 2, 2, r, scr); continue; } r -= I_FF;
        if (r < I_OUT) { transpose_item(inp(F, 22), D, D, nullptr, WSP(bf16, WS_WODOUT), 0, scr, r, F.lane); continue; } r -= I_OUT;
        if (r < I_ODIN) { transpose_item(inp(F, 21), D, OD_IN, inp(F, 1) + 4 * D, WSP(bf16, WS_WODIN), 0, scr, r, F.lane); continue; } r -= I_ODIN;
        convert_ffn(F, 3, r / I_FF, r % I_FF, scr);
    }
}
__device__ __forceinline__ void prologue_phase(Frame& F) {
    const int gw = F.vcu * NWAVES + F.wave, NGW = F.G * NWAVES;
    convert_items(F, 0, CV_G1, gw, NGW);
    {
        const GAS float* w2 = inp(F, 12); const GAS float* a2 = inp(F, 14); const GAS float* g2 = inp(F, 15); GAS bf16* lw = WSP(bf16, WS_LW2); GAS bf16* la = WSP(bf16, WS_LA2); GAS bf16* lg = WSP(bf16, WS_LG2);
        for (int i = gw * 64 + F.lane; i < 512 * 64; i += NGW * 64) { const int n = i >> 6, k = i & 63; lw[i] = (bf16)f2bf(w2[k * 512 + n]); la[i] = (bf16)f2bf(a2[k * 512 + n]); }
        for (int i = gw * 64 + F.lane; i < 512 * 128; i += NGW * 64) { const int n = i >> 7, k = i & 127; lg[i] = (bf16)f2bf(g2[k * 512 + n]); } }
    const GAS float* x = inp(F, 0); GAS bf16* XB = WSP(bf16, WS_XB); GAS pg8::ssq_t* ssq = SSQ_SLOT(0);
    for (int m = gw; m < M; m += NGW) {
        const GAS f32x4* xr = (const GAS f32x4*)(x + (size_t)m * D) + F.lane; f32x4 v[4]; float s = 0.f;
#pragma unroll
        for (int j = 0; j < 4; ++j) { v[j] = xr[64 * j]; s += (v[j].x * v[j].x + v[j].y * v[j].y) + (v[j].z * v[j].z + v[j].w * v[j].w); }
        s = wave_sum(s);
        GAS unsigned long long* o8 = (GAS unsigned long long*)(XB + (size_t)m * D) + F.lane;
#pragma unroll
        for (int j = 0; j < 4; ++j) o8[64 * j] = (unsigned long long)pk2(v[j].x, v[j].y) | ((unsigned long long)pk2(v[j].z, v[j].w) << 32);
        if (F.lane == 0) ssq[m] = pg8::ssq_fix(s);
    }
}

__device__ __forceinline__ float dpp_add16(float v) {
    v += __builtin_bit_cast(float, __builtin_amdgcn_mov_dpp(__builtin_bit_cast(int, v), 0xB1, 0xF, 0xF, true));
    v += __builtin_bit_cast(float, __builtin_amdgcn_mov_dpp(__builtin_bit_cast(int, v), 0x4E, 0xF, 0xF, true));
    v += __builtin_bit_cast(float, __builtin_amdgcn_mov_dpp(__builtin_bit_cast(int, v), 0x141, 0xF, 0xF, true));
    v += __builtin_bit_cast(float, __builtin_amdgcn_mov_dpp(__builtin_bit_cast(int, v), 0x140, 0xF, 0xF, true));
    return v;
}
__device__ __forceinline__ float bflo(unsigned w) { return __builtin_bit_cast(float, w << 16); }
__device__ __forceinline__ float bfhi(unsigned w) { return __builtin_bit_cast(float, w & 0xffff0000u); }
__device__ __forceinline__ float bfel(const v4u v, int e) { const unsigned w = (e >> 1) == 0 ? v.x : (e >> 1) == 1 ? v.y : (e >> 1) == 2 ? v.z : v.w; return (e & 1) ? bfhi(w) : bflo(w); }
__device__ __forceinline__ void unpack8(const v4u v, float (&o)[8]) { o[0] = bflo(v.x); o[1] = bfhi(v.x); o[2] = bflo(v.y); o[3] = bfhi(v.y); o[4] = bflo(v.z); o[5] = bfhi(v.z); o[6] = bflo(v.w); o[7] = bfhi(v.w); }
constexpr int LO_PITCH = 528;
__device__ __forceinline__ void rwkv_lora_unit(Frame& F, int u) {
    const int tid = F.tid, lane = F.lane, w = F.wave, r16 = lane & 15, g4 = lane >> 4; LAS unsigned char* L = F.lds;
    const GAS bf16* PR = WSP(bf16, WS_PR); GAS bf16* RE = OSP(bf16, OS_RE); GAS bf16* RA = OSP(bf16, OS_RA); GAS bf16* Y = WSP(bf16, WS_Y);
    const GAS bf16* LW = WSP(bf16, WS_LW2); const GAS bf16* LA = WSP(bf16, WS_LA2); const GAS bf16* LG = WSP(bf16, WS_LG2);
    const GAS float* mu = inp(F, 10); const GAS float* w0 = inp(F, 11); const GAS float* a0 = inp(F, 13);
    const int m0 = u * 64;
    const int t = tid >> 3; const size_t row = (size_t)m0 + t; const bool hp = ((m0 + t) & (SEQ - 1)) != 0; const size_t rowp = hp ? row - 1 : row;
    __syncthreads();
    {   const int c0 = (tid & 7) * 32; v4u cur[4], prv[4];
#pragma unroll
        for (int q = 0; q < 4; ++q) { cur[q] = *(const GAS v4u*)(PR + row * RW_COLS + 1536 + c0 + 8 * q); prv[q] = *(const GAS v4u*)(PR + rowp * RW_COLS + 1536 + c0 + 8 * q); }
#pragma unroll
        for (int q = 0; q < 4; ++q) { const int c = c0 + 8 * q; float cf[8], pf[8]; unpack8(cur[q], cf); unpack8(hp ? prv[q] : v4u{0u, 0u, 0u, 0u}, pf); float o[8];
#pragma unroll
            for (int e = 0; e < 8; ++e) { float v = cf[e] + (pf[e] - cf[e]) * mu[1536 + c + e]; if (c < 64) v = 1.0f - 2.0f * __builtin_amdgcn_rcpf(1.0f + __builtin_amdgcn_exp2f(2.8853900817779268f * v)); else if (c >= 128) v = sigmf(v); o[e] = v; }
            *(LAS v4u*)(L + t * LO_PITCH + c * 2) = v4u{pk2(o[0], o[1]), pk2(o[2], o[3]), pk2(o[4], o[5]), pk2(o[6], o[7])}; } }
    {
        const int hh = tid & 7; const GAS float* k_k = inp(F, 16); GAS float* RN = OSP(float, OS_RN); float ss = 0.f; v4u cur[8], prv[8];
#pragma unroll
        for (int q = 0; q < 8; ++q) { const int cc = hh * 64 + 8 * q; cur[q] = *(const GAS v4u*)(PR + row * RW_COLS + 512 + cc); prv[q] = *(const GAS v4u*)(PR + rowp * RW_COLS + 512 + cc); }
#pragma unroll
        for (int q = 0; q < 8; ++q) { const int cc = hh * 64 + 8 * q;
#pragma unroll
            for (int e = 0; e < 8; ++e) { const float kc = bfel(cur[q], e), kp = hp ? bfel(prv[q], e) : 0.f; const float kk = (kc + (kp - kc) * mu[512 + cc + e]) * k_k[cc + e]; ss += kk * kk; } }
        RN[row * 8 + hh] = 1.0f / sqrtf(fmaxf(ss, 1e-24f)); }
    asm volatile("" ::: "memory");
    bf16x8 bw[4][2], ba[4][2], bg[4][4]; f32x4v biw[4], bia[4];
#pragma unroll
    for (int ntl = 0; ntl < 4; ++ntl) { const int n = 16 * (4 * w + ntl) + r16, n4 = 16 * (4 * w + ntl) + 4 * g4;
#pragma unroll
        for (int kk = 0; kk < 2; ++kk) { bw[ntl][kk] = *(const GAS bf16x8*)(LW + (size_t)n * 64 + 32 * kk + 8 * g4); ba[ntl][kk] = *(const GAS bf16x8*)(LA + (size_t)n * 64 + 32 * kk + 8 * g4); }
        biw[ntl] = *(const GAS f32x4v*)(w0 + n4); bia[ntl] = *(const GAS f32x4v*)(a0 + n4); }
    __syncthreads();
#define LO_PROD(KK, KOFF, BF, ...) do { _Pragma("unroll") for (int ntl = 0; ntl < 4; ++ntl) { const int n4 = 16 * (4 * w + ntl) + 4 * g4; _Pragma("unroll") for (int mt = 0; mt < 4; ++mt) { f32x4v acc = f32x4v{0.f, 0.f, 0.f, 0.f}; \
        _Pragma("unroll") for (int kk = 0; kk < (KK); ++kk) { const bf16x8 af = *(const LAS bf16x8*)(L + (16 * mt + r16) * LO_PITCH + ((KOFF) + 32 * kk + 8 * g4) * 2); acc = __builtin_amdgcn_mfma_f32_16x16x32_bf16(BF[ntl][kk], af, acc, 0, 0, 0); } \
        const size_t orow = (size_t)m0 + 16 * mt + r16; __VA_ARGS__; } } } while (0)
    LO_PROD(2, 0, bw, { const f32x4v x = acc + biw[ntl]; *(GAS v2u*)(RE + orow * 512 + n4) = v2u{pk2(0.6065306597126334f * sigmf(x[0]), 0.6065306597126334f * sigmf(x[1])), pk2(0.6065306597126334f * sigmf(x[2]), 0.6065306597126334f * sigmf(x[3]))}; });
#pragma unroll
    for (int ntl = 0; ntl < 2; ++ntl) { const int n = 16 * (4 * w + ntl) + r16;
#pragma unroll
        for (int kk = 0; kk < 4; ++kk) bg[ntl][kk] = *(const GAS bf16x8*)(LG + (size_t)n * 128 + 32 * kk + 8 * g4); }
    LO_PROD(2, 64, ba, { const f32x4v x = acc + bia[ntl]; *(GAS v2u*)(RA + orow * 512 + n4) = v2u{pk2(sigmf(x[0]), sigmf(x[1])), pk2(sigmf(x[2]), sigmf(x[3]))}; });
#pragma unroll
    for (int ntl = 2; ntl < 4; ++ntl) { const int n = 16 * (4 * w + ntl) + r16;
#pragma unroll
        for (int kk = 0; kk < 4; ++kk) bg[ntl][kk] = *(const GAS bf16x8*)(LG + (size_t)n * 128 + 32 * kk + 8 * g4); }
    LO_PROD(4, 128, bg, { *(GAS v2u*)(Y + orow * 1024 + n4) = v2u{pk2(acc[0], acc[1]), pk2(acc[2], acc[3])}; });
#undef LO_PROD
}
constexpr int GR_P = 128, GR_BUF = 32 * GR_P, GR_AF = 0, GR_WAVE = 4 * GR_BUF;
static_assert(8 * GR_WAVE <= RING_BYTES && 32 * 33 * 4 + 3 * 2560 <= GR_WAVE, "gram LDS");
__device__ __forceinline__ void rwkv_gram_phase(Frame& F) {
    const int lane = F.lane, r16 = lane & 15, g4 = lane >> 4; LAS unsigned char* Lw = F.lds + F.wave * GR_WAVE; LAS float* Af = (LAS float*)(Lw + GR_AF);
    const GAS bf16* PR = WSP(bf16, WS_PR); const GAS bf16* RE = OSP(bf16, OS_RE); const GAS bf16* RA = OSP(bf16, OS_RA); const GAS float* RN = OSP(float, OS_RN); GAS v4u* GM = WSP(v4u, WS_GM); GAS float* WCg = OSP(float, OS_WC);
    GAS bf16* IKH = OSP(bf16, OS_IKH); GAS bf16* IRH = OSP(bf16, OS_IRH); GAS bf16* IAH = WSP(bf16, WS_IAH);
    const GAS float* mu = inp(F, 10); const GAS float* k_k = inp(F, 16); const GAS float* k_a = inp(F, 17);
    const int gw = F.vcu * NWAVES + F.wave, NGW = F.G * NWAVES;
    for (int u = gw; u < 64 * 64; u += NGW) { const int bh = u >> 6, c = u & 63, b = bh >> 3, h = bh & 7, gc = h * 64 + lane; const size_t row0 = (size_t)b * SEQ + c * 32;
        const float mr = mu[gc], mk = mu[512 + gc], ckk = k_k[gc], cka = k_a[gc];
        bf16x8 fKh[2][2], fAh[2][2], fKt[2][2], fRh[2][2];
        {   float cs = 0.f, rprev = 0.f, kprev = 0.f; if (c > 0) { rprev = bf2f(PR[(row0 - 1) * RW_COLS + gc]); kprev = bf2f(PR[(row0 - 1) * RW_COLS + 512 + gc]); }
            unsigned short lr[8], lk[8], le[8], la[8], nr[8], nk[8], ne[8], na[8];
#pragma unroll
            for (int i = 0; i < 8; ++i) { const size_t row = row0 + i; lr[i] = PR[row * RW_COLS + gc]; lk[i] = PR[row * RW_COLS + 512 + gc]; le[i] = RE[row * 512 + gc]; la[i] = RA[row * 512 + gc]; }
#pragma unroll 1
            for (int tb = 0; tb < 32; tb += 8) {
                if (tb + 8 < 32) {
#pragma unroll
                    for (int i = 0; i < 8; ++i) { const size_t row = row0 + tb + 8 + i; nr[i] = PR[row * RW_COLS + gc]; nk[i] = PR[row * RW_COLS + 512 + gc]; ne[i] = RE[row * 512 + gc]; na[i] = RA[row * 512 + gc]; } }
#pragma unroll
                for (int i = 0; i < 8; ++i) { const int t = tb + i; const size_t row = row0 + t; const float rc = bf2f(lr[i]), kc = bf2f(lk[i]), e = bf2f(le[i]), a = bf2f(la[i]);
                    const float r = rc + (rprev - rc) * mr, kx = kc + (kprev - kc) * mk; rprev = rc; kprev = kc;
                    const float kk = kx * ckk * RN[row * 8 + h];
                    const float wm = __expf(-cs); cs += e; const float wt = __expf(-cs), iw = __builtin_amdgcn_rcpf(wt);
                    if (t == 31) WCg[(size_t)u * 64 + lane] = wt;
                    LAS unsigned char* im = Lw + t * GR_P + lane * 2;
                    *(LAS unsigned short*)(im) = (unsigned short)f2bf(kk * wm); *(LAS unsigned short*)(im + GR_BUF) = (unsigned short)f2bf(kk * a * iw);
                    *(LAS unsigned short*)(im + 2 * GR_BUF) = (unsigned short)f2bf(kx * (1.0f + (a - 1.0f) * cka) * iw); *(LAS unsigned short*)(im + 3 * GR_BUF) = (unsigned short)f2bf(r * wt); }
#pragma unroll
                for (int i = 0; i < 8; ++i) { lr[i] = nr[i]; lk[i] = nk[i]; le[i] = ne[i]; la[i] = na[i]; }
            }
            asm volatile("s_waitcnt lgkmcnt(0)" ::: "memory");
#pragma unroll
            for (int mt = 0; mt < 2; ++mt)
#pragma unroll
                for (int kk2 = 0; kk2 < 2; ++kk2) { const LAS unsigned char* fp = Lw + (16 * mt + r16) * GR_P + (32 * kk2 + 8 * g4) * 2;
                    fKh[mt][kk2] = *(const LAS bf16x8*)(fp); fAh[mt][kk2] = *(const LAS bf16x8*)(fp + GR_BUF); fKt[mt][kk2] = *(const LAS bf16x8*)(fp + 2 * GR_BUF); fRh[mt][kk2] = *(const LAS bf16x8*)(fp + 3 * GR_BUF); }
            asm volatile("s_waitcnt lgkmcnt(0)" ::: "memory");
            {
                GAS bf16* IKT = (b < 5) ? WSP(bf16, WS_IKT_LO) : WSP(bf16, WS_IKT_HI); const int tq = lane >> 3, k8 = (lane & 7) * 8;
#pragma unroll 1
                for (int q = 0; q < 4; ++q) { const int t = q * 8 + tq; const LAS unsigned char* ip = Lw + t * GR_P + k8 * 2; const size_t go = (row0 + t) * 512 + h * 64 + k8;
                    const v4u i0 = *(const LAS v4u*)(ip), i1 = *(const LAS v4u*)(ip + GR_BUF), i2 = *(const LAS v4u*)(ip + 2 * GR_BUF), i3 = *(const LAS v4u*)(ip + 3 * GR_BUF);
                    *(GAS v4u*)(IKH + go) = i0; *(GAS v4u*)(IAH + go) = i1; *(GAS v4u*)(IKT + go) = i2; *(GAS v4u*)(IRH + go) = i3; }
                asm volatile("s_waitcnt lgkmcnt(0)" ::: "memory"); }
        }
        f32x4v gA[2][2], gB[2][2], gRA[2][2], gRK[2][2];
#pragma unroll
        for (int mt = 0; mt < 2; ++mt)
#pragma unroll
            for (int st = 0; st < 2; ++st) { f32x4v z = f32x4v{0.f, 0.f, 0.f, 0.f}; gA[mt][st] = z; gB[mt][st] = z; gRA[mt][st] = z; gRK[mt][st] = z;
#pragma unroll
                for (int kk = 0; kk < 2; ++kk) { gA[mt][st] = __builtin_amdgcn_mfma_f32_16x16x32_bf16(fKh[mt][kk], fAh[st][kk], gA[mt][st], 0, 0, 0); gB[mt][st] = __builtin_amdgcn_mfma_f32_16x16x32_bf16(fKh[mt][kk], fKt[st][kk], gB[mt][st], 0, 0, 0);
                    gRA[mt][st] = __builtin_amdgcn_mfma_f32_16x16x32_bf16(fRh[mt][kk], fAh[st][kk], gRA[mt][st], 0, 0, 0); gRK[mt][st] = __builtin_amdgcn_mfma_f32_16x16x32_bf16(fRh[mt][kk], fKt[st][kk], gRK[mt][st], 0, 0, 0); } }
#pragma unroll
        for (int mt = 0; mt < 2; ++mt)
#pragma unroll
            for (int st = 0; st < 2; ++st)
#pragma unroll
                for (int rg = 0; rg < 4; ++rg) { const int t = 16 * mt + 4 * g4 + rg, s_ = 16 * st + r16; Af[t * 33 + s_] = (s_ < t) ? gA[mt][st][rg] : 0.f; }
        asm volatile("s_waitcnt lgkmcnt(0)" ::: "memory");
        float Tc[32]; const int j = lane & 31;
#pragma unroll
        for (int t = 0; t < 32; ++t) { float acc[4] = {(t == j) ? 1.0f : 0.f, 0.f, 0.f, 0.f};
#pragma unroll
            for (int s_ = 0; s_ < t; ++s_) acc[s_ & 3] -= Af[t * 33 + s_] * Tc[s_];
            Tc[t] = (acc[0] + acc[1]) + (acc[2] + acc[3]); }
        LAS unsigned char* I0 = Lw, * I1 = Lw + 2560, * I2 = Lw + 5120;
        if (lane < 32) {
#pragma unroll
            for (int t = 0; t < 32; ++t) *(LAS unsigned short*)(I0 + t * 80 + j * 2) = (unsigned short)f2bf(Tc[t]); }
#define GR_CW(IMG, G, STRICT) do { _Pragma("unroll") for (int mt = 0; mt < 2; ++mt) _Pragma("unroll") for (int st = 0; st < 2; ++st) _Pragma("unroll") for (int rg = 0; rg < 4; ++rg) { const int t = 16 * mt + 4 * g4 + rg, s_ = 16 * st + r16; \
            *(LAS unsigned short*)(IMG + t * 80 + s_ * 2) = (unsigned short)f2bf(((STRICT) ? (s_ < t) : (s_ <= t)) ? G[mt][st][rg] : 0.f); } } while (0)
        GR_CW(I1, gB, true); GR_CW(I2, gRA, false);
        asm volatile("s_waitcnt lgkmcnt(0)" ::: "memory");
        GAS v4u* gm = GM + (size_t)u * 512 + lane;
#pragma unroll
        for (int mt = 0; mt < 2; ++mt) { const LAS unsigned char* rT = I0 + (16 * mt + r16) * 80, * rB = I1 + (16 * mt + r16) * 80, * rR = I2 + (16 * mt + r16) * 80;
            const v2u t0 = *(const LAS v2u*)(rT + (4 * g4) * 2), t1 = *(const LAS v2u*)(rT + (16 + 4 * g4) * 2); gm[(0 * 2 + mt) * 64] = v4u{t0.x, t0.y, t1.x, t1.y};
            gm[(1 * 2 + mt) * 64] = *(const LAS v4u*)(rB + (8 * g4) * 2);
            const v2u a0 = *(const LAS v2u*)(rR + (4 * g4) * 2), a1 = *(const LAS v2u*)(rR + (16 + 4 * g4) * 2); gm[(2 * 2 + mt) * 64] = v4u{a0.x, a0.y, a1.x, a1.y}; }
        asm volatile("s_waitcnt lgkmcnt(0)" ::: "memory");
        GR_CW(I0, gRK, false);
        asm volatile("s_waitcnt lgkmcnt(0)" ::: "memory");
#pragma unroll
        for (int mt = 0; mt < 2; ++mt) gm[(3 * 2 + mt) * 64] = *(const LAS v4u*)(I0 + (16 * mt + r16) * 80 + (8 * g4) * 2);
        asm volatile("s_waitcnt lgkmcnt(0)" ::: "memory");
#undef GR_CW
    }
}
constexpr int CS_KH = 0, CS_RH = CS_KH + 32 * 144, CS_AT = CS_RH + 32 * 144, CS_KT = CS_AT + 64 * 80, CS_VT = CS_KT + 64 * 80, CS_WC = CS_VT + 16 * 80, CS_YR = CS_WC + 256, CS_BUF = CS_YR + 32 * 16 * 4;
static_assert(2 * CS_BUF <= RING_BYTES && CS_AT % 16 == 0 && CS_VT % 16 == 0 && CS_WC % 16 == 0 && CS_YR % 16 == 0 && CS_BUF % 16 == 0, "chunk scan LDS");
__device__ __forceinline__ bf16x8 pack8(const f32x4v a, const f32x4v b) { const v4u w = v4u{pk2(a[0], a[1]), pk2(a[2], a[3]), pk2(b[0], b[1]), pk2(b[2], b[3])}; return __builtin_bit_cast(bf16x8, w); }
__device__ __forceinline__ bf16x8 cat8(const v2u a, const v2u b) { const v4u w = v4u{a.x, a.y, b.x, b.y}; return __builtin_bit_cast(bf16x8, w); }
template <bool DRY = false, bool NOPROD = false> __device__ __forceinline__ void rwkv_cscan_unit(Frame& F, int u) {
    const int tid = F.tid, lane = F.lane, w = F.wave, r16 = lane & 15, g4 = lane >> 4; LAS unsigned char* L = F.lds;
    const int ch = u >> 2, rg = u & 3, b = ch >> 3, h = ch & 7; const size_t rowbase = (size_t)b * SEQ;
    const GAS bf16* PR = WSP(bf16, WS_PR); const GAS v4u* GM = WSP(v4u, WS_GM); GAS bf16* YRAW = WSP(bf16, WS_YRAW); GAS long long* RST = OSP(long long, OS_RST);
    const GAS float* WCg = OSP(float, OS_WC); const GAS bf16* IKH = OSP(bf16, OS_IKH); const GAS bf16* IRH = OSP(bf16, OS_IRH); const GAS bf16* IAH = WSP(bf16, WS_IAH);
    const GAS bf16* IKT = (b < 5) ? WSP(bf16, WS_IKT_LO) : WSP(bf16, WS_IKT_HI);
#define CS_T16(DST, V, C8, T_) do { _Pragma("unroll") for (int e = 0; e < 8; ++e) *(LAS unsigned short*)((DST) + ((C8) + e) * 80 + (T_) * 2) = (unsigned short)(((V)[e >> 1]) >> (16 * (e & 1))); } while (0)
#define CS_CL(CC) ((CC) < 63 ? (CC) : 63)
#define CS_FLUSH(CC) do { const int t0f_ = (CC) * 32; const LAS float* yr_ = (const LAS float*)(L + ((CC) & 1) * CS_BUF + CS_YR); \
        { const int t_ = lane >> 1, hf_ = lane & 1; const LAS float* p_ = yr_ + t_ * 16 + hf_ * 8; const f32x4v a_ = *(const LAS f32x4v*)p_, b_ = *(const LAS f32x4v*)(p_ + 4); \
            *(GAS v4u*)(YRAW + (rowbase + t0f_ + t_) * 512 + h * 64 + rg * 16 + hf_ * 8) = v4u{pk2(a_[0], a_[1]), pk2(a_[2], a_[3]), pk2(b_[0], b_[1]), pk2(b_[2], b_[3])}; \
            float s1_ = (a_[0] + a_[1]) + (a_[2] + a_[3]) + (b_[0] + b_[1]) + (b_[2] + b_[3]); float s2_ = (a_[0] * a_[0] + a_[1] * a_[1]) + (a_[2] * a_[2] + a_[3] * a_[3]) + (b_[0] * b_[0] + b_[1] * b_[1]) + (b_[2] * b_[2] + b_[3] * b_[3]); \
            s1_ += __shfl_xor(s1_, 1); s2_ += __shfl_xor(s2_, 1); \
            if (hf_ == 0 && !DRY) { GAS long long* st_ = RST + ((rowbase + t0f_ + t_) * 8 + h) * 2; __hip_atomic_fetch_add(st_, fx20(s1_), __ATOMIC_RELAXED, __HIP_MEMORY_SCOPE_AGENT); __hip_atomic_fetch_add(st_ + 1, fx20(s2_), __ATOMIC_RELAXED, __HIP_MEMORY_SCOPE_AGENT); } } \
    } while (0)
    __syncthreads();
    if (w == 0) {
        f32x4v S[4]; S[0] = f32x4v{0.f, 0.f, 0.f, 0.f}; S[1] = S[0]; S[2] = S[0]; S[3] = S[0];
        v4u gTa[2], gBa[2], gRAa[2], gRKa[2];
#define CS_GM(CC, G) do { const GAS v4u* gm_ = GM + ((size_t)ch * 64 + (CC)) * 512 + lane; gT##G[0] = gm_[0]; gT##G[1] = gm_[64]; gB##G[0] = gm_[128]; gB##G[1] = gm_[192]; gRA##G[0] = gm_[256]; gRA##G[1] = gm_[320]; gRK##G[0] = gm_[384]; gRK##G[1] = gm_[448]; } while (0)
        CS_GM(0, a);
        LDS_BARRIER();
#define CS_CONS(c, G) do { \
            const LAS unsigned char* B = L + ((c) & 1) * CS_BUF; \
            const bf16x8 fT0 = __builtin_bit_cast(bf16x8, gT##G[0]), fT1 = __builtin_bit_cast(bf16x8, gT##G[1]), fB0 = __builtin_bit_cast(bf16x8, gB##G[0]), fB1 = __builtin_bit_cast(bf16x8, gB##G[1]); \
            const bf16x8 fRA0 = __builtin_bit_cast(bf16x8, gRA##G[0]), fRA1 = __builtin_bit_cast(bf16x8, gRA##G[1]), fRK0 = __builtin_bit_cast(bf16x8, gRK##G[0]), fRK1 = __builtin_bit_cast(bf16x8, gRK##G[1]); \
            CS_GM(CS_CL((c) + 1), G); \
            const bf16x8 sB0 = pack8(S[0], S[1]), sB1 = pack8(S[2], S[3]); \
            const bf16x8 vB = *(const LAS bf16x8*)(B + CS_VT + r16 * 80 + 16 * g4); \
            f32x4v X[2], Y[2]; \
            _Pragma("unroll") \
            for (int mt = 0; mt < 2; ++mt) { const LAS unsigned char* kr = B + CS_KH + (16 * mt + r16) * 144 + 8 * g4; const LAS unsigned char* rr = B + CS_RH + (16 * mt + r16) * 144 + 8 * g4; \
                const bf16x8 k0 = cat8(*(const LAS v2u*)(kr), *(const LAS v2u*)(kr + 32)), k1 = cat8(*(const LAS v2u*)(kr + 64), *(const LAS v2u*)(kr + 96)); \
                const bf16x8 q0 = cat8(*(const LAS v2u*)(rr), *(const LAS v2u*)(rr + 32)), q1 = cat8(*(const LAS v2u*)(rr + 64), *(const LAS v2u*)(rr + 96)); \
                f32x4v x = f32x4v{0.f, 0.f, 0.f, 0.f}; x = __builtin_amdgcn_mfma_f32_16x16x32_bf16(k0, sB0, x, 0, 0, 0); x = __builtin_amdgcn_mfma_f32_16x16x32_bf16(k1, sB1, x, 0, 0, 0); \
                X[mt] = __builtin_amdgcn_mfma_f32_16x16x32_bf16(mt ? fB1 : fB0, vB, x, 0, 0, 0); \
                f32x4v y = f32x4v{0.f, 0.f, 0.f, 0.f}; y = __builtin_amdgcn_mfma_f32_16x16x32_bf16(q0, sB0, y, 0, 0, 0); y = __builtin_amdgcn_mfma_f32_16x16x32_bf16(q1, sB1, y, 0, 0, 0); \
                Y[mt] = __builtin_amdgcn_mfma_f32_16x16x32_bf16(mt ? fRK1 : fRK0, vB, y, 0, 0, 0); } \
            const bf16x8 xB = pack8(X[0], X[1]); \
            const f32x4v z = f32x4v{0.f, 0.f, 0.f, 0.f}; \
            const f32x4v U0 = -__builtin_amdgcn_mfma_f32_16x16x32_bf16(fT0, xB, z, 0, 0, 0), U1 = -__builtin_amdgcn_mfma_f32_16x16x32_bf16(fT1, xB, z, 0, 0, 0); \
            const bf16x8 uB = pack8(U0, U1); \
            Y[0] = __builtin_amdgcn_mfma_f32_16x16x32_bf16(fRA0, uB, Y[0], 0, 0, 0); Y[1] = __builtin_amdgcn_mfma_f32_16x16x32_bf16(fRA1, uB, Y[1], 0, 0, 0); \
            _Pragma("unroll") \
            for (int kt = 0; kt < 4; ++kt) { const LAS unsigned char* ar = B + CS_AT + (16 * kt + r16) * 80 + 8 * g4; const bf16x8 af = cat8(*(const LAS v2u*)(ar), *(const LAS v2u*)(ar + 32)); \
                const bf16x8 kf = *(const LAS bf16x8*)(B + CS_KT + (16 * kt + r16) * 80 + 16 * g4); const f32x4v wc = *(const LAS f32x4v*)(B + CS_WC + (16 * kt + 4 * g4) * 4); \
                f32x4v acc = __builtin_amdgcn_mfma_f32_16x16x32_bf16(af, uB, S[kt], 0, 0, 0); acc = __builtin_amdgcn_mfma_f32_16x16x32_bf16(kf, vB, acc, 0, 0, 0); S[kt] = acc * wc; } \
            LAS float* yr = (LAS float*)(L + ((c) & 1) * CS_BUF + CS_YR); \
            _Pragma("unroll") \
            for (int mt = 0; mt < 2; ++mt) \
            _Pragma("unroll") \
                for (int rg_ = 0; rg_ < 4; ++rg_) yr[(16 * mt + 4 * g4 + rg_) * 16 + r16] = Y[mt][rg_]; \
        LDS_BARRIER(); \
    } while (0)
#pragma unroll 1
        for (int c2 = 0; c2 < 64; c2 += 2) { CS_CONS(c2, a); CS_CONS(c2 + 1, a); }
#undef CS_CONS
#undef CS_GM
    } else if (w == 1) {
        LDS_BARRIER();
#pragma unroll 1
        for (int c = 0; c < 64; ++c) { if (c >= 1) CS_FLUSH(c - 1); LDS_BARRIER(); }
        CS_FLUSH(63);
    } else if (w == 2) {
        const int t8 = lane >> 3, c8 = (lane & 7) * 8; const GAS bf16* src = IKT + (rowbase + t8) * 512 + h * 64 + c8; v4u qa[4], qb[4];
#define CS_LOAD(CC, Q) do { const GAS bf16* p_ = src + (size_t)CS_CL(CC) * (32 * 512); _Pragma("unroll") for (int it_ = 0; it_ < 4; ++it_) q##Q[it_] = *(const GAS v4u*)(p_ + it_ * (8 * 512)); } while (0)
#define CS_PREP(CC, Q) do { LAS unsigned char* B_ = L + ((CC) & 1) * CS_BUF; _Pragma("unroll") for (int it_ = 0; it_ < 4; ++it_) CS_T16(B_ + CS_KT, q##Q[it_], c8, 8 * it_ + t8); } while (0)
#define CS_PROD(c, Q) do { if (!NOPROD) { CS_PREP((c) + 1, Q); CS_LOAD((c) + 3, Q); } LDS_BARRIER(); } while (0)
        CS_LOAD(0, a); CS_PREP(0, a); CS_LOAD(1, b); CS_LOAD(2, a);
        LDS_BARRIER();
#pragma unroll 1
        for (int c2 = 0; c2 < 64; c2 += 2) { CS_PROD(c2, b); CS_PROD(c2 + 1, a); }
#undef CS_LOAD
#undef CS_PREP
    } else if (w == 3) {
        const int t_ = lane >> 1, hf = (lane & 1) * 8, vcol = h * 64 + rg * 16 + hf; const GAS float* mu = inp(F, 10); float cB[8];
#pragma unroll
        for (int e = 0; e < 8; ++e) cB[e] = mu[1024 + vcol + e];
        const GAS bf16* src = PR + (rowbase + t_) * RW_COLS + 1024 + vcol; v4u qa[2], qb[2];
#define CS_LOAD(CC, Q) do { const GAS bf16* p_ = src + (size_t)CS_CL(CC) * (32 * RW_COLS); q##Q[0] = *(const GAS v4u*)(p_); q##Q[1] = *(const GAS v4u*)(p_ - ((CS_CL(CC) * 32 + t_ > 0) ? RW_COLS : 0)); } while (0)
#define CS_PREP(CC, Q) do { LAS unsigned char* B_ = L + ((CC) & 1) * CS_BUF; const bool first_ = ((CC) * 32 + t_ == 0); \
            _Pragma("unroll") for (int e = 0; e < 8; ++e) { const float vc_ = bfel(q##Q[0], e), vp_ = first_ ? 0.f : bfel(q##Q[1], e); *(LAS unsigned short*)(B_ + CS_VT + (hf + e) * 80 + t_ * 2) = (unsigned short)f2bf(vc_ + (vp_ - vc_) * cB[e]); } } while (0)
        CS_LOAD(0, a); CS_PREP(0, a); CS_LOAD(1, b); CS_LOAD(2, a);
        LDS_BARRIER();
#pragma unroll 1
        for (int c2 = 0; c2 < 64; c2 += 2) { CS_PROD(c2, b); CS_PROD(c2 + 1, a); }
#undef CS_LOAD
#undef CS_PREP
    } else {
        const int ptid = tid & 255, pt = ptid >> 3, c8 = (ptid & 7) * 8; const size_t o0 = (rowbase + pt) * 512 + h * 64 + c8; const GAS float* wsrc = WCg + (size_t)ch * 64 * 64 + (ptid & 63);
        v4u qa[3], qb[3]; float qwa, qwb;
#define CS_LOAD(CC, Q) do { const size_t o_ = o0 + (size_t)CS_CL(CC) * (32 * 512); q##Q[0] = *(const GAS v4u*)(IKH + o_); q##Q[1] = *(const GAS v4u*)(IRH + o_); q##Q[2] = *(const GAS v4u*)(IAH + o_); qw##Q = wsrc[CS_CL(CC) * 64]; } while (0)
#define CS_PREP(CC, Q) do { LAS unsigned char* B_ = L + ((CC) & 1) * CS_BUF; *(LAS v4u*)(B_ + CS_KH + pt * 144 + c8 * 2) = q##Q[0]; *(LAS v4u*)(B_ + CS_RH + pt * 144 + c8 * 2) = q##Q[1]; CS_T16(B_ + CS_AT, q##Q[2], c8, pt); \
            if (ptid < 64) *(LAS float*)(B_ + CS_WC + ptid * 4) = qw##Q; } while (0)
        CS_LOAD(0, a); CS_PREP(0, a); CS_LOAD(1, b); CS_LOAD(2, a);
        LDS_BARRIER();
#pragma unroll 1
        for (int c2 = 0; c2 < 64; c2 += 2) { CS_PROD(c2, b); CS_PROD(c2 + 1, a); }
#undef CS_LOAD
#undef CS_PREP
#undef CS_PROD
    }
#undef CS_FLUSH
#undef CS_T16
#undef CS_CL
}
template <bool DRY = false, bool NOPROD = false> __device__ __forceinline__ void rwkv_cscan_phase(Frame& F) {
    for (int u = F.vcu; u < 256; u += F.G) rwkv_cscan_unit<DRY, NOPROD>(F, u);
}
__device__ __forceinline__ void rwkv_post_phase(Frame& F) {
    const int gw = F.vcu * NWAVES + F.wave, NGW = F.G * NWAVES, lane = F.lane, c = lane * 8, hh = lane >> 3;
    const GAS bf16* PR = WSP(bf16, WS_PR); const GAS bf16* RA = OSP(bf16, OS_RA); const GAS bf16* YRAW = WSP(bf16, WS_YRAW); const GAS long long* RST = OSP(long long, OS_RST); GAS bf16* Y = WSP(bf16, WS_Y);
    const GAS float* mu = inp(F, 10); const GAS float* k_a = inp(F, 17); const GAS float* r_k = inp(F, 18); const GAS float* lnw = inp(F, 19); const GAS float* lnb = inp(F, 20);
    float mur[8], muk[8], muv[8], cka[8], crk[8], clw[8], clb[8];
#pragma unroll
    for (int e = 0; e < 8; ++e) { mur[e] = mu[c + e]; muk[e] = mu[512 + c + e]; muv[e] = mu[1024 + c + e]; cka[e] = k_a[c + e]; crk[e] = r_k[c + e]; clw[e] = lnw[c + e]; clb[e] = lnb[c + e]; }
    for (int m0 = gw; m0 < M; m0 += 2 * NGW) {
        v4u rc_[2], kc_[2], vc_[2], rp_[2], kp_[2], vp_[2], av_[2], gv_[2], yv_[2]; long long s1_[2], s2_[2];
#pragma unroll
        for (int k = 0; k < 2; ++k) { const int mk = m0 + k * NGW, m = mk < M ? mk : M - 1; const size_t row = (size_t)m, rowp = (m & (SEQ - 1)) != 0 ? row - 1 : row;
            rc_[k] = *(const GAS v4u*)(PR + row * RW_COLS + c); kc_[k] = *(const GAS v4u*)(PR + row * RW_COLS + 512 + c); vc_[k] = *(const GAS v4u*)(PR + row * RW_COLS + 1024 + c);
            rp_[k] = *(const GAS v4u*)(PR + rowp * RW_COLS + c); kp_[k] = *(const GAS v4u*)(PR + rowp * RW_COLS + 512 + c); vp_[k] = *(const GAS v4u*)(PR + rowp * RW_COLS + 1024 + c);
            av_[k] = *(const GAS v4u*)(RA + row * 512 + c); gv_[k] = *(const GAS v4u*)(Y + row * 1024 + c); yv_[k] = *(const GAS v4u*)(YRAW + row * 512 + c);
            s1_[k] = RST[(row * 8 + hh) * 2]; s2_[k] = RST[(row * 8 + hh) * 2 + 1]; }
#pragma unroll
        for (int k = 0; k < 2; ++k) { const int m = m0 + k * NGW; if (m < M) { const size_t row = (size_t)m; const bool hp = (m & (SEQ - 1)) != 0; const v4u z = v4u{0u, 0u, 0u, 0u};
            float rc[8], rp[8], kc[8], kp[8], vc[8], vp[8], aa[8], gg[8], yy[8]; unpack8(rc_[k], rc); unpack8(hp ? rp_[k] : z, rp); unpack8(kc_[k], kc); unpack8(hp ? kp_[k] : z, kp); unpack8(vc_[k], vc); unpack8(hp ? vp_[k] : z, vp); unpack8(av_[k], aa); unpack8(gv_[k], gg); unpack8(yv_[k], yy);
            float vs[8]; float bon = 0.f;
#pragma unroll
            for (int e = 0; e < 8; ++e) { const float r = rc[e] + (rp[e] - rc[e]) * mur[e], kx = kc[e] + (kp[e] - kc[e]) * muk[e]; vs[e] = vc[e] + (vp[e] - vc[e]) * muv[e]; bon += r * (kx * (1.0f + (aa[e] - 1.0f) * cka[e])) * crk[e]; }
            bon += __shfl_xor(bon, 1); bon += __shfl_xor(bon, 2); bon += __shfl_xor(bon, 4);
            const float s1 = unfx20(s1_[k]), s2 = unfx20(s2_[k]); const float mean = s1 * (1.0f / 64.0f), var = fmaxf(s2 * (1.0f / 64.0f) - mean * mean, 0.f), rs = 1.0f / sqrtf(var + 64e-5f);
            float o[8];
#pragma unroll
            for (int e = 0; e < 8; ++e) o[e] = ((yy[e] - mean) * rs * clw[e] + clb[e] + bon * vs[e]) * gg[e];
            *(GAS v4u*)(Y + row * 1024 + c) = v4u{pk2(o[0], o[1]), pk2(o[2], o[3]), pk2(o[4], o[5]), pk2(o[6], o[7])}; } }
    }
}
__device__ __forceinline__ void lora_kmean_phase(Frame& F) {
    for (int u = F.vcu; u < 256; u += F.G) rwkv_lora_unit(F, u);
}

__device__ __forceinline__ int crow(int r, int hi) { return (r & 3) + 8 * (r >> 2) + 4 * hi; }
constexpr int MO_ROWB = 144;
constexpr int MO_BUF = 2 * 64 * MO_ROWB;
constexpr int MO_KM = 40960;
static_assert(2 * MO_BUF <= MO_KM && MO_KM + 2048 <= RING_BYTES, "MoBA LDS");
__device__ __forceinline__ void moba_unit(Frame& F, int b, int h, int qb) {
    const int tid = F.tid, lane = F.lane, wid = F.wave, r32 = lane & 31, hi = lane >> 5;
    const GAS bf16* QB = WSP(bf16, WS_QB); const GAS bf16* KB = WSP(bf16, WS_KB); const GAS bf16* VB = WSP(bf16, WS_VB); GAS bf16* Y = WSP(bf16, WS_Y); const GAS float* km = WSP(float, WS_KMEAN);
    const size_t rowbase = (size_t)b * SEQ; const int qpos = qb * 256 + wid * 32 + r32; const float NEG = -INFINITY;
    bf16x8 qr[4]; { const GAS bf16* qp = QB + (rowbase + qpos) * 512 + h * 64 + hi * 8;
#pragma unroll
        for (int d0 = 0; d0 < 4; ++d0) qr[d0] = *(const GAS bf16x8*)(qp + d0 * 16); }
    unsigned sel = 0u;
    if (qb > 0) {
        LAS float* KM = (LAS float*)(F.lds + MO_KM);
        __syncthreads();
        KM[tid] = km[(size_t)(b * 8 + h) * 8 * 64 + tid];
        __syncthreads();
        float gate[7];
#pragma unroll
        for (int n = 0; n < 7; ++n) { float g = 0.f;
            if (n < qb) { const LAS float* kp = KM + n * 64 + hi * 8;
#pragma unroll
                for (int d0 = 0; d0 < 4; ++d0) { const f32x4v k0 = *(const LAS f32x4v*)(kp + d0 * 16), k1 = *(const LAS f32x4v*)(kp + d0 * 16 + 4);
#pragma unroll
                    for (int j = 0; j < 4; ++j) { g += bf2f((bf16)qr[d0][j]) * k0[j]; g += bf2f((bf16)qr[d0][4 + j]) * k1[j]; } }
                g += __shfl_xor(g, 32); }
            gate[n] = (n < qb) ? g : NEG; }
        const int nsel = qb < 3 ? qb : 3;
#pragma unroll
        for (int s = 0; s < 3; ++s) { int best = 0; float bv = NEG; bool have = false;
#pragma unroll
            for (int n = 0; n < 7; ++n) { const bool ok = (n < qb) && !((sel >> n) & 1u) && (!have || gate[n] > bv); if (ok) { best = n; bv = gate[n]; have = true; } }
            if (s < nsel) sel |= 1u << best; }
    }
    const float C2 = 0.125f * 1.4426950408889634f, sl2 = exp2f(-(float)(h + 1)) * 1.4426950408889634f;
    const int NT = 4 * (qb + 1);
    f32x16 abias[2];
#pragma unroll
    for (int kb = 0; kb < 2; ++kb)
#pragma unroll
        for (int r = 0; r < 16; ++r) abias[kb][r] = sl2 * (float)(32 * kb + crow(r, hi));
    const GAS bf16* kg = KB + (rowbase + (tid >> 3)) * 512 + h * 64 + (tid & 7) * 8; const GAS bf16* vg = VB + (rowbase + lane) * 512 + h * 64 + wid * 8;
    const int kdst = (tid >> 3) * MO_ROWB + (tid & 7) * 16, vdst = 64 * MO_ROWB + (wid * 8) * MO_ROWB + lane * 2;
    f32x16 o[2]; o[0] = f32x16{}; o[1] = f32x16{}; float mrun = NEG, lrun = 0.f;
    v4u kreg, vreg;
    { const int kb0 = (4 * qb) * 64; kreg = *(const GAS v4u*)(kg + (size_t)kb0 * 512); vreg = *(const GAS v4u*)(vg + (size_t)kb0 * 512); }
    __syncthreads();
    { LAS unsigned char* B0 = F.lds; *(LAS v4u*)(B0 + kdst) = kreg; const unsigned w[4] = {vreg.x, vreg.y, vreg.z, vreg.w};
#pragma unroll
        for (int e = 0; e < 8; ++e) *(LAS unsigned short*)(B0 + vdst + e * MO_ROWB) = (unsigned short)((e & 1) ? (w[e >> 1] >> 16) : (w[e >> 1] & 0xffffu)); }
    __syncthreads();
    for (int it = 0; it < NT; ++it) {
        const int tk = (it < 4) ? 4 * qb + it : it - 4, kb0 = tk * 64, nb = tk >> 2;
        if (it + 1 < NT) { const int tn = (it + 1 < 4) ? 4 * qb + it + 1 : it - 3; kreg = *(const GAS v4u*)(kg + (size_t)tn * 64 * 512); vreg = *(const GAS v4u*)(vg + (size_t)tn * 64 * 512); }
        LAS unsigned char* Kb = F.lds + (it & 1) * MO_BUF; LAS unsigned char* Vb = Kb + 64 * MO_ROWB;
        const bool row_ok = (nb == qb) || ((sel >> nb) & 1u);
        f32x16 p[2];
#pragma unroll
        for (int kb = 0; kb < 2; ++kb) { p[kb] = f32x16{};
#pragma unroll
            for (int d0 = 0; d0 < 4; ++d0) { const bf16x8 a = *(const LAS bf16x8*)(Kb + (32 * kb + r32) * MO_ROWB + (d0 * 16 + hi * 8) * 2); p[kb] = __builtin_amdgcn_mfma_f32_32x32x16_bf16(a, qr[d0], p[kb], 0, 0, 0); } }
        float rmax = NEG; const float off = row_ok ? sl2 * (float)(kb0 - qpos) : NEG;
        p[0] = p[0] * C2 + (abias[0] + off); p[1] = p[1] * C2 + (abias[1] + off);
        if (nb == qb) {
#pragma unroll
            for (int kb = 0; kb < 2; ++kb)
#pragma unroll
                for (int r = 0; r < 16; ++r) { const int kpos = kb0 + 32 * kb + crow(r, hi); if (kpos > qpos) p[kb][r] = NEG; }
        }
#pragma unroll
        for (int kb = 0; kb < 2; ++kb)
#pragma unroll
            for (int r = 0; r < 16; r += 2) rmax = fmaxf(fmaxf(rmax, p[kb][r]), p[kb][r + 1]);
        rmax = fmaxf(rmax, __shfl_xor(rmax, 32));
        const float mnew = fmaxf(mrun, rmax), alpha = __builtin_amdgcn_exp2f(mrun - mnew); mrun = mnew; lrun *= alpha;
        if (__any(alpha != 1.0f)) {
#pragma unroll
            for (int r = 0; r < 16; ++r) { o[0][r] *= alpha; o[1][r] *= alpha; } }
        {   const v2f nm = v2f{-mnew, -mnew}; v2f ps0 = v2f{0.f, 0.f}, ps1 = ps0;
#pragma unroll
            for (int kb = 0; kb < 2; ++kb)
#pragma unroll
                for (int r = 0; r < 16; r += 2) { v2f x = v2f{p[kb][r], p[kb][r + 1]} + nm; x = v2f{__builtin_amdgcn_exp2f(x.x), __builtin_amdgcn_exp2f(x.y)}; if (kb == 0) ps0 += x; else ps1 += x; p[kb][r] = x.x; p[kb][r + 1] = x.y; }
            ps0 += ps1; lrun += ps0.x + ps0.y; }
#pragma unroll
        for (int kb = 0; kb < 2; ++kb)
#pragma unroll
            for (int s2 = 0; s2 < 2; ++s2) { v4u pw; pw.x = pg8::cvt_pk_bf16(p[kb][8 * s2 + 0], p[kb][8 * s2 + 1]); pw.y = pg8::cvt_pk_bf16(p[kb][8 * s2 + 2], p[kb][8 * s2 + 3]);
                pw.z = pg8::cvt_pk_bf16(p[kb][8 * s2 + 4], p[kb][8 * s2 + 5]); pw.w = pg8::cvt_pk_bf16(p[kb][8 * s2 + 6], p[kb][8 * s2 + 7]);
                const bf16x8 pb = __builtin_bit_cast(bf16x8, pw); const int k0 = 32 * kb + 16 * s2 + 4 * hi;
#pragma unroll
                for (int db = 0; db < 2; ++db) { const LAS unsigned char* vp = Vb + (32 * db + r32) * MO_ROWB + k0 * 2;
                    const v2u lo = *(const LAS v2u*)vp, hi8 = *(const LAS v2u*)(vp + 16); const v4u av = {lo.x, lo.y, hi8.x, hi8.y};
                    o[db] = __builtin_amdgcn_mfma_f32_32x32x16_bf16(__builtin_bit_cast(bf16x8, av), pb, o[db], 0, 0, 0); } }
        if (it + 1 < NT) { LAS unsigned char* B1 = F.lds + ((it + 1) & 1) * MO_BUF; *(LAS v4u*)(B1 + kdst) = kreg; const unsigned w[4] = {vreg.x, vreg.y, vreg.z, vreg.w};
#pragma unroll
            for (int e = 0; e < 8; ++e) *(LAS unsigned short*)(B1 + vdst + e * MO_ROWB) = (unsigned short)((e & 1) ? (w[e >> 1] >> 16) : (w[e >> 1] & 0xffffu)); }
        __syncthreads();
    }
    lrun += __shfl_xor(lrun, 32); const float inv = 1.0f / lrun;
    GAS bf16* yp = Y + (rowbase + qpos) * 1024 + 512 + h * 64 + 4 * hi;
#pragma unroll
    for (int db = 0; db < 2; ++db)
#pragma unroll
        for (int g = 0; g < 4; ++g) *(GAS v2u*)(yp + 32 * db + 8 * g) = v2u{pk2(o[db][4 * g] * inv, o[db][4 * g + 1] * inv), pk2(o[db][4 * g + 2] * inv, o[db][4 * g + 3] * inv)};
}
__device__ __forceinline__ void moba_phase(Frame& F) {
    for (int u = F.vcu; u < 256; u += F.G) { const int bh = u >> 2, pr = u & 3; moba_unit(F, bh >> 3, bh & 7, pr); moba_unit(F, bh >> 3, bh & 7, 7 - pr); }
}

constexpr int HG_PQ = 272, HG_PS = 144;
constexpr int HG_QT = 0, HG_KT = HG_QT + 64 * HG_PQ, HG_KTT = HG_KT + 64 * HG_PQ, HG_IT = HG_KTT + 128 * HG_PS, HG_ST = HG_IT + 32 * HG_PS, HG_AS = HG_ST + 32 * HG_PQ, HG_TOT = HG_AS + 64 * HG_PS, HG_END = HG_TOT + 8 * 128 * 4;
constexpr int HG_OB = 81920, HG_POB = 80;
static_assert(HG_END <= HG_OB && HG_OB + 512 * HG_POB <= RING_BYTES, "HGRN2 LDS");
static_assert(HG_END <= RING_BYTES, "hgrn LDS");
__device__ __forceinline__ void hgrn_prep_phase(Frame& F) {
    const int tid = F.tid; LAS float* TOT = (LAS float*)(F.lds + HG_TOT);
    GAS bf16* HQ = WSP(bf16, WS_HQ); GAS bf16* HF = WSP(bf16, WS_HF); GAS bf16* KT2 = OSP(bf16, OS_KT2); GAS float* RB = WSP(float, WS_RB);
    const GAS float* lbl = inp(F, 24); const int kp = tid & 63, tq = tid >> 6;
    unsigned fr_n[8], qr_n[8];
#define HP_LOAD(U) do { const int u_ = (U); const int gc_ = ((u_ >> 5) & 7) * 128 + 2 * kp; const size_t r0_ = (size_t)(u_ >> 8) * SEQ + (u_ & 31) * 64 + 8 * tq; \
        _Pragma("unroll") for (int i = 0; i < 8; ++i) { fr_n[i] = *(const GAS unsigned*)(HF + (r0_ + i) * 1024 + gc_); qr_n[i] = *(const GAS unsigned*)(HQ + (r0_ + i) * 1024 + gc_); } } while (0)
    if (F.vcu < 2048) HP_LOAD(F.vcu);
    for (int u = F.vcu; u < 2048; u += F.G) {
        const int h = (u >> 5) & 7, gc = h * 128 + 2 * kp; const size_t r0 = (size_t)(u >> 8) * SEQ + (u & 31) * 64 + 8 * tq;
        const float lb0 = __builtin_amdgcn_rcpf(1.0f + __expf(lbl[gc] - lbl[1024 + gc])), lb1 = __builtin_amdgcn_rcpf(1.0f + __expf(lbl[gc + 1] - lbl[1024 + gc + 1]));
        float qv[8][2], kd[8][2], bl[8][2]; float run0 = 0.f, run1 = 0.f;
#pragma unroll
        for (int i = 0; i < 8; ++i) { const float s0 = sigmf(bflo(fr_n[i])), s1 = sigmf(bfhi(fr_n[i]));
            kd[i][0] = (1.0f - lb0) * (1.0f - s0); kd[i][1] = (1.0f - lb1) * (1.0f - s1); qv[i][0] = bflo(qr_n[i]); qv[i][1] = bfhi(qr_n[i]);
            run0 += __logf(lb0 + (1.0f - lb0) * s0); run1 += __logf(lb1 + (1.0f - lb1) * s1); bl[i][0] = run0; bl[i][1] = run1; }
        LDS_BARRIER();
        *(LAS v2f*)(TOT + tq * 128 + 2 * kp) = v2f{run0, run1};
        LDS_BARRIER();
        if (u + F.G < 2048) HP_LOAD(u + F.G);
        float off0 = 0.f, off1 = 0.f, rr0 = 0.f, rr1 = 0.f, bb0 = 0.f, bb1 = 0.f;
#pragma unroll
        for (int q = 0; q < 8; ++q) { const v2f tv = *(const LAS v2f*)(TOT + q * 128 + 2 * kp); if (q < tq) { off0 += tv[0]; off1 += tv[1]; } if (q < 4) { rr0 += tv[0]; rr1 += tv[1]; } bb0 += tv[0]; bb1 += tv[1]; }
        unsigned kw0[4], kw1[4];
#pragma unroll
        for (int i = 0; i < 8; ++i) { const float e0 = __expf(bl[i][0] + off0 - rr0), e1 = __expf(bl[i][1] + off1 - rr1);
            *(GAS unsigned*)(HQ + (r0 + i) * 1024 + gc) = pk2(qv[i][0] * e0, qv[i][1] * e1);
            const unsigned kk = pk2(kd[i][0] * __builtin_amdgcn_rcpf(e0), kd[i][1] * __builtin_amdgcn_rcpf(e1)); *(GAS unsigned*)(HF + (r0 + i) * 1024 + gc) = kk;
            if (i & 1) { kw0[i >> 1] |= kk << 16; kw1[i >> 1] |= kk & 0xffff0000u; } else { kw0[i >> 1] = kk & 0xffffu; kw1[i >> 1] = kk >> 16; } }
        GAS bf16* kt = KT2 + ((size_t)u * 128 + 2 * kp) * 64 + 8 * tq; *(GAS v4u*)kt = v4u{kw0[0], kw0[1], kw0[2], kw0[3]}; *(GAS v4u*)(kt + 64) = v4u{kw1[0], kw1[1], kw1[2], kw1[3]};
        if (tq == 0) { *(GAS v2f*)(RB + (size_t)u * 256 + 2 * kp) = v2f{rr0, rr1}; *(GAS v2f*)(RB + (size_t)u * 256 + 128 + 2 * kp) = v2f{bb0, bb1}; }
    }
#undef HP_LOAD
}
template <bool DRY> __device__ __forceinline__ void hgrn_unit(Frame& F, int b, int h, int vq) {
    const int tid = F.tid, lane = F.lane, w = F.wave, r16 = lane & 15, g4 = lane >> 4;
    LAS unsigned char* L = F.lds;
    const GAS bf16* HQ = WSP(bf16, WS_HQ); const GAS bf16* HF = WSP(bf16, WS_HF); GAS bf16* HI = WSP(bf16, WS_HI); GAS long long* HSS = OSP(long long, OS_HSS); const GAS bf16* KT2 = OSP(bf16, OS_KT2); const GAS float* RB = WSP(float, WS_RB);
    const size_t rowbase = (size_t)b * SEQ; const int ubase = (b * 8 + h) * 32;
    f32x4v S[2]; S[0] = f32x4v{0.f, 0.f, 0.f, 0.f}; S[1] = S[0];
    __syncthreads();
    for (int i = tid; i < 64 * HG_PS / 4; i += NTHREADS) ((LAS unsigned*)(L + HG_AS))[i] = 0u;
    const int tr = w >> 1, vc = w & 1;
    v4u q0A, q1A, k0A, k1A, t0A, t1A, q0B, q1B, k0B, k1B, t0B, t1B, rbA, rbB; v2u iiA, iiB;
#define HS_LOAD(C, q0_, q1_, k0_, k1_, t0_, t1_, ii_, rb_) do { const size_t row_ = rowbase + (size_t)(C) * 64 + (tid >> 3); const GAS bf16* qp_ = HQ + row_ * 1024 + h * 128 + (tid & 7) * 16; const GAS bf16* kp_ = HF + row_ * 1024 + h * 128 + (tid & 7) * 16; \
        q0_ = *(const GAS v4u*)qp_; q1_ = *(const GAS v4u*)(qp_ + 8); k0_ = *(const GAS v4u*)kp_; k1_ = *(const GAS v4u*)(kp_ + 8); \
        const GAS bf16* tp_ = KT2 + ((size_t)(ubase + (C)) * 128 + (tid >> 2)) * 64 + (tid & 3) * 16; t0_ = *(const GAS v4u*)tp_; t1_ = *(const GAS v4u*)(tp_ + 8); \
        ii_ = *(const GAS v2u*)(HI + row_ * 1024 + h * 128 + vq * 32 + (tid & 7) * 4); \
        rb_ = *(const GAS v4u*)(RB + (size_t)(ubase + (C)) * 256 + (tid & 63) * 4); } while (0)
#define HS_CHUNK(CC, q0_, q1_, k0_, k1_, t0_, t1_, ii_, rb_, rbn_) do { \
        LDS_BARRIER(); \
        const f32x4v rv_ = *(const LAS f32x4v*)(L + HG_TOT + ((CC) & 1) * 1024 + (16 * w + 4 * g4) * 4), bv_ = *(const LAS f32x4v*)(L + HG_TOT + ((CC) & 1) * 1024 + 512 + (16 * w + 4 * g4) * 4); \
        {   LAS unsigned char* qd = L + HG_QT + (tid >> 3) * HG_PQ + (tid & 7) * 32; *(LAS v4u*)qd = q0_; *(LAS v4u*)(qd + 16) = q1_; \
            LAS unsigned char* kd_ = L + HG_KT + (tid >> 3) * HG_PQ + (tid & 7) * 32; *(LAS v4u*)kd_ = k0_; *(LAS v4u*)(kd_ + 16) = k1_; \
            LAS unsigned char* td = L + HG_KTT + (tid >> 2) * HG_PS + (tid & 3) * 32; *(LAS v4u*)td = t0_; *(LAS v4u*)(td + 16) = t1_; \
            LAS unsigned char* id = L + HG_IT + ((tid & 7) * 4) * HG_PS + (tid >> 3) * 2; \
            *(LAS unsigned short*)(id) = (unsigned short)(ii_.x & 0xffffu); *(LAS unsigned short*)(id + HG_PS) = (unsigned short)(ii_.x >> 16); *(LAS unsigned short*)(id + 2 * HG_PS) = (unsigned short)(ii_.y & 0xffffu); *(LAS unsigned short*)(id + 3 * HG_PS) = (unsigned short)(ii_.y >> 16); } \
        HS_LOAD(((CC) + 2 < 32 ? (CC) + 2 : 31), q0_, q1_, k0_, k1_, t0_, t1_, ii_, rb_);         \
        float e63[4], e63r[4]; \
        {   float er[4]; \
_Pragma("unroll") \
            for (int rg = 0; rg < 4; ++rg) { er[rg] = __expf(rv_[rg]); e63[rg] = __expf(bv_[rg]); e63r[rg] = __expf(bv_[rg] - rv_[rg]); } \
_Pragma("unroll") \
            for (int cc = 0; cc < 2; ++cc) *(LAS v2u*)(L + HG_ST + (16 * cc + r16) * HG_PQ + (16 * w + 4 * g4) * 2) = v2u{pk2(S[cc][0] * er[0], S[cc][1] * er[1]), pk2(S[cc][2] * er[2], S[cc][3] * er[3])}; } \
        LDS_BARRIER(); \
        f32x4v oacc = f32x4v{0.f, 0.f, 0.f, 0.f}; \
        {   bf16x8 qa[4]; \
_Pragma("unroll") \
            for (int kk = 0; kk < 4; ++kk) qa[kk] = *(const LAS bf16x8*)(L + HG_QT + (16 * tr + r16) * HG_PQ + (32 * kk + 8 * g4) * 2); \
_Pragma("unroll") \
            for (int cc = 0; cc < 2; ++cc) { const int tc = 2 * vc + cc; \
                if (tc <= tr) { f32x4v acc = f32x4v{0.f, 0.f, 0.f, 0.f}; \
_Pragma("unroll") \
                    for (int kk = 0; kk < 4; ++kk) { const bf16x8 kb = *(const LAS bf16x8*)(L + HG_KT + (16 * tc + r16) * HG_PQ + (32 * kk + 8 * g4) * 2); acc = __builtin_amdgcn_mfma_f32_16x16x32_bf16(qa[kk], kb, acc, 0, 0, 0); } \
_Pragma("unroll") \
                    for (int rg = 0; rg < 4; ++rg) { const int t = 16 * tr + 4 * g4 + rg, s_ = 16 * tc + r16; *(LAS unsigned short*)(L + HG_AS + t * HG_PS + s_ * 2) = (unsigned short)f2bf(s_ <= t ? acc[rg] : 0.f); } } } \
_Pragma("unroll") \
            for (int kk = 0; kk < 4; ++kk) { const bf16x8 sb = *(const LAS bf16x8*)(L + HG_ST + (16 * vc + r16) * HG_PQ + (32 * kk + 8 * g4) * 2); oacc = __builtin_amdgcn_mfma_f32_16x16x32_bf16(qa[kk], sb, oacc, 0, 0, 0); } \
        } \
        f32x4v dS[2]; \
_Pragma("unroll") \
        for (int cc = 0; cc < 2; ++cc) { dS[cc] = f32x4v{0.f, 0.f, 0.f, 0.f}; \
_Pragma("unroll") \
            for (int kk = 0; kk < 2; ++kk) { const bf16x8 ka = *(const LAS bf16x8*)(L + HG_KTT + (16 * w + r16) * HG_PS + (32 * kk + 8 * g4) * 2); const bf16x8 ib = *(const LAS bf16x8*)(L + HG_IT + (16 * cc + r16) * HG_PS + (32 * kk + 8 * g4) * 2); \
                dS[cc] = __builtin_amdgcn_mfma_f32_16x16x32_bf16(ka, ib, dS[cc], 0, 0, 0); } } \
_Pragma("unroll") \
        for (int cc = 0; cc < 2; ++cc) \
_Pragma("unroll") \
            for (int rg = 0; rg < 4; ++rg) S[cc][rg] = e63[rg] * S[cc][rg] + e63r[rg] * dS[cc][rg]; \
        LDS_BARRIER(); \
        if (tid < 64) *(LAS v4u*)(L + HG_TOT + (((CC) + 1) & 1) * 1024 + tid * 16) = rbn_;                    \
_Pragma("unroll") \
        for (int kk = 0; kk < 2; ++kk) { const bf16x8 aa = *(const LAS bf16x8*)(L + HG_AS + (16 * tr + r16) * HG_PS + (32 * kk + 8 * g4) * 2); const bf16x8 ib = *(const LAS bf16x8*)(L + HG_IT + (16 * vc + r16) * HG_PS + (32 * kk + 8 * g4) * 2); \
            oacc = __builtin_amdgcn_mfma_f32_16x16x32_bf16(aa, ib, oacc, 0, 0, 0); } \
_Pragma("unroll") \
        for (int rg = 0; rg < 4; ++rg) *(LAS unsigned short*)(L + HG_OB + (((CC) & 7) * 64 + 16 * tr + 4 * g4 + rg) * HG_POB + (16 * vc + r16) * 2) = (unsigned short)f2bf(oacc[rg]); \
    } while (0)
    HS_LOAD(0, q0A, q1A, k0A, k1A, t0A, t1A, iiA, rbA);
    HS_LOAD(1, q0B, q1B, k0B, k1B, t0B, t1B, iiB, rbB);
    if (tid < 64) *(LAS v4u*)(L + HG_TOT + tid * 16) = rbA;
#pragma unroll
    for (int blk = 0; blk < 4; ++blk) {
#pragma unroll 1
        for (int c = 8 * blk; c < 8 * blk + 8; c += 2) {
            HS_CHUNK(c, q0A, q1A, k0A, k1A, t0A, t1A, iiA, rbA, rbB);
            HS_CHUNK(c + 1, q0B, q1B, k0B, k1B, t0B, t1B, iiB, rbB, rbA);
        }
        LDS_BARRIER();
        {
            const size_t row = rowbase + (size_t)blk * 512 + tid; const LAS unsigned char* op = L + HG_OB + tid * HG_POB; float ss = 0.f;
            GAS bf16* dst = (DRY ? WSP(bf16, WS_DRY) : HI) + (DRY ? (row & 2047) : row) * 1024 + h * 128 + vq * 32;
#pragma unroll
            for (int q = 0; q < 4; ++q) { const v4u v = *(const LAS v4u*)(op + 16 * q); *(GAS v4u*)(dst + 8 * q) = v;
#pragma unroll
                for (int e = 0; e < 8; ++e) { const float x = bfel(v, e); ss += x * x; } }
            if (!DRY) __hip_atomic_fetch_add(HSS + row * 8 + h, fx20(ss), __ATOMIC_RELAXED, __HIP_MEMORY_SCOPE_AGENT);
            __builtin_amdgcn_s_waitcnt(0x0F70);
        }
    }
#undef HS_CHUNK
#undef HS_LOAD
}
template <bool DRY> __device__ __forceinline__ void hgrn_phase(Frame& F) {
    for (int u = F.vcu; u < 256; u += F.G) hgrn_unit<DRY>(F, u >> 5, (u >> 2) & 7, u & 3);
}
__device__ __forceinline__ void hgrn_post_phase(Frame& F) {
    const int gw = F.vcu * NWAVES + F.wave, NGW = F.G * NWAVES, c0 = F.lane * 8; GAS bf16* HI = WSP(bf16, WS_HI); const GAS bf16* HG = WSP(bf16, WS_HG); const GAS long long* HSS = OSP(long long, OS_HSS); const GAS float* nw = inp(F, 23);
    float nwv[2][8];
#pragma unroll
    for (int j = 0; j < 2; ++j)
#pragma unroll
        for (int e = 0; e < 8; ++e) nwv[j][e] = nw[c0 + 512 * j + e];
    for (int m0 = gw; m0 < M; m0 += 4 * NGW) { v4u ov[4][2], gv[4][2]; long long hs[4][2];
#pragma unroll
        for (int k = 0; k < 4; ++k) { const int mk = m0 + k * NGW, m = mk < M ? mk : M - 1;
#pragma unroll
            for (int j = 0; j < 2; ++j) { const int c = c0 + 512 * j; hs[k][j] = HSS[(size_t)m * 8 + (c >> 7)]; ov[k][j] = *(const GAS v4u*)(HI + (size_t)m * 1024 + c); gv[k][j] = *(const GAS v4u*)(HG + (size_t)m * 1024 + c); } }
#pragma unroll
        for (int k = 0; k < 4; ++k) { const int m = m0 + k * NGW; if (m < M) {
#pragma unroll
            for (int j = 0; j < 2; ++j) { const int c = c0 + 512 * j; const float rs = 1.0f / sqrtf(unfx20(hs[k][j]) * (1.0f / 128.0f) + 1e-6f);
                const unsigned ow[4] = {ov[k][j].x, ov[k][j].y, ov[k][j].z, ov[k][j].w}, gw4[4] = {gv[k][j].x, gv[k][j].y, gv[k][j].z, gv[k][j].w}; unsigned rw[4];
#pragma unroll
                for (int e = 0; e < 4; ++e) { const float o0 = __builtin_bit_cast(float, ow[e] << 16), o1 = __builtin_bit_cast(float, ow[e] & 0xffff0000u), g0 = __builtin_bit_cast(float, gw4[e] << 16), g1 = __builtin_bit_cast(float, gw4[e] & 0xffff0000u);
                    rw[e] = pk2(o0 * rs * nwv[j][2 * e] * sigmf(g0), o1 * rs * nwv[j][2 * e + 1] * sigmf(g1)); }
                *(GAS v4u*)(HI + (size_t)m * 1024 + c) = v4u{rw[0], rw[1], rw[2], rw[3]}; } } }
    }
}

__device__ __forceinline__ void final_phase(Frame& F) {
    const int gw = F.vcu * NWAVES + F.wave, NGW = F.G * NWAVES, c0 = F.lane * 8; const GAS float* fg = inp(F, 25); const GAS pg8::ssq_t* ssq = SSQ_SLOT(6); const GAS bf16* XB = WSP(bf16, WS_XB);
    f32x4 g[2][2];
#pragma unroll
    for (int j = 0; j < 2; ++j) { g[j][0] = *(const GAS f32x4*)(fg + c0 + 512 * j); g[j][1] = *(const GAS f32x4*)(fg + c0 + 512 * j + 4); }
    for (int m0 = gw; m0 < M; m0 += 4 * NGW) { v4u xr[4][2]; pg8::ssq_t sq[4];
#pragma unroll
        for (int k = 0; k < 4; ++k) { const int mk = m0 + k * NGW, m = mk < M ? mk : M - 1; sq[k] = ssq[m];
#pragma unroll
            for (int j = 0; j < 2; ++j) xr[k][j] = *(const GAS v4u*)(XB + (size_t)m * D + c0 + 512 * j); }
#pragma unroll
        for (int k = 0; k < 4; ++k) { const int m = m0 + k * NGW; if (m < M) { const float rs = pg8::ssq_to_rstd(sq[k]);
#pragma unroll
            for (int j = 0; j < 2; ++j) { float xv[8]; unpack8(xr[k][j], xv); GAS f32x4* o = (GAS f32x4*)(F.out + (size_t)m * D + c0 + 512 * j);
                o[0] = (f32x4){xv[0] * rs * g[j][0][0], xv[1] * rs * g[j][0][1], xv[2] * rs * g[j][0][2], xv[3] * rs * g[j][0][3]}; o[1] = (f32x4){xv[4] * rs * g[j][1][0], xv[5] * rs * g[j][1][1], xv[6] * rs * g[j][1][2], xv[7] * rs * g[j][1][3]}; } } }
    }
}

#ifndef PROBE_DBL
#define PROBE_DBL 0
#endif
#ifndef MK_N_LAUNCHES
#define MK_N_LAUNCHES 1
#endif
constexpr int NPHASE = 17;
__global__ void __launch_bounds__(NTHREADS, 2) hyb_fwd(Args args) {
    extern __shared__ __attribute__((aligned(16))) unsigned char lds[];
    Frame F0;
    F0.lds = (LAS unsigned char*)lds; F0.MISC = (volatile LAS unsigned*)(F0.lds + MISC_OFF);
    F0.tid = threadIdx.x; F0.lane = F0.tid & 63; F0.wave = __builtin_amdgcn_readfirstlane(F0.tid >> 6);
    F0.G = gridDim.x; { const int bx = blockIdx.x; F0.vcu = (F0.G % 8 == 0) ? (bx % 8) * (F0.G / 8) + bx / 8 : bx; }
    F0.out = (GAS float*)args.out; F0.ws = (GAS unsigned char*)args.ws; F0.ctl = (gu32*)(args.ws + WS_CTL);
    for (int u = F0.tid; u < (LDS_BYTES - LDSCTL_OFF) / 4; u += NTHREADS) ((LAS unsigned*)(F0.lds + LDSCTL_OFF))[u] = 0u;
    __syncthreads();
    if (F0.tid == 0) {
#pragma unroll
        for (int i = 0; i < N_IN; ++i) ((LAS unsigned long long*)(F0.lds + PTAB_OFF))[i] = (unsigned long long)args.in[i]; }
    __syncthreads();
    XcdBarrier bar; bar.bar = (unsigned*)(F0.ctl + CW_BAR); bar.x = 0; bar.st = nullptr;
    if (MK_N_LAUNCHES == 1) bar = xcd_barrier_post((unsigned*)(F0.ctl + CW_BAR), F0.MISC + 8);
    const int lo = args.ph_lo, hi = args.ph_hi;
#define IN(k) (MK_N_LAUNCHES == 1 || in_range((k), lo, hi))
#define GBAR() do { asm volatile("" : "+s"(bar.bar), "+s"(bar.x)); xcd_barrier(bar); } while (0)
#define SEAM(k) do { if (MK_N_LAUNCHES == 1) GBAR(); } while (0)
    if (IN(0)) { if (PROBE_DBL & 1) { { PHASE_FRAME(F); prologue_phase(F); } GBAR(); } PHASE_FRAME(F); prologue_phase(F); SEAM(0); }
#pragma unroll
    for (int f = 0; f < 4; ++f) {
        const int pu = (f == 0) ? 1 : (f == 1) ? 7 : (f == 2) ? 9 : 14;
        if (IN(pu)) { PHASE_FRAME(F);
            pg8::Gemm g{(const bf16*)WSP(bf16, WS_XB), (const bf16*)WSP(bf16, WS_WUP + f * W_UP_BYTES), M, 2 * FF, D}; pg8::StaticOrder S; S.init(M, 2 * FF, F.G, (int)blockIdx.x);
            pg8::EpiSwiglu E{WSP(bf16, WS_H), FF, SSQ_SLOT((f == 0) ? 0 : (f == 1) ? 2 : (f == 2) ? 3 : 5)};
            if (PROBE_DBL & (2 | 128)) { pg8::gemm_phase<pg8::EpiSwiglu, pg8::StaticOrder, true, true>(F.lds, g, S, E); GBAR(); }
            pg8::gemm_phase<pg8::EpiSwiglu, pg8::StaticOrder, true, true>(F.lds, g, S, E);
            {
                constexpr int UP_IDLE0 = (M / 256) * (2 * FF / 256) % 256; static_assert(UP_IDLE0 == 128, "idle tail of the up GEMM");
                if ((int)blockIdx.x >= UP_IDLE0 && F.G == 256) { const int rk = ((int)blockIdx.x - UP_IDLE0) * NWAVES + F.wave, nr = (256 - UP_IDLE0) * NWAVES;
                    if (f == 0) convert_items(F, CV_G1, CV_G2, rk, nr); else if (f == 1) convert_items(F, CV_G3, CV_G4, rk, nr); else if (f == 2) convert_items(F, CV_G4, CV_G5, rk, nr); else convert_items(F, CV_G5, CV_END, rk, nr); }
                else if (F.G != 256) { const int gw_ = (int)blockIdx.x * NWAVES + F.wave, nr_ = F.G * NWAVES;
                    if (f == 0) convert_items(F, CV_G1, CV_G2, gw_, nr_); else if (f == 1) convert_items(F, CV_G3, CV_G4, gw_, nr_); else if (f == 2) convert_items(F, CV_G4, CV_G5, gw_, nr_); else convert_items(F, CV_G5, CV_END, gw_, nr_); } }
            SEAM(pu);
        }
        if (IN(pu + 1)) { PHASE_FRAME(F);
            pg8::Gemm g{(const bf16*)WSP(bf16, WS_H), (const bf16*)WSP(bf16, WS_WDN + f * W_DN_BYTES), M, D, FF}; pg8::StaticOrder S; S.init(M, D, F.G, (int)blockIdx.x);
            pg8::EpiResid E{WSP(bf16, WS_XB), SSQ_SLOT((f == 0) ? 1 : (f == 1) ? 3 : (f == 2) ? 4 : 6), 0.5f};
            if (PROBE_DBL & (2 | 256)) { pg8::EpiResid E0 = E; E0.alpha = 0.f; pg8::gemm_phase<pg8::EpiResid, pg8::StaticOrder, true, true>(F.lds, g, S, E0); GBAR(); }
            pg8::gemm_phase<pg8::EpiResid, pg8::StaticOrder, true, true>(F.lds, g, S, E);
            SEAM(pu + 1);
        }
        if (f == 0) {
            if (IN(3)) { PHASE_FRAME(F);
                pg8::Gemm g{(const bf16*)WSP(bf16, WS_XB), (const bf16*)WSP(bf16, WS_WEVIN), M, EV_IN, D}; pg8::StaticOrder S; S.init(M, EV_IN, F.G, (int)blockIdx.x);
                pg8::EpiProj E{WSP(bf16, WS_PR), RW_COLS, RW_COLS / 256, WSP(bf16, WS_QB), 512, 2, (size_t)M * 512, SSQ_SLOT(1), WSP(float, WS_KMEAN), RW_COLS / 256 + 2};
                if (PROBE_DBL & (2 | 512)) { pg8::EpiProj E0 = E; E0.kmean = nullptr; pg8::gemm_phase<pg8::EpiProj, pg8::StaticOrder, true, true>(F.lds, g, S, E0); GBAR(); }
                pg8::gemm_phase<pg8::EpiProj, pg8::StaticOrder, true, true>(F.lds, g, S, E);
                {
                    if ((int)blockIdx.x >= 64 && F.G == 256) convert_items(F, CV_G2, CV_G3, ((int)blockIdx.x - 64) * NWAVES + F.wave, 192 * NWAVES);
                    else if (F.G != 256) convert_items(F, CV_G2, CV_G3, (int)blockIdx.x * NWAVES + F.wave, F.G * NWAVES); }
                SEAM(3);
            }
                        if (IN(5)) { if (PROBE_DBL & 4) { { PHASE_FRAME(F); lora_kmean_phase(F); } GBAR(); } { PHASE_FRAME(F); lora_kmean_phase(F); } if (PROBE_DBL & 8) { { PHASE_FRAME(F); moba_phase(F); } GBAR(); } { PHASE_FRAME(F); moba_phase(F); } if (MK_N_LAUNCHES == 1) GBAR(); if (PROBE_DBL & 4096) { { PHASE_FRAME(F); rwkv_gram_phase(F); } GBAR(); } { PHASE_FRAME(F); rwkv_gram_phase(F); } GBAR(); if (PROBE_DBL & 16) { { PHASE_FRAME(F); rwkv_cscan_phase<true, false>(F); } GBAR(); } if (PROBE_DBL & 8192) { { PHASE_FRAME(F); rwkv_cscan_phase<true, true>(F); } GBAR(); } { PHASE_FRAME(F); rwkv_cscan_phase(F); } if (MK_N_LAUNCHES == 1) GBAR(); { PHASE_FRAME(F); rwkv_post_phase(F); } SEAM(5); }
            if (IN(6)) { PHASE_FRAME(F);
                pg8::Gemm g{(const bf16*)WSP(bf16, WS_Y), (const bf16*)WSP(bf16, WS_WEVOUT), M, D, D}; pg8::StaticOrder S; S.init(M, D, F.G, (int)blockIdx.x);
                pg8::EpiResid E{WSP(bf16, WS_XB), SSQ_SLOT(2), 1.0f};
                if (PROBE_DBL & (2 | 256)) { pg8::EpiResid E0 = E; E0.alpha = 0.f; pg8::gemm_phase<pg8::EpiResid, pg8::StaticOrder, true, true>(F.lds, g, S, E0); GBAR(); }
                pg8::gemm_phase<pg8::EpiResid, pg8::StaticOrder, true, true>(F.lds, g, S, E);
                SEAM(6);
            }
        }
        if (f == 2) {
            if (IN(11)) { PHASE_FRAME(F);
                pg8::Gemm g{(const bf16*)WSP(bf16, WS_XB), (const bf16*)WSP(bf16, WS_WODIN), M, OD_IN, D}; pg8::StaticOrder S; S.init(M, OD_IN, F.G, (int)blockIdx.x);
                pg8::EpiProj E{nullptr, 0, 0, WSP(bf16, WS_HQ), 1024, 4, (size_t)M * 1024, SSQ_SLOT(4), nullptr, 0};
                if (PROBE_DBL & (2 | 512)) { pg8::EpiProj E0 = E; E0.kmean = nullptr; pg8::gemm_phase<pg8::EpiProj, pg8::StaticOrder, true, true>(F.lds, g, S, E0); GBAR(); }
                pg8::gemm_phase<pg8::EpiProj, pg8::StaticOrder, true, true>(F.lds, g, S, E);
                SEAM(11);
            }
            if (IN(12)) { { PHASE_FRAME(F); hgrn_prep_phase(F); } GBAR(); if (PROBE_DBL & 32) { { PHASE_FRAME(F); hgrn_phase<true>(F); } GBAR(); } { PHASE_FRAME(F); hgrn_phase<false>(F); } if (MK_N_LAUNCHES == 1) GBAR(); { PHASE_FRAME(F); hgrn_post_phase(F); } SEAM(12); }
            if (IN(13)) { PHASE_FRAME(F);
                pg8::Gemm g{(const bf16*)WSP(bf16, WS_HI), (const bf16*)WSP(bf16, WS_WODOUT), M, D, D}; pg8::StaticOrder S; S.init(M, D, F.G, (int)blockIdx.x);
                pg8::EpiResid E{WSP(bf16, WS_XB), SSQ_SLOT(5), 1.0f};
                if (PROBE_DBL & (2 | 256)) { pg8::EpiResid E0 = E; E0.alpha = 0.f; pg8::gemm_phase<pg8::EpiResid, pg8::StaticOrder, true, true>(F.lds, g, S, E0); GBAR(); }
                pg8::gemm_phase<pg8::EpiResid, pg8::StaticOrder, true, true>(F.lds, g, S, E);
                SEAM(13);
            }
        }
    }
    if (PROBE_DBL & 64) { for (int i_ = 0; i_ < 20; ++i_) GBAR(); }
    if (IN(16)) { PHASE_FRAME(F); final_phase(F); }
#undef IN
#undef SEAM
}

extern "C" void kernel_launch(void* const* d_in, const int* in_sizes, int n_in, void* d_out, int out_size, void* d_ws, size_t ws_size, hipStream_t stream) {
    static int grid = 0;
    if (grid == 0) {
        if (n_in != N_IN || in_sizes[0] != M * D || out_size != M * D || ws_size < WS_END) { fprintf(stderr, "kernel_launch: unexpected shapes (n_in %d in0 %d out %d ws %zu); nothing launched\n", n_in, n_in > 0 ? in_sizes[0] : -1, out_size, ws_size); grid = -1; return; }
        int dev = 0, cus = 0, per_cu = 0;
        if (hipGetDevice(&dev) != hipSuccess || hipDeviceGetAttribute(&cus, hipDeviceAttributeMultiprocessorCount, dev) != hipSuccess) { grid = -1; return; }
        if (hipFuncSetAttribute((const void*)hyb_fwd, hipFuncAttributeMaxDynamicSharedMemorySize, LDS_BYTES) != hipSuccess) { fprintf(stderr, "kernel_launch: hipFuncSetAttribute failed\n"); grid = -1; return; }
        if (hipOccupancyMaxActiveBlocksPerMultiprocessor(&per_cu, (const void*)hyb_fwd, NTHREADS, LDS_BYTES) != hipSuccess || per_cu < 1) { fprintf(stderr, "kernel_launch: occupancy query says %d\n", per_cu); }
        (void)hipGetLastError();
        grid = cus;
    }
    if (grid < 0) return;
    if (hipMemsetAsync((char*)d_ws + WS_CTL, 0, CTL_ZERO_BYTES, stream) != hipSuccess) return;
    if (hipMemsetAsync((char*)d_out + OS_ZERO_BEGIN, 0, OS_ZERO_BYTES, stream) != hipSuccess) return;
    Args a{};
    for (int i = 0; i < N_IN; ++i) a.in[i] = (const float*)d_in[i];
    a.out = (float*)d_out; a.ws = (unsigned char*)d_ws;
    if (MK_N_LAUNCHES == 1) { a.ph_lo = 0; a.ph_hi = NPHASE; a.li = 0; hipLaunchKernelGGL(hyb_fwd, dim3(grid), dim3(NTHREADS), LDS_BYTES, stream, a); }
    else for (int li = 0; li < NPHASE; ++li) { a.ph_lo = li; a.ph_hi = li + 1; a.li = 0; hipLaunchKernelGGL(hyb_fwd, dim3(grid), dim3(NTHREADS), LDS_BYTES, stream, a); }
}
```

```cpp
#include <hip/hip_runtime.h>
#include <cstdio>
#include <cstdint>
namespace pg8 {
#define PG8_LAS __attribute__((address_space(3)))
typedef unsigned short bf16_t;
typedef short bf16x8 __attribute__((ext_vector_type(8)));
typedef float f32x4 __attribute__((ext_vector_type(4)));
typedef unsigned u32x4 __attribute__((ext_vector_type(4)));
constexpr int BM = 256, BK = 64, HALF = 128, HTB = HALF * BK * 2  , STAGE_BYTES = 8 * HTB, NXCD = 8, WGM = 4;

__host__ __device__ __forceinline__ int lds_byte(int r, int c) { const int st = (r >> 4) * 2 + (c >> 5), rr = r & 15, cc = c & 31, ob = rr * 64 + cc * 2; return st * 1024 + (ob ^ (((ob >> 9) & 1) << 5)); }
__host__ __device__ __forceinline__ void stage_rc(int b, int& R, int& C) { const int st = b / 1024, sb = b % 1024, swz = sb ^ (((sb >> 9) & 1) << 5); R = (st >> 1) * 16 + swz / 64; C = (st & 1) * 32 + (swz % 64) / 2; }
__host__ __device__ __forceinline__ int perm32(int rho) { const int n = rho >> 4, i = rho & 15; return 8 * (i >> 2) + 4 * n + (i & 3); }

struct Unit { int pm, pn; };
struct Gemm { const bf16_t* A; const bf16_t* Bt; int M, N, K; };

struct StaticOrder {
    int nM, nN, nwg, G, c;
    __host__ __device__ void init(int M, int N, int G_, int c_) { nM = M / BM; nN = N / BM; nwg = nM * nN; G = G_; c = c_; }
    __host__ __device__ bool next(int i, Unit& u) const {
        const long L = (long)i * G + c; if (L >= nwg) return false;
        int wgid = (int)L; { const int q = nwg / NXCD, r = nwg % NXCD, xcd = wgid % NXCD, off = wgid / NXCD; wgid = (xcd < r ? xcd * (q + 1) : r * (q + 1) + (xcd - r) * q) + off; }
        const int nig = WGM * nN, gid = wgid / nig, fm = gid * WGM, gsz = (nM - fm) < WGM ? (nM - fm) : WGM;
        u.pm = fm + ((wgid % nig) % gsz); u.pn = (wgid % nig) / gsz; return true;
    }
    __device__ __forceinline__ void a_ready(const Unit&) const {}
    __device__ __forceinline__ void done(const Unit&) const {}
};

__device__ __forceinline__ unsigned cvt_pk_bf16(float lo, float hi) { unsigned r; asm volatile("v_cvt_pk_bf16_f32 %0, %1, %2" : "=v"(r) : "v"(lo), "v"(hi)); return r; }
typedef float f32x2 __attribute__((ext_vector_type(2)));
#define PG8_GAS __attribute__((address_space(1)))
typedef unsigned long long ssq_t;
__device__ __forceinline__ float ssq_to_rstd(ssq_t v) { return __builtin_amdgcn_rsqf((float)v * (1.0f / (16777216.0f * 1024.0f)) + 1e-6f); }
__device__ __forceinline__ ssq_t ssq_fix(float s) { return (ssq_t)(s * 16777216.0f + 0.5f); }
__device__ __forceinline__ float row_rstd(const PG8_GAS ssq_t* ssq, int row) { return ssq_to_rstd(ssq[row]); }
__device__ __forceinline__ float silu_f(float x) { return x * __builtin_amdgcn_rcpf(1.0f + __builtin_amdgcn_exp2f(-1.4426950408889634f * x)); }
struct EpiSwiglu {
    static constexpr bool PERM = true, AFTER_DRAIN = false;
    PG8_GAS bf16_t* H; int ldh; const PG8_GAS ssq_t* ssq;
    __device__ __forceinline__ void operator()(const f32x4 (&acc)[2][2][4][2], const Unit& u, int wr, int wc, int fr, int fq) const {
        const int row0 = u.pm * BM + wr * 64 + fr, col0 = u.pn * HALF + wc * 32 + 8 * fq; ssq_t rsv[2][4];
#pragma unroll
        for (int ai = 0; ai < 2; ++ai)
#pragma unroll
            for (int m = 0; m < 4; ++m) rsv[ai][m] = ssq[row0 + ai * HALF + m * 16];
#pragma unroll
        for (int ai = 0; ai < 2; ++ai)
#pragma unroll
            for (int m = 0; m < 4; ++m) { const int row = row0 + ai * HALF + m * 16; const float rs = ssq_to_rstd(rsv[ai][m]), cexp = -1.4426950408889634f * rs, rs2 = rs * rs;
                typedef float v2f_ __attribute__((ext_vector_type(2))); u32x4 w; unsigned wv[4];
#pragma unroll
                for (int p = 0; p < 4; ++p) { const f32x4 gq = acc[ai][0][m][p >> 1], uq = acc[ai][1][m][p >> 1]; const v2f_ g = {gq[2 * (p & 1)], gq[2 * (p & 1) + 1]}, u = {uq[2 * (p & 1)], uq[2 * (p & 1) + 1]};
                    const v2f_ t = g * cexp; v2f_ d = {__builtin_amdgcn_exp2f(t.x), __builtin_amdgcn_exp2f(t.y)}; d = d + 1.0f; const v2f_ r = {__builtin_amdgcn_rcpf(d.x), __builtin_amdgcn_rcpf(d.y)};
                    const v2f_ o = (g * u) * (r * rs2); wv[p] = cvt_pk_bf16(o.x, o.y); }
                w.x = wv[0]; w.y = wv[1]; w.z = wv[2]; w.w = wv[3];
                *(PG8_GAS u32x4*)(H + (size_t)row * ldh + col0) = w; }
    }
};
struct EpiProj {
    static constexpr bool PERM = true, AFTER_DRAIN = false;
    PG8_GAS bf16_t* OA; int ldA; int ntA; PG8_GAS bf16_t* OB; int ldB; int tpB; size_t strideB; const PG8_GAS ssq_t* ssq; PG8_GAS float* kmean; int kt0;
    __device__ __forceinline__ void operator()(const f32x4 (&acc)[2][2][4][2], const Unit& u, int wr, int wc, int fr, int fq) const {
        const int row0 = u.pm * BM + wr * 64 + fr; PG8_GAS bf16_t* base; int ld, colt; f32x4 cs[2][2]; const bool km = kmean != nullptr && (unsigned)(u.pn - kt0) < 2u;
#pragma unroll
        for (int bj = 0; bj < 2; ++bj) { cs[bj][0] = (f32x4){0.f, 0.f, 0.f, 0.f}; cs[bj][1] = cs[bj][0]; }
        if (u.pn < ntA) { base = OA; ld = ldA; colt = u.pn * BM; } else { const int q = u.pn - ntA, t = q / tpB; base = OB + (size_t)t * strideB; ld = ldB; colt = (q - t * tpB) * BM; }
        const int col0 = colt + wc * 32 + 8 * fq; ssq_t rsv[2][4];
#pragma unroll
        for (int ai = 0; ai < 2; ++ai)
#pragma unroll
            for (int m = 0; m < 4; ++m) rsv[ai][m] = ssq[row0 + ai * HALF + m * 16];
#pragma unroll
        for (int ai = 0; ai < 2; ++ai)
#pragma unroll
            for (int m = 0; m < 4; ++m) { const int row = row0 + ai * HALF + m * 16; const float rs = ssq_to_rstd(rsv[ai][m]); PG8_GAS bf16_t* rowp = base + (size_t)row * ld + col0;
#pragma unroll
                for (int bj = 0; bj < 2; ++bj) { const f32x4 v0 = acc[ai][bj][m][0] * rs, v1 = acc[ai][bj][m][1] * rs; cs[bj][0] += v0; cs[bj][1] += v1;
                    u32x4 w; w.x = cvt_pk_bf16(v0[0], v0[1]); w.y = cvt_pk_bf16(v0[2], v0[3]); w.z = cvt_pk_bf16(v1[0], v1[1]); w.w = cvt_pk_bf16(v1[2], v1[3]);
                    *(PG8_GAS u32x4*)(rowp + bj * HALF) = w; } }
        if (km) {
            const int ck0 = (u.pn - kt0) * BM + wc * 32 + 8 * fq; PG8_GAS float* kb = kmean + (size_t)((u.pm >> 3) * 8) * 8 * 64 + (size_t)(u.pm & 7) * 64;
#pragma unroll
            for (int bj = 0; bj < 2; ++bj)
#pragma unroll
                for (int n = 0; n < 2; ++n)
#pragma unroll
                    for (int e = 0; e < 4; ++e) { float v = cs[bj][n][e]; v += __shfl_xor(v, 1); v += __shfl_xor(v, 2); v += __shfl_xor(v, 4); v += __shfl_xor(v, 8);
                        if (fr == 0) { const int ck = ck0 + bj * HALF + 4 * n + e; __builtin_amdgcn_global_atomic_fadd_f32(kb + (size_t)(ck >> 6) * 8 * 64 + (ck & 63), v * (1.0f / 256.0f)); } } }
    }
};
struct EpiResid {
    static constexpr bool PERM = true, AFTER_DRAIN = false;
    PG8_GAS bf16_t* XB; PG8_GAS ssq_t* ssq; float alpha;
    __device__ __forceinline__ void operator()(const f32x4 (&acc)[2][2][4][2], const Unit& u, int wr, int wc, int fr, int fq) const {
        const int row0 = u.pm * BM + wr * 64 + fr, col0 = u.pn * BM + wc * 32 + 8 * fq;
        u32x4 bq_[8][2];
#pragma unroll
        for (int g = 0; g < 6; ++g)
#pragma unroll
            for (int bj = 0; bj < 2; ++bj) bq_[g][bj] = *(const PG8_GAS u32x4*)(XB + (size_t)(row0 + (g >> 2) * HALF + (g & 3) * 16) * 1024 + col0 + bj * HALF);
#pragma unroll
        for (int g = 0; g < 8; ++g) { const int ai = g >> 2, m = g & 3; const int row = row0 + ai * HALF + m * 16; const size_t off = (size_t)row * 1024 + col0; float ss = 0.f;
            if (g < 2) {
#pragma unroll
                for (int bj = 0; bj < 2; ++bj) bq_[g + 6][bj] = *(const PG8_GAS u32x4*)(XB + (size_t)(row0 + ((g + 6) >> 2) * HALF + ((g + 6) & 3) * 16) * 1024 + col0 + bj * HALF); }
#pragma unroll
            for (int bj = 0; bj < 2; ++bj) { const u32x4 bw = bq_[g][bj]; const unsigned bq[4] = {bw.x, bw.y, bw.z, bw.w}; unsigned wq[4];
#pragma unroll
                for (int n = 0; n < 2; ++n) {
                    const f32x4 b = (f32x4){__builtin_bit_cast(float, bq[2 * n] << 16), __builtin_bit_cast(float, bq[2 * n] & 0xffff0000u), __builtin_bit_cast(float, bq[2 * n + 1] << 16), __builtin_bit_cast(float, bq[2 * n + 1] & 0xffff0000u)};
                    const f32x4 o = b + acc[ai][bj][m][n] * alpha; wq[2 * n] = cvt_pk_bf16(o[0], o[1]); wq[2 * n + 1] = cvt_pk_bf16(o[2], o[3]);
                    const float r0 = __builtin_bit_cast(float, wq[2 * n] << 16), r1 = __builtin_bit_cast(float, wq[2 * n] & 0xffff0000u), r2 = __builtin_bit_cast(float, wq[2 * n + 1] << 16), r3 = __builtin_bit_cast(float, wq[2 * n + 1] & 0xffff0000u);
                    ss += (r0 * r0 + r1 * r1) + (r2 * r2 + r3 * r3); }
                u32x4 w; w.x = wq[0]; w.y = wq[1]; w.z = wq[2]; w.w = wq[3]; *(PG8_GAS u32x4*)(XB + off + bj * HALF) = w; }
            ss += __shfl_xor(ss, 16); ss += __shfl_xor(ss, 32);
            if (fq == 0 && alpha != 0.f) __hip_atomic_fetch_add(ssq + row, ssq_fix(ss), __ATOMIC_RELAXED, __HIP_MEMORY_SCOPE_AGENT);
            asm volatile("" ::: "memory"); }
    }
};

template <class Epi, class Sched, bool ALIGN_EPI = false, bool SP2 = false>
__device__ __forceinline__ void gemm_phase(PG8_LAS unsigned char* lds, const Gemm g, const Sched& S, const Epi& E) {
    int tid_l = threadIdx.x; asm volatile("" : "+v"(tid_l));
    const int tid = tid_l, wid = __builtin_amdgcn_readfirstlane(tid >> 6), lane = tid & 63, wr = wid >> 2, wc = wid & 3, fr = lane & 15, fq = lane >> 4;
    const int K = g.K, nt = K / BK;
    unsigned voffA[2], voffB[2];
#pragma unroll
    for (int i = 0; i < 2; ++i) { int R, C; stage_rc(tid * 16 + i * 8192, R, C); const int Rb = Epi::PERM ? ((R & ~31) + perm32(R & 31)) : R;
        voffA[i] = (unsigned)(R * K + C) * 2u; voffB[i] = (unsigned)(Rb * K + C) * 2u; }
    const size_t kstep = (size_t)(BK * 2);
    const size_t hstep = (size_t)HALF * K * 2;
    const size_t tstep = 2 * hstep;
    const unsigned ldsw = (unsigned)wid * 1024u;
    const int aoff = lds_byte(wr * 64 + fr, fq * 8), boff = lds_byte(wc * 32 + fr, fq * 8);
#define PG8_SA(b, h) (((b) * 2 + (h)) * HTB)
#define PG8_SB(b, h) ((4 + (b) * 2 + (h)) * HTB)
#define PG8_STAGE(bufoff, gbase, voff) do { _Pragma("unroll") for (int _i = 0; _i < 2; ++_i) \
        __builtin_amdgcn_global_load_lds((const unsigned*)((const char*)(gbase) + (voff)[_i]), (PG8_LAS unsigned*)(lds + (bufoff) + ldsw + _i * 8192), 16, 0, 0); } while (0)
#define PG8_LDA(dst, b, h) do { _Pragma("unroll") for (int m = 0; m < 4; ++m) _Pragma("unroll") for (int k = 0; k < 2; ++k) dst[m][k] = *(const PG8_LAS bf16x8*)(lds + PG8_SA(b, h) + aoff + m * 2048 + k * 1024); } while (0)
#define PG8_LDB(dst, b, h) do { _Pragma("unroll") for (int n = 0; n < 2; ++n) _Pragma("unroll") for (int k = 0; k < 2; ++k) dst[n][k] = *(const PG8_LAS bf16x8*)(lds + PG8_SB(b, h) + boff + n * 2048 + k * 1024); } while (0)
#define PG8_MMA(ai, bj, At, Bt) do { __builtin_amdgcn_s_setprio(1); _Pragma("unroll") for (int m = 0; m < 4; ++m) _Pragma("unroll") for (int n = 0; n < 2; ++n) _Pragma("unroll") for (int k = 0; k < 2; ++k) \
        acc[ai][bj][m][n] = __builtin_amdgcn_mfma_f32_16x16x32_bf16(Bt[n][k], At[m][k], acc[ai][bj][m][n], 0, 0, 0); __builtin_amdgcn_s_setprio(0); } while (0)
#define PG8_WAIT_V(n) asm volatile("s_waitcnt vmcnt(" #n ")" ::: "memory")
#define PG8_WAIT_L(n) asm volatile("s_waitcnt lgkmcnt(" #n ")" ::: "memory")
#define PG8_BAR __builtin_amdgcn_s_barrier()
#define PG8_SCHED __builtin_amdgcn_sched_barrier(0)
    Unit cur, nxt; int ui = 0;
    if (!S.next(0, cur)) return;
    f32x4 acc[2][2][4][2];
#pragma unroll
    for (int a = 0; a < 2; ++a)
#pragma unroll
        for (int b = 0; b < 2; ++b)
#pragma unroll
            for (int m = 0; m < 4; ++m)
#pragma unroll
                for (int n = 0; n < 2; ++n) acc[a][b][m][n] = (f32x4){0.f, 0.f, 0.f, 0.f};
    bf16x8 At[4][2], B0[2][2], B1[2][2];
    const char* cA = (const char*)g.A + (size_t)cur.pm * tstep; const char* cB = (const char*)g.Bt + (size_t)cur.pn * tstep;
    S.a_ready(cur);
    if constexpr (SP2) {
        PG8_STAGE(PG8_SB(0, 0), cB, voffB); PG8_STAGE(PG8_SB(0, 1), cB + hstep, voffB); PG8_STAGE(PG8_SA(0, 0), cA, voffA); PG8_STAGE(PG8_SA(0, 1), cA + hstep, voffA);
        if (wr == 1) PG8_BAR;
        PG8_WAIT_V(2); PG8_BAR;
        PG8_STAGE(PG8_SB(1, 0), cB + kstep, voffB); PG8_STAGE(PG8_SA(1, 0), cA + kstep, voffA); PG8_STAGE(PG8_SB(1, 1), cB + hstep + kstep, voffB);
        PG8_WAIT_V(6); PG8_BAR;
    } else {
        PG8_STAGE(PG8_SB(0, 0), cB, voffB); PG8_STAGE(PG8_SA(0, 0), cA, voffA); PG8_STAGE(PG8_SB(0, 1), cB + hstep, voffB); PG8_STAGE(PG8_SA(0, 1), cA + hstep, voffA);
        if (wr == 1) PG8_BAR;
        PG8_WAIT_V(4); PG8_BAR;
        PG8_STAGE(PG8_SB(1, 0), cB + kstep, voffB); PG8_STAGE(PG8_SA(1, 0), cA + kstep, voffA); PG8_STAGE(PG8_SB(1, 1), cB + hstep + kstep, voffB);
        PG8_WAIT_V(6); PG8_BAR;
    }
    for (;;) {
        const bool has_next = S.next(ui + 1, nxt);
        const char* nA = has_next ? (const char*)g.A + (size_t)nxt.pm * tstep : cA; const char* nB = has_next ? (const char*)g.Bt + (size_t)nxt.pn * tstep : cB;
        for (int t = 0; t < nt; t += 2) {
            const bool last = (t == nt - 2);
            const char* a1 = cA + (size_t)(t + 1) * kstep;
            const char* a2 = last ? nA : cA + (size_t)(t + 2) * kstep; const char* b2 = last ? nB : cB + (size_t)(t + 2) * kstep;
            const char* a3 = a2 + kstep; const char* b3 = b2 + kstep;
            if (last && has_next) S.a_ready(nxt);
            if constexpr (SP2) {
            PG8_LDB(B0, 0, 0); PG8_LDB(B1, 0, 1); PG8_SCHED; PG8_LDA(At, 0, 0); PG8_STAGE(PG8_SA(1, 1), a1 + hstep, voffA);
            PG8_WAIT_V(8); PG8_WAIT_L(0); PG8_BAR; PG8_MMA(0, 0, At, B0); PG8_MMA(0, 1, At, B1); PG8_BAR; PG8_SCHED;
            PG8_LDA(At, 0, 1); PG8_STAGE(PG8_SB(0, 0), b2, voffB); PG8_STAGE(PG8_SB(0, 1), b2 + hstep, voffB); PG8_STAGE(PG8_SA(0, 0), a2, voffA);
            PG8_WAIT_V(8); PG8_WAIT_L(0); PG8_BAR; PG8_MMA(1, 0, At, B0); PG8_MMA(1, 1, At, B1); PG8_BAR; PG8_SCHED;
            PG8_LDB(B0, 1, 0); PG8_LDB(B1, 1, 1); PG8_SCHED; PG8_LDA(At, 1, 0); PG8_STAGE(PG8_SA(0, 1), a2 + hstep, voffA);
            PG8_WAIT_V(8); PG8_WAIT_L(0); PG8_BAR; PG8_MMA(0, 0, At, B0); PG8_MMA(0, 1, At, B1); PG8_BAR; PG8_SCHED;
            PG8_LDA(At, 1, 1); PG8_STAGE(PG8_SB(1, 0), b3, voffB); PG8_STAGE(PG8_SB(1, 1), b3 + hstep, voffB); PG8_STAGE(PG8_SA(1, 0), a3, voffA);
            PG8_WAIT_V(8); PG8_WAIT_L(0); PG8_BAR; PG8_MMA(1, 0, At, B0); PG8_MMA(1, 1, At, B1); PG8_BAR; PG8_SCHED;
            } else {
            PG8_LDB(B0, 0, 0); PG8_SCHED; PG8_LDA(At, 0, 0); PG8_STAGE(PG8_SA(1, 1), a1 + hstep, voffA);
            PG8_WAIT_L(8); PG8_BAR; PG8_WAIT_L(0); PG8_MMA(0, 0, At, B0); PG8_BAR; PG8_SCHED;
            PG8_LDB(B1, 0, 1); PG8_STAGE(PG8_SB(0, 0), b2, voffB);
            PG8_BAR; PG8_WAIT_L(0); PG8_MMA(0, 1, At, B1); PG8_BAR;
            PG8_LDA(At, 0, 1); PG8_STAGE(PG8_SA(0, 0), a2, voffA);
            PG8_BAR; PG8_WAIT_L(0); PG8_MMA(1, 0, At, B0); PG8_BAR; PG8_SCHED;
            PG8_STAGE(PG8_SB(0, 1), b2 + hstep, voffB);
            PG8_WAIT_V(6); PG8_BAR; PG8_MMA(1, 1, At, B1); PG8_BAR;
            PG8_LDB(B0, 1, 0); PG8_SCHED; PG8_LDA(At, 1, 0); PG8_STAGE(PG8_SA(0, 1), a2 + hstep, voffA);
            PG8_WAIT_L(8); PG8_BAR; PG8_WAIT_L(0); PG8_MMA(0, 0, At, B0); PG8_BAR; PG8_SCHED;
            PG8_LDB(B1, 1, 1); PG8_STAGE(PG8_SB(1, 0), b3, voffB);
            PG8_BAR; PG8_WAIT_L(0); PG8_MMA(0, 1, At, B1); PG8_BAR;
            PG8_LDA(At, 1, 1); PG8_STAGE(PG8_SA(1, 0), a3, voffA);
            PG8_BAR; PG8_WAIT_L(0); PG8_MMA(1, 0, At, B0); PG8_BAR; PG8_SCHED;
            PG8_STAGE(PG8_SB(1, 1), b3 + hstep, voffB);
            PG8_WAIT_V(6); PG8_BAR; PG8_MMA(1, 1, At, B1); PG8_BAR;
            }
        }
        if constexpr (ALIGN_EPI) { if (wr == 0) PG8_BAR; }
        if constexpr (!Epi::AFTER_DRAIN) { E(acc, cur, wr, wc, fr, fq); S.done(cur); }
        if (!has_next) break;
#pragma unroll
        for (int a = 0; a < 2; ++a)
#pragma unroll
            for (int b = 0; b < 2; ++b)
#pragma unroll
                for (int m = 0; m < 4; ++m)
#pragma unroll
                    for (int n = 0; n < 2; ++n) acc[a][b][m][n] = (f32x4){0.f, 0.f, 0.f, 0.f};
        cur = nxt; cA = nA; cB = nB; ++ui;
        if constexpr (ALIGN_EPI) { if (wr == 1) PG8_BAR; }
    }
    PG8_WAIT_V(0);
    if constexpr (!ALIGN_EPI) { if (wr == 0) PG8_BAR; }
    PG8_BAR;
    if constexpr (Epi::AFTER_DRAIN) { E.fused(acc, cur, wr, wc, fr, fq, lds, wid, lane); S.done(cur); }
#undef PG8_SA
#undef PG8_SB
#undef PG8_STAGE
#undef PG8_LDA
#undef PG8_LDB
#undef PG8_MMA
#undef PG8_WAIT_V
#undef PG8_WAIT_L
#undef PG8_BAR
#undef PG8_SCHED
}
}

#define GAS __attribute__((address_space(1)))
#define LAS __attribute__((address_space(3)))
typedef unsigned short bf16;
typedef unsigned v4u __attribute__((ext_vector_type(4)));
typedef float f32x4 __attribute__((ext_vector_type(4)));
typedef short bf16x8 __attribute__((ext_vector_type(8)));
typedef GAS unsigned gu32;
typedef GAS unsigned long long gu64;
#define RLX_AGENT __ATOMIC_RELAXED, __HIP_MEMORY_SCOPE_AGENT
#define LDS_WAIT() asm volatile("s_waitcnt lgkmcnt(0)" ::: "memory")
#define VM_WAIT() asm volatile("s_waitcnt vmcnt(0)" ::: "memory")
__device__ __forceinline__ unsigned long long rt() { return __builtin_amdgcn_s_memrealtime(); }
typedef float f32x2_t __attribute__((ext_vector_type(2))); typedef __bf16 bf16x2_t __attribute__((ext_vector_type(2)));
__device__ __forceinline__ unsigned pk2(float lo, float hi) { const f32x2_t v = {lo, hi}; return __builtin_bit_cast(unsigned, __builtin_convertvector(v, bf16x2_t)); }
__device__ __forceinline__ unsigned f2bf(float f) { return pk2(f, f) & 0xffffu; }
#define XB_TMO      128
#define XB_XCNT(j)  (256  + 64 * (j))
#define XB_XSUB(j)  (1280 + 64 * (j))
#define XB_XGEN(j)  (2304 + 64 * (j))
#define XB_TOP      3328
#define XB_TOPGEN   3392
#define XCD_BAR_WORDS 3456
#define XB_SPIN_CAP (1u << 18)

__device__ __forceinline__ unsigned xb_ld(unsigned* p)              { return __hip_atomic_load(p, __ATOMIC_RELAXED, __HIP_MEMORY_SCOPE_AGENT); }
__device__ __forceinline__ unsigned xb_add(unsigned* p, unsigned v) { return __hip_atomic_fetch_add(p, v, __ATOMIC_RELAXED, __HIP_MEMORY_SCOPE_AGENT); }
__device__ __forceinline__ unsigned xb_xcc_id() { return (unsigned)__builtin_amdgcn_s_getreg((3 << 11) | 20) & 0xFu; }
#define XB_SPIN(cond, bar) do { unsigned _sp = 0; while (cond) { __builtin_amdgcn_s_sleep(1); \
    if ((++_sp & 255u) == 0u) { if (xb_ld(&(bar)[XB_TMO])) break; if (_sp > XB_SPIN_CAP) { atomicAdd(&(bar)[XB_TMO], 1u); break; } } } } while (0)

struct XcdBarrier {
    unsigned* bar; unsigned x;
    volatile LAS unsigned* st;
};

__device__ __forceinline__ XcdBarrier xcd_barrier_post(unsigned* bar, volatile LAS unsigned* st) {
    XcdBarrier b; b.bar = bar; b.x = xb_xcc_id(); b.st = st;
    if (threadIdx.x == 0) (void)xb_add(&bar[XB_XCNT(b.x)], 1u);
    return b;
}
__device__ __forceinline__ void xcd_barrier_complete(unsigned* bar, unsigned x, unsigned& nloc, unsigned& nx) {
    const unsigned G = gridDim.x * gridDim.y * gridDim.z;
    unsigned sum, cnt, mine, sp = 0u;
    for (;;) {
        sum = 0u; cnt = 0u; mine = 0u;
#pragma unroll 1
        for (unsigned j = 0; j < 16; ++j) { const unsigned c = xb_ld(&bar[XB_XCNT(j)]); sum += c; cnt += (c > 0u) ? 1u : 0u; mine = (j == x) ? c : mine; }
        if (sum == G) break;
        __builtin_amdgcn_s_sleep(1);
        if ((++sp & 255u) == 0u) { if (xb_ld(&bar[XB_TMO])) break; if (sp > XB_SPIN_CAP) { atomicAdd(&bar[XB_TMO], 1u); break; } }
    }
    nloc = mine > 0u ? mine : 1u; nx = cnt > 0u ? cnt : 1u;
}

__device__ __forceinline__ void xcd_barrier(const XcdBarrier& b) {
    asm volatile("s_waitcnt vmcnt(0)" ::: "memory");
    __syncthreads();
    if (threadIdx.x == 0) {
        unsigned* bar = b.bar;
        __builtin_amdgcn_s_waitcnt(0);
        unsigned nloc = b.st[0], nx = b.st[1];
        if (nloc == 0u) { xcd_barrier_complete(bar, b.x, nloc, nx); b.st[0] = nloc; b.st[1] = nx; }
        const unsigned old = xb_add(&bar[XB_XSUB(b.x)], 1u);
        const unsigned gen = old / nloc;
        if (old + 1u == (gen + 1u) * nloc) {
            __builtin_amdgcn_fence(__ATOMIC_RELEASE, "agent");
            asm volatile("s_waitcnt vmcnt(0)" ::: "memory");
            const unsigned og = xb_add(&bar[XB_TOP], 1u);
            const unsigned tg = og / nx;
            if (og + 1u == (tg + 1u) * nx) xb_add(&bar[XB_TOPGEN], 1u);
            else XB_SPIN(xb_ld(&bar[XB_TOPGEN]) == tg, bar);
            __builtin_amdgcn_fence(__ATOMIC_ACQUIRE, "agent");
            xb_add(&bar[XB_XGEN(b.x)], 1u);
            asm volatile("s_waitcnt vmcnt(0)" ::: "memory");
        } else {
            XB_SPIN(xb_ld(&bar[XB_XGEN(b.x)]) == gen, bar);
            __builtin_amdgcn_fence(__ATOMIC_ACQUIRE, "agent");
            asm volatile("s_waitcnt vmcnt(0)" ::: "memory");
        }
    }
    __syncthreads();
}
constexpr int BATCH = 8, SEQ = 2048, D = 1024, M = BATCH * SEQ, FF = 2816;
constexpr int RW_COLS = 1792, EV_IN = 3328, OD_IN = 4096;
constexpr int NWAVES = 8, NTHREADS = NWAVES * 64;
constexpr int N_IN = 26;
constexpr size_t MiB = 1u << 20;
constexpr size_t WS_CTL = 0, CTL_ZERO_BYTES = 3 * MiB;
constexpr size_t OS_HSS = 32 * MiB;
constexpr size_t OS_WC = 56 * MiB;
constexpr size_t OS_IKH = 0, OS_IRH = 40 * MiB, WS_IAH = 36 * MiB, WS_IKT_LO = 3 * MiB, WS_IKT_HI = 48 * MiB;
constexpr size_t OS_RN = 36 * MiB;
constexpr size_t OS_RST = 33 * MiB, OS_ZERO_BEGIN = 32 * MiB, OS_ZERO_BYTES = 3 * MiB;
constexpr size_t WS_SSQ = 2 * MiB;
#define SSQ_SLOT(k) WSP(pg8::ssq_t, WS_SSQ + (size_t)(k) * M * 8)
constexpr size_t WS_W = 3 * MiB;
constexpr size_t W_UP_BYTES = (size_t)2 * FF * D * 2, W_DN_BYTES = (size_t)D * FF * 2;
constexpr size_t WS_WUP = WS_W, WS_WDN = WS_WUP + 4 * W_UP_BYTES, WS_WEVIN = WS_WDN + 4 * W_DN_BYTES, WS_WEVOUT = WS_WEVIN + (size_t)EV_IN * D * 2,
                 WS_WODIN = WS_WEVOUT + (size_t)D * D * 2, WS_WODOUT = WS_WODIN + (size_t)OD_IN * D * 2, WS_WEND = WS_WODOUT + (size_t)D * D * 2;
constexpr size_t WS_KMEAN = 128 * 1024;
constexpr size_t WS_LW2 = 88 * MiB - 512 * 1024, WS_LA2 = WS_LW2 + 64 * 1024, WS_LG2 = WS_LA2 + 64 * 1024;
constexpr size_t WS_XB = 88 * MiB;
constexpr size_t WS_H = 120 * MiB;
constexpr size_t WS_PR = 120 * MiB, WS_QB = 176 * MiB, WS_KB = 192 * MiB, WS_VB = 208 * MiB, WS_Y = 224 * MiB;
constexpr size_t OS_RE = 0, OS_RA = 16 * MiB, WS_YRAW = WS_QB;
constexpr size_t WS_GM = WS_KB;
constexpr size_t WS_HQ = 120 * MiB, WS_HF = 152 * MiB, WS_HI = 184 * MiB, WS_HG = 216 * MiB;
constexpr size_t OS_KT2 = 0;
constexpr size_t WS_RB = 248 * MiB;
constexpr size_t WS_DRY = 250 * MiB;
constexpr size_t WS_END = 256 * MiB;
static_assert(WS_WEND <= WS_LW2 && WS_LG2 + 128 * 1024 <= WS_XB && WS_H + (size_t)M * FF * 2 <= WS_Y + 0 * MiB + 32 * MiB && WS_PR + (size_t)M * RW_COLS * 2 <= WS_QB && WS_Y + (size_t)M * D * 2 <= WS_END && WS_HG + (size_t)M * D * 2 <= WS_END, "d_ws map");
constexpr int CW_BAR = 4096;
constexpr int RING_BYTES = 131072, LDSCTL_OFF = RING_BYTES, MISC_OFF = LDSCTL_OFF + 320, LDS_BYTES = 147456;

__device__ __forceinline__ float bf2f(bf16 v) { return __builtin_bit_cast(float, (unsigned)v << 16); }
__device__ __forceinline__ float sigm(float x) { return 1.0f / (1.0f + __expf(-x)); }
__device__ __forceinline__ float sigmf(float x) { return __builtin_amdgcn_rcpf(1.0f + __builtin_amdgcn_exp2f(-1.4426950408889634f * x)); }
__device__ __forceinline__ float wave_sum(float v) {
#pragma unroll
    for (int o = 1; o < 64; o <<= 1) v += __shfl_xor(v, o);
    return v;
}
__device__ __forceinline__ float wave_max(float v) {
#pragma unroll
    for (int o = 1; o < 64; o <<= 1) v = fmaxf(v, __shfl_xor(v, o));
    return v;
}

typedef float f32x4v __attribute__((ext_vector_type(4)));
typedef float f32x16 __attribute__((ext_vector_type(16)));
typedef unsigned v2u __attribute__((ext_vector_type(2)));
typedef float v2f __attribute__((ext_vector_type(2)));
#define LDS_BARRIER() do { asm volatile("s_waitcnt lgkmcnt(0)" ::: "memory"); __builtin_amdgcn_s_barrier(); asm volatile("" ::: "memory"); } while (0)
__device__ __forceinline__ long long fx20(float v) { return (long long)llrintf(v * 1073741824.0f); }
__device__ __forceinline__ float unfx20(long long v) { return (float)v * (1.0f / 1073741824.0f); }
struct Frame {
    LAS unsigned char* lds; volatile LAS unsigned* MISC; gu32* ctl;
    int tid, lane, wave, vcu, G;
    GAS float* out; GAS unsigned char* ws;
};
#define WSP(T, off) ((GAS T*)(F.ws + (off)))
#define OSP(T, off) ((GAS T*)((GAS unsigned char*)F.out + (off)))
constexpr int PTAB_OFF = LDSCTL_OFF + 1024;
__device__ __forceinline__ const GAS float* inp(const Frame& F, int i) {
    const unsigned long long v = ((const LAS unsigned long long*)(F.lds + PTAB_OFF))[i];
    const unsigned lo = __builtin_amdgcn_readfirstlane((unsigned)v), hi = __builtin_amdgcn_readfirstlane((unsigned)(v >> 32));
    return (const GAS float*)(((unsigned long long)hi << 32) | lo);
}
__device__ __forceinline__ bool in_range(int k, int lo, int hi) { asm volatile("" : "+s"(lo), "+s"(hi)); return lo <= k && k < hi; }
#define PHASE_FRAME(FP) Frame FP = F0; asm volatile("" : "+v"(FP.tid), "+v"(FP.lane)); asm volatile("" : "+s"(FP.wave), "+s"(FP.vcu), "+s"(FP.G), "+s"(FP.ws), "+s"(FP.out))
struct Args { const float* in[N_IN]; float* out; unsigned char* ws; int ph_lo, ph_hi, li, pad; };

__device__ __forceinline__ void transpose_item(const GAS float* W, int K, int N, const GAS float* gain, GAS bf16* WT, int mode, LAS float* scr, int item, int lane) {
    const int nblk = N / 32, kb = item / nblk, nb = item % nblk, k0 = 64 * kb, n0 = 32 * nb;
    float wv[32];
#pragma unroll
    for (int i = 0; i < 32; ++i) wv[i] = W[(size_t)(k0 + 2 * i + (lane >> 5)) * N + n0 + (lane & 31)];
    if (gain) { const float g0 = gain[k0 + lane];
#pragma unroll
        for (int i = 0; i < 32; ++i) wv[i] *= __shfl(g0, 2 * i + (lane >> 5)); }
#pragma unroll
    for (int i = 0; i < 32; ++i) scr[(2 * i + (lane >> 5)) * 33 + (lane & 31)] = wv[i];
    LDS_WAIT(); asm volatile("" ::: "memory");
    const int c = lane & 7; const int rbase = (mode == 0) ? n0 : (n0 + 128 * (n0 >> 7) + (mode == 2 ? 128 : 0));
#pragma unroll
    for (int j = 0; j < 4; ++j) { const int n = (lane >> 3) + 8 * j; const LAS float* s = scr + (8 * c) * 33 + n;
        v4u o; o.x = pk2(s[0 * 33], s[1 * 33]); o.y = pk2(s[2 * 33], s[3 * 33]); o.z = pk2(s[4 * 33], s[5 * 33]); o.w = pk2(s[6 * 33], s[7 * 33]);
        *(GAS v4u*)(WT + (size_t)(rbase + n) * K + k0 + 8 * c) = o; }
    LDS_WAIT(); asm volatile("" ::: "memory");
}
constexpr int I_FF = (D / 64) * (FF / 32), I_EVIN = (D / 64) * (EV_IN / 32), I_OUT = (D / 64) * (D / 32), I_ODIN = (D / 64) * (OD_IN / 32);
constexpr int CV_G1 = 2 * I_FF, CV_G2 = CV_G1 + I_FF + I_EVIN + I_OUT, CV_G3 = CV_G2 + 4 * I_FF, CV_G4 = CV_G3 + 2 * I_FF + I_OUT + I_ODIN / 2, CV_G5 = CV_G4 + I_ODIN / 2 + 2 * I_FF, CV_END = CV_G5 + I_FF;
static_assert(CV_END == 12 * I_FF + I_EVIN + 2 * I_OUT + I_ODIN, "conversion item count");
__device__ __forceinline__ void convert_ffn(Frame& F, int f, int which  , int item, LAS float* scr) {
    const int l = f >> 1, second = f & 1; const GAS float* gain = inp(F, 1) + (size_t)(l * 3 + (second ? 2 : 0)) * D;
    if (which == 0) transpose_item((second ? inp(F, 5) : inp(F, 2)) + (size_t)l * D * FF, D, FF, gain, WSP(bf16, WS_WUP + f * W_UP_BYTES), 1, scr, item, F.lane);
    else if (which == 1) transpose_item((second ? inp(F, 6) : inp(F, 3)) + (size_t)l * D * FF, D, FF, gain, WSP(bf16, WS_WUP + f * W_UP_BYTES), 2, scr, item, F.lane);
    else transpose_item((second ? inp(F, 7) : inp(F, 4)) + (size_t)l * FF * D, FF, D, nullptr, WSP(bf16, WS_WDN + f * W_DN_BYTES), 0, scr, item, F.lane);
}
__device__ __forceinline__ void convert_items(Frame& F, int first, int last, int rank, int nranks) {
    LAS float* scr = (LAS float*)(F.lds + F.wave * 16384);
    for (int it = first + rank; it < last; it += nranks) {
        int r = it;
        if (r < CV_G1) { convert_ffn(F, 0, r / I_FF, r % I_FF, scr); continue; } r -= CV_G1;
        if (r < I_FF) { convert_ffn(F, 0, 2, r, scr); continue; } r -= I_FF;
        if (r < I_EVIN) { transpose_item(inp(F, 8), D, EV_IN, inp(F, 1) + 1 * D, WSP(bf16, WS_WEVIN), 0, scr, r, F.lane); continue; } r -= I_EVIN;
        if (r < I_OUT) { transpose_item(inp(F, 9), D, D, nullptr, WSP(bf16, WS_WEVOUT), 0, scr, r, F.lane); continue; } r -= I_OUT;
        if (r < 3 * I_FF) { convert_ffn(F, 1, r / I_FF, r % I_FF, scr); continue; } r -= 3 * I_FF;
        if (r < 2 * I_FF) { convert_ffn(F, 2, r / I_FF, r % I_FF, scr); continue; } r -= 2 * I_FF;
        if (r < I_FF) { convert_ffn(F, 2, 2, r, scr); continue; } r -= I_FF;
        if (r < I_OUT) { transpose_item(inp(F, 22), D, D, nullptr, WSP(bf16, WS_WODOUT), 0, scr, r, F.lane); continue; } r -= I_OUT;
        if (r < I_ODIN) { transpose_item(inp(F, 21), D, OD_IN, inp(F, 1) + 4 * D, WSP(bf16, WS_WODIN), 0, scr, r, F.lane); continue; } r -= I_ODIN;
        convert_ffn(F, 3, r / I_FF, r % I_FF, scr);
    }
}
__device__ __forceinline__ void prologue_phase(Frame& F) {
    const int gw = F.vcu * NWAVES + F.wave, NGW = F.G * NWAVES;
    convert_items(F, 0, CV_G1, gw, NGW);
    {
        const GAS float* w2 = inp(F, 12); const GAS float* a2 = inp(F, 14); const GAS float* g2 = inp(F, 15); GAS bf16* lw = WSP(bf16, WS_LW2); GAS bf16* la = WSP(bf16, WS_LA2); GAS bf16* lg = WSP(bf16, WS_LG2);
        for (int i = gw * 64 + F.lane; i < 512 * 64; i += NGW * 64) { const int n = i >> 6, k = i & 63; lw[i] = (bf16)f2bf(w2[k * 512 + n]); la[i] = (bf16)f2bf(a2[k * 512 + n]); }
        for (int i = gw * 64 + F.lane; i < 512 * 128; i += NGW * 64) { const int n = i >> 7, k = i & 127; lg[i] = (bf16)f2bf(g2[k * 512 + n]); } }
    const GAS float* x = inp(F, 0); GAS bf16* XB = WSP(bf16, WS_XB); GAS pg8::ssq_t* ssq = SSQ_SLOT(0);
    for (int m0 = gw; m0 < M; m0 += 4 * NGW) {
        f32x4 v[4][4];
#pragma unroll
        for (int k = 0; k < 4; ++k) { const int mk = m0 + k * NGW, m = mk < M ? mk : M - 1; const GAS f32x4* xr = (const GAS f32x4*)(x + (size_t)m * D) + F.lane;
#pragma unroll
            for (int j = 0; j < 4; ++j) v[k][j] = xr[64 * j]; }
#pragma unroll
        for (int k = 0; k < 4; ++k) { const int m = m0 + k * NGW; if (m < M) { float s = 0.f;
#pragma unroll
            for (int j = 0; j < 4; ++j) s += (v[k][j].x * v[k][j].x + v[k][j].y * v[k][j].y) + (v[k][j].z * v[k][j].z + v[k][j].w * v[k][j].w);
            s = wave_sum(s);
            GAS unsigned long long* o8 = (GAS unsigned long long*)(XB + (size_t)m * D) + F.lane;
#pragma unroll
            for (int j = 0; j < 4; ++j) o8[64 * j] = (unsigned long long)pk2(v[k][j].x, v[k][j].y) | ((unsigned long long)pk2(v[k][j].z, v[k][j].w) << 32);
            if (F.lane == 0) ssq[m] = pg8::ssq_fix(s); } }
    }
    {
        GAS v4u* z = OSP(v4u, OS_ZERO_BEGIN); const int gt = (F.vcu * NWAVES + F.wave) * 64 + F.lane, NT_ = F.G * NWAVES * 64;
        for (int i = gt; i < (int)(OS_ZERO_BYTES / 16); i += NT_) z[i] = v4u{0u, 0u, 0u, 0u}; }
}

__device__ __forceinline__ float dpp_add16(float v) {
    v += __builtin_bit_cast(float, __builtin_amdgcn_mov_dpp(__builtin_bit_cast(int, v), 0xB1, 0xF, 0xF, true));
    v += __builtin_bit_cast(float, __builtin_amdgcn_mov_dpp(__builtin_bit_cast(int, v), 0x4E, 0xF, 0xF, true));
    v += __builtin_bit_cast(float, __builtin_amdgcn_mov_dpp(__builtin_bit_cast(int, v), 0x141, 0xF, 0xF, true));
    v += __builtin_bit_cast(float, __builtin_amdgcn_mov_dpp(__builtin_bit_cast(int, v), 0x140, 0xF, 0xF, true));
    return v;
}
__device__ __forceinline__ float bflo(unsigned w) { return __builtin_bit_cast(float, w << 16); }
__device__ __forceinline__ float bfhi(unsigned w) { return __builtin_bit_cast(float, w & 0xffff0000u); }
__device__ __forceinline__ float bfel(const v4u v, int e) { const unsigned w = (e >> 1) == 0 ? v.x : (e >> 1) == 1 ? v.y : (e >> 1) == 2 ? v.z : v.w; return (e & 1) ? bfhi(w) : bflo(w); }
__device__ __forceinline__ void unpack8(const v4u v, float (&o)[8]) { o[0] = bflo(v.x); o[1] = bfhi(v.x); o[2] = bflo(v.y); o[3] = bfhi(v.y); o[4] = bflo(v.z); o[5] = bfhi(v.z); o[6] = bflo(v.w); o[7] = bfhi(v.w); }
constexpr int LO_PITCH = 528;
__device__ __forceinline__ void rwkv_lora_unit(Frame& F, int u) {
    const int tid = F.tid, lane = F.lane, w = F.wave, r16 = lane & 15, g4 = lane >> 4; LAS unsigned char* L = F.lds;
    const GAS bf16* PR = WSP(bf16, WS_PR); GAS bf16* RE = OSP(bf16, OS_RE); GAS bf16* RA = OSP(bf16, OS_RA); GAS bf16* Y = WSP(bf16, WS_Y);
    const GAS bf16* LW = WSP(bf16, WS_LW2); const GAS bf16* LA = WSP(bf16, WS_LA2); const GAS bf16* LG = WSP(bf16, WS_LG2);
    const GAS float* mu = inp(F, 10); const GAS float* w0 = inp(F, 11); const GAS float* a0 = inp(F, 13);
    const int m0 = u * 64;
    const int t = tid >> 3; const size_t row = (size_t)m0 + t; const bool hp = ((m0 + t) & (SEQ - 1)) != 0; const size_t rowp = hp ? row - 1 : row;
    __syncthreads();
    {
        const int c0 = (tid & 7) * 32; v4u cur[4], prv[4]; f32x4v mv[8];
#pragma unroll
        for (int q = 0; q < 4; ++q) { cur[q] = *(const GAS v4u*)(PR + row * RW_COLS + 1536 + c0 + 8 * q); prv[q] = *(const GAS v4u*)(PR + rowp * RW_COLS + 1536 + c0 + 8 * q); }
#pragma unroll
        for (int q = 0; q < 8; ++q) mv[q] = *(const GAS f32x4v*)(mu + 1536 + c0 + 4 * q);
        const bool isT = c0 < 64, isI = (c0 >= 64) && (c0 < 128); const float ka = isT ? 2.8853900817779268f : -1.4426950408889634f, aa = isT ? 1.0f : 0.f, bb = isT ? -2.0f : 1.0f;
#pragma unroll
        for (int q = 0; q < 4; ++q) { const int c = c0 + 8 * q; float cf[8], pf[8]; unpack8(cur[q], cf); unpack8(hp ? prv[q] : v4u{0u, 0u, 0u, 0u}, pf); float o[8];
#pragma unroll
            for (int e = 0; e < 8; ++e) { const float v = cf[e] + (pf[e] - cf[e]) * mv[2 * q + (e >> 2)][e & 3]; const float y = aa + bb * __builtin_amdgcn_rcpf(1.0f + __builtin_amdgcn_exp2f(ka * v)); o[e] = isI ? v : y; }
            *(LAS v4u*)(L + t * LO_PITCH + c * 2) = v4u{pk2(o[0], o[1]), pk2(o[2], o[3]), pk2(o[4], o[5]), pk2(o[6], o[7])}; } }
    {
        const int hh = tid & 7; const GAS float* k_k = inp(F, 16); GAS float* RN = OSP(float, OS_RN); float ss = 0.f;
#pragma unroll
        for (int hf = 0; hf < 2; ++hf) { v4u cur[4], prv[4]; f32x4v mk[8], kv[8]; const int cb = hh * 64 + 32 * hf;
#pragma unroll
            for (int q = 0; q < 4; ++q) { cur[q] = *(const GAS v4u*)(PR + row * RW_COLS + 512 + cb + 8 * q); prv[q] = *(const GAS v4u*)(PR + rowp * RW_COLS + 512 + cb + 8 * q); }
#pragma unroll
            for (int q = 0; q < 8; ++q) { mk[q] = *(const GAS f32x4v*)(mu + 512 + cb + 4 * q); kv[q] = *(const GAS f32x4v*)(k_k + cb + 4 * q); }
#pragma unroll
            for (int q = 0; q < 4; ++q)
#pragma unroll
                for (int e = 0; e < 8; ++e) { const float kc = bfel(cur[q], e), kp = hp ? bfel(prv[q], e) : 0.f; const float kk = (kc + (kp - kc) * mk[2 * q + (e >> 2)][e & 3]) * kv[2 * q + (e >> 2)][e & 3]; ss += kk * kk; } }
        RN[row * 8 + hh] = 1.0f / sqrtf(fmaxf(ss, 1e-24f)); }
    asm volatile("" ::: "memory");
#define LO_N(NTL) (64 * w + 32 * ((NTL) >> 1) + 8 * (r16 >> 2) + 4 * ((NTL) & 1) + (r16 & 3))
    bf16x8 bw[4][2], ba[4][2], bg[4][4]; f32x4v biw[4], bia[4];
#pragma unroll
    for (int ntl = 0; ntl < 4; ++ntl) { const int n = LO_N(ntl), n4 = 64 * w + 32 * (ntl >> 1) + 8 * g4 + 4 * (ntl & 1);
#pragma unroll
        for (int kk = 0; kk < 2; ++kk) { bw[ntl][kk] = *(const GAS bf16x8*)(LW + (size_t)n * 64 + 32 * kk + 8 * g4); ba[ntl][kk] = *(const GAS bf16x8*)(LA + (size_t)n * 64 + 32 * kk + 8 * g4); }
        biw[ntl] = *(const GAS f32x4v*)(w0 + n4); bia[ntl] = *(const GAS f32x4v*)(a0 + n4); }
    __syncthreads();
#define LO_PROD(KK, KOFF, BF, ...) do { _Pragma("unroll") for (int p = 0; p < 2; ++p) { const int c0 = 64 * w + 32 * p + 8 * g4; _Pragma("unroll") for (int mt = 0; mt < 4; ++mt) { f32x4v acc0 = f32x4v{0.f, 0.f, 0.f, 0.f}, acc1 = acc0; \
        _Pragma("unroll") for (int kk = 0; kk < (KK); ++kk) { const bf16x8 af = *(const LAS bf16x8*)(L + (16 * mt + r16) * LO_PITCH + ((KOFF) + 32 * kk + 8 * g4) * 2); \
            acc0 = __builtin_amdgcn_mfma_f32_16x16x32_bf16(BF[2 * p][kk], af, acc0, 0, 0, 0); acc1 = __builtin_amdgcn_mfma_f32_16x16x32_bf16(BF[2 * p + 1][kk], af, acc1, 0, 0, 0); } \
        const size_t orow = (size_t)m0 + 16 * mt + r16; __VA_ARGS__; } } } while (0)
    LO_PROD(2, 0, bw, { const f32x4v x = acc0 + biw[2 * p], y = acc1 + biw[2 * p + 1]; const float ce = 0.6065306597126334f;
        *(GAS v4u*)(RE + orow * 512 + c0) = v4u{pk2(ce * sigmf(x[0]), ce * sigmf(x[1])), pk2(ce * sigmf(x[2]), ce * sigmf(x[3])), pk2(ce * sigmf(y[0]), ce * sigmf(y[1])), pk2(ce * sigmf(y[2]), ce * sigmf(y[3]))}; });
#pragma unroll
    for (int ntl = 0; ntl < 2; ++ntl) { const int n = LO_N(ntl);
#pragma unroll
        for (int kk = 0; kk < 4; ++kk) bg[ntl][kk] = *(const GAS bf16x8*)(LG + (size_t)n * 128 + 32 * kk + 8 * g4); }
    LO_PROD(2, 64, ba, { const f32x4v x = acc0 + bia[2 * p], y = acc1 + bia[2 * p + 1];
        *(GAS v4u*)(RA + orow * 512 + c0) = v4u{pk2(sigmf(x[0]), sigmf(x[1])), pk2(sigmf(x[2]), sigmf(x[3])), pk2(sigmf(y[0]), sigmf(y[1])), pk2(sigmf(y[2]), sigmf(y[3]))}; });
#pragma unroll
    for (int ntl = 2; ntl < 4; ++ntl) { const int n = LO_N(ntl);
#pragma unroll
        for (int kk = 0; kk < 4; ++kk) bg[ntl][kk] = *(const GAS bf16x8*)(LG + (size_t)n * 128 + 32 * kk + 8 * g4); }
    LO_PROD(4, 128, bg, { *(GAS v4u*)(Y + orow * 1024 + c0) = v4u{pk2(acc0[0], acc0[1]), pk2(acc0[2], acc0[3]), pk2(acc1[0], acc1[1]), pk2(acc1[2], acc1[3])}; });
#undef LO_PROD
#undef LO_N
}
constexpr int GR_P = 128, GR_BUF = 32 * GR_P, GR_AF = 0, GR_AP = 36, GR_WAVE = 4 * GR_BUF;
static_assert(8 * GR_WAVE <= RING_BYTES && 32 * GR_AP * 4 <= 3 * 2560 + 4608 && 3 * 2560 <= GR_WAVE && GR_AP % 4 == 0, "gram LDS");
__device__ __forceinline__ void rwkv_gram_phase(Frame& F) {
    const int lane = F.lane, r16 = lane & 15, g4 = lane >> 4; LAS unsigned char* Lw = F.lds + F.wave * GR_WAVE; LAS float* Af = (LAS float*)(Lw + GR_AF);
    const GAS bf16* PR = WSP(bf16, WS_PR); const GAS bf16* RE = OSP(bf16, OS_RE); const GAS bf16* RA = OSP(bf16, OS_RA); const GAS float* RN = OSP(float, OS_RN); GAS v4u* GM = WSP(v4u, WS_GM); GAS float* WCg = OSP(float, OS_WC);
    GAS bf16* IKH = OSP(bf16, OS_IKH); GAS bf16* IRH = OSP(bf16, OS_IRH); GAS bf16* IAH = WSP(bf16, WS_IAH);
    const GAS float* mu = inp(F, 10); const GAS float* k_k = inp(F, 16); const GAS float* k_a = inp(F, 17);
    const int gw = F.vcu * NWAVES + F.wave, NGW = F.G * NWAVES;
    for (int u = gw; u < 64 * 64; u += NGW) { const int bh = u >> 6, c = u & 63, b = bh >> 3, h = bh & 7, gc = h * 64 + lane; const size_t row0 = (size_t)b * SEQ + c * 32;
        const float mr = mu[gc], mk = mu[512 + gc], ckk = k_k[gc], cka = k_a[gc];
        bf16x8 fKh[2][2], fAh[2][2], fKt[2][2], fRh[2][2];
        {
            const size_t rowp = (c > 0) ? row0 - 1 : row0; const unsigned short rp_ = PR[rowp * RW_COLS + gc], kp_ = PR[rowp * RW_COLS + 512 + gc];
            const float rnl = RN[(row0 + (lane & 31)) * 8 + h];
            float cs = 0.f, rprev, kprev;
            {
                v4u raw[16]; const int t8 = lane >> 3, c8 = (lane & 7) * 8;
#pragma unroll
                for (int q = 0; q < 16; ++q) { const int a_ = q >> 2; const size_t row = row0 + 8 * (q & 3) + t8;
                    const GAS bf16* src = (a_ == 0) ? PR + row * RW_COLS + h * 64 : (a_ == 1) ? PR + row * RW_COLS + 512 + h * 64 : (a_ == 2) ? RE + row * 512 + h * 64 : RA + row * 512 + h * 64;
                    raw[q] = *(const GAS v4u*)(src + c8); }
#pragma unroll
                for (int q = 0; q < 16; ++q) *(LAS v4u*)(Lw + (q >> 2) * GR_BUF + (8 * (q & 3) + t8) * GR_P + c8 * 2) = raw[q];
                asm volatile("s_waitcnt lgkmcnt(0)" ::: "memory"); }
            rprev = (c > 0) ? bf2f(rp_) : 0.f; kprev = (c > 0) ? bf2f(kp_) : 0.f;
#pragma unroll 1
            for (int tb = 0; tb < 32; tb += 8) {
#pragma unroll
                for (int i = 0; i < 8; ++i) { const int t = tb + i; LAS unsigned char* im = Lw + t * GR_P + lane * 2;
                    const float rc = bf2f(*(const LAS unsigned short*)(im)), kc = bf2f(*(const LAS unsigned short*)(im + GR_BUF)), e = bf2f(*(const LAS unsigned short*)(im + 2 * GR_BUF)), a = bf2f(*(const LAS unsigned short*)(im + 3 * GR_BUF));
                    const float r = rc + (rprev - rc) * mr, kx = kc + (kprev - kc) * mk; rprev = rc; kprev = kc;
                    const float kk = kx * ckk * __builtin_bit_cast(float, __builtin_amdgcn_readlane(__builtin_bit_cast(int, rnl), t));
                    const float wm = __expf(-cs); cs += e; const float wt = __expf(-cs), iw = __builtin_amdgcn_rcpf(wt);
                    if (t == 31) WCg[(size_t)u * 64 + lane] = wt;
                    *(LAS unsigned short*)(im) = (unsigned short)f2bf(kk * wm); *(LAS unsigned short*)(im + GR_BUF) = (unsigned short)f2bf(kk * a * iw);
                    *(LAS unsigned short*)(im + 2 * GR_BUF) = (unsigned short)f2bf(kx * (1.0f + (a - 1.0f) * cka) * iw); *(LAS unsigned short*)(im + 3 * GR_BUF) = (unsigned short)f2bf(r * wt); }
            }
            asm volatile("s_waitcnt lgkmcnt(0)" ::: "memory");
#pragma unroll
            for (int mt = 0; mt < 2; ++mt)
#pragma unroll
                for (int kk2 = 0; kk2 < 2; ++kk2) { const LAS unsigned char* fp = Lw + (16 * mt + r16) * GR_P + (32 * kk2 + 8 * g4) * 2;
                    fKh[mt][kk2] = *(const LAS bf16x8*)(fp); fAh[mt][kk2] = *(const LAS bf16x8*)(fp + GR_BUF); fKt[mt][kk2] = *(const LAS bf16x8*)(fp + 2 * GR_BUF); fRh[mt][kk2] = *(const LAS bf16x8*)(fp + 3 * GR_BUF); }
            asm volatile("s_waitcnt lgkmcnt(0)" ::: "memory");
            {
                GAS bf16* IKT = (b < 5) ? WSP(bf16, WS_IKT_LO) : WSP(bf16, WS_IKT_HI); const int tq = lane >> 3, k8 = (lane & 7) * 8;
#pragma unroll 1
                for (int q = 0; q < 4; ++q) { const int t = q * 8 + tq; const LAS unsigned char* ip = Lw + t * GR_P + k8 * 2; const size_t go = (row0 + t) * 512 + h * 64 + k8;
                    const v4u i0 = *(const LAS v4u*)(ip), i1 = *(const LAS v4u*)(ip + GR_BUF), i2 = *(const LAS v4u*)(ip + 2 * GR_BUF), i3 = *(const LAS v4u*)(ip + 3 * GR_BUF);
                    *(GAS v4u*)(IKH + go) = i0; *(GAS v4u*)(IAH + go) = i1; *(GAS v4u*)(IKT + go) = i2; *(GAS v4u*)(IRH + go) = i3; }
                asm volatile("s_waitcnt lgkmcnt(0)" ::: "memory"); }
        }
        f32x4v gA[2][2], gB[2][2], gRA[2][2], gRK[2][2];
#pragma unroll
        for (int mt = 0; mt < 2; ++mt)
#pragma unroll
            for (int st = 0; st < 2; ++st) { f32x4v z = f32x4v{0.f, 0.f, 0.f, 0.f}; gA[mt][st] = z; gB[mt][st] = z; gRA[mt][st] = z; gRK[mt][st] = z;
#pragma unroll
                for (int kk = 0; kk < 2; ++kk) { gA[mt][st] = __builtin_amdgcn_mfma_f32_16x16x32_bf16(fKh[mt][kk], fAh[st][kk], gA[mt][st], 0, 0, 0); gB[mt][st] = __builtin_amdgcn_mfma_f32_16x16x32_bf16(fKh[mt][kk], fKt[st][kk], gB[mt][st], 0, 0, 0);
                    gRA[mt][st] = __builtin_amdgcn_mfma_f32_16x16x32_bf16(fRh[mt][kk], fAh[st][kk], gRA[mt][st], 0, 0, 0); gRK[mt][st] = __builtin_amdgcn_mfma_f32_16x16x32_bf16(fRh[mt][kk], fKt[st][kk], gRK[mt][st], 0, 0, 0); } }
#pragma unroll
        for (int mt = 0; mt < 2; ++mt)
#pragma unroll
            for (int st = 0; st < 2; ++st)
#pragma unroll
                for (int rg = 0; rg < 4; ++rg) { const int t = 16 * mt + 4 * g4 + rg, s_ = 16 * st + r16; Af[t * GR_AP + s_] = (s_ < t) ? gA[mt][st][rg] : 0.f; }
        asm volatile("s_waitcnt lgkmcnt(0)" ::: "memory");
        float Tc[32]; const int j = lane & 31;
#pragma unroll
        for (int t = 0; t < 32; ++t) { float acc[4] = {(t == j) ? 1.0f : 0.f, 0.f, 0.f, 0.f};
#pragma unroll
            for (int s4 = 0; s4 < (t + 3) / 4; ++s4) { const f32x4v a4 = *(const LAS f32x4v*)(Af + t * GR_AP + 4 * s4);
#pragma unroll
                for (int e = 0; e < 4; ++e) if (4 * s4 + e < t) acc[e] -= a4[e] * Tc[4 * s4 + e]; }
            Tc[t] = (acc[0] + acc[1]) + (acc[2] + acc[3]); }
        LAS unsigned char* I0 = Lw, * I1 = Lw + 2560, * I2 = Lw + 5120;
        if (lane < 32) {
#pragma unroll
            for (int t = 0; t < 32; ++t) *(LAS unsigned short*)(I0 + t * 80 + j * 2) = (unsigned short)f2bf(Tc[t]); }
#define GR_CW(IMG, G, STRICT) do { _Pragma("unroll") for (int mt = 0; mt < 2; ++mt) _Pragma("unroll") for (int st = 0; st < 2; ++st) _Pragma("unroll") for (int rg = 0; rg < 4; ++rg) { const int t = 16 * mt + 4 * g4 + rg, s_ = 16 * st + r16; \
            *(LAS unsigned short*)(IMG + t * 80 + s_ * 2) = (unsigned short)f2bf(((STRICT) ? (s_ < t) : (s_ <= t)) ? G[mt][st][rg] : 0.f); } } while (0)
        GR_CW(I1, gB, true); GR_CW(I2, gRA, false);
        asm volatile("s_waitcnt lgkmcnt(0)" ::: "memory");
        GAS v4u* gm = GM + (size_t)u * 512 + lane;
#pragma unroll
        for (int mt = 0; mt < 2; ++mt) { const LAS unsigned char* rT = I0 + (16 * mt + r16) * 80, * rB = I1 + (16 * mt + r16) * 80, * rR = I2 + (16 * mt + r16) * 80;
            const v2u t0 = *(const LAS v2u*)(rT + (4 * g4) * 2), t1 = *(const LAS v2u*)(rT + (16 + 4 * g4) * 2); gm[(0 * 2 + mt) * 64] = v4u{t0.x, t0.y, t1.x, t1.y};
            gm[(1 * 2 + mt) * 64] = *(const LAS v4u*)(rB + (8 * g4) * 2);
            const v2u a0 = *(const LAS v2u*)(rR + (4 * g4) * 2), a1 = *(const LAS v2u*)(rR + (16 + 4 * g4) * 2); gm[(2 * 2 + mt) * 64] = v4u{a0.x, a0.y, a1.x, a1.y}; }
        asm volatile("s_waitcnt lgkmcnt(0)" ::: "memory");
        GR_CW(I0, gRK, false);
        asm volatile("s_waitcnt lgkmcnt(0)" ::: "memory");
#pragma unroll
        for (int mt = 0; mt < 2; ++mt) gm[(3 * 2 + mt) * 64] = *(const LAS v4u*)(I0 + (16 * mt + r16) * 80 + (8 * g4) * 2);
        asm volatile("s_waitcnt lgkmcnt(0)" ::: "memory");
#undef GR_CW
    }
}
constexpr int CS_KH = 0, CS_RH = CS_KH + 32 * 144, CS_AT = CS_RH + 32 * 144, CS_KT = CS_AT + 64 * 80, CS_VT = CS_KT + 64 * 80, CS_WC = CS_VT + 16 * 80, CS_YR = CS_WC + 256, CS_BUF = CS_YR + 32 * 16 * 4;
static_assert(2 * CS_BUF <= RING_BYTES && CS_AT % 16 == 0 && CS_VT % 16 == 0 && CS_WC % 16 == 0 && CS_YR % 16 == 0 && CS_BUF % 16 == 0, "chunk scan LDS");
__device__ __forceinline__ bf16x8 pack8(const f32x4v a, const f32x4v b) { const v4u w = v4u{pk2(a[0], a[1]), pk2(a[2], a[3]), pk2(b[0], b[1]), pk2(b[2], b[3])}; return __builtin_bit_cast(bf16x8, w); }
__device__ __forceinline__ bf16x8 cat8(const v2u a, const v2u b) { const v4u w = v4u{a.x, a.y, b.x, b.y}; return __builtin_bit_cast(bf16x8, w); }
template <bool DRY = false, bool NOPROD = false> __device__ __forceinline__ void rwkv_cscan_unit(Frame& F, int u) {
    const int tid = F.tid, lane = F.lane, w = F.wave, r16 = lane & 15, g4 = lane >> 4; LAS unsigned char* L = F.lds;
    const int ch = u >> 2, rg = u & 3, b = ch >> 3, h = ch & 7; const size_t rowbase = (size_t)b * SEQ;
    const GAS bf16* PR = WSP(bf16, WS_PR); const GAS v4u* GM = WSP(v4u, WS_GM); GAS bf16* YRAW = WSP(bf16, WS_YRAW); GAS long long* RST = OSP(long long, OS_RST);
    const GAS float* WCg = OSP(float, OS_WC); const GAS bf16* IKH = OSP(bf16, OS_IKH); const GAS bf16* IRH = OSP(bf16, OS_IRH); const GAS bf16* IAH = WSP(bf16, WS_IAH);
    const GAS bf16* IKT = (b < 5) ? WSP(bf16, WS_IKT_LO) : WSP(bf16, WS_IKT_HI);
#define CS_T16(DST, V, C8, T_) do { _Pragma("unroll") for (int e = 0; e < 8; ++e) *(LAS unsigned short*)((DST) + ((C8) + e) * 80 + (T_) * 2) = (unsigned short)(((V)[e >> 1]) >> (16 * (e & 1))); } while (0)
#define CS_CL(CC) ((CC) < 63 ? (CC) : 63)
#define CS_FLUSH(CC) do { const int t0f_ = (CC) * 32; const LAS float* yr_ = (const LAS float*)(L + ((CC) & 1) * CS_BUF + CS_YR); \
        { const int t_ = lane >> 1, hf_ = lane & 1; const LAS float* p_ = yr_ + t_ * 16 + hf_ * 8; const f32x4v a_ = *(const LAS f32x4v*)p_, b_ = *(const LAS f32x4v*)(p_ + 4); \
            *(GAS v4u*)(YRAW + (rowbase + t0f_ + t_) * 512 + h * 64 + rg * 16 + hf_ * 8) = v4u{pk2(a_[0], a_[1]), pk2(a_[2], a_[3]), pk2(b_[0], b_[1]), pk2(b_[2], b_[3])}; \
            float s1_ = (a_[0] + a_[1]) + (a_[2] + a_[3]) + (b_[0] + b_[1]) + (b_[2] + b_[3]); float s2_ = (a_[0] * a_[0] + a_[1] * a_[1]) + (a_[2] * a_[2] + a_[3] * a_[3]) + (b_[0] * b_[0] + b_[1] * b_[1]) + (b_[2] * b_[2] + b_[3] * b_[3]); \
            s1_ += __shfl_xor(s1_, 1); s2_ += __shfl_xor(s2_, 1); \
            if (hf_ == 0 && !DRY) { GAS long long* st_ = RST + ((rowbase + t0f_ + t_) * 8 + h) * 2; __hip_atomic_fetch_add(st_, fx20(s1_), __ATOMIC_RELAXED, __HIP_MEMORY_SCOPE_AGENT); __hip_atomic_fetch_add(st_ + 1, fx20(s2_), __ATOMIC_RELAXED, __HIP_MEMORY_SCOPE_AGENT); } } \
    } while (0)
    __syncthreads();
    if (w == 0) {
        f32x4v S[4]; S[0] = f32x4v{0.f, 0.f, 0.f, 0.f}; S[1] = S[0]; S[2] = S[0]; S[3] = S[0];
        v4u gTa[2], gBa[2], gRAa[2], gRKa[2];
#define CS_GM(CC, G) do { const GAS v4u* gm_ = GM + ((size_t)ch * 64 + (CC)) * 512 + lane; gT##G[0] = gm_[0]; gT##G[1] = gm_[64]; gB##G[0] = gm_[128]; gB##G[1] = gm_[192]; gRA##G[0] = gm_[256]; gRA##G[1] = gm_[320]; gRK##G[0] = gm_[384]; gRK##G[1] = gm_[448]; } while (0)
        CS_GM(0, a);
        LDS_BARRIER();
#define CS_CONS(c, G) do { \
            const LAS unsigned char* B = L + ((c) & 1) * CS_BUF; \
            const bf16x8 fT0 = __builtin_bit_cast(bf16x8, gT##G[0]), fT1 = __builtin_bit_cast(bf16x8, gT##G[1]), fB0 = __builtin_bit_cast(bf16x8, gB##G[0]), fB1 = __builtin_bit_cast(bf16x8, gB##G[1]); \
            const bf16x8 fRA0 = __builtin_bit_cast(bf16x8, gRA##G[0]), fRA1 = __builtin_bit_cast(bf16x8, gRA##G[1]), fRK0 = __builtin_bit_cast(bf16x8, gRK##G[0]), fRK1 = __builtin_bit_cast(bf16x8, gRK##G[1]); \
            CS_GM(CS_CL((c) + 1), G); \
            const bf16x8 sB0 = pack8(S[0], S[1]), sB1 = pack8(S[2], S[3]); \
            const bf16x8 vB = *(const LAS bf16x8*)(B + CS_VT + r16 * 80 + 16 * g4); \
            f32x4v X[2], Y[2]; \
            _Pragma("unroll") \
            for (int mt = 0; mt < 2; ++mt) { const LAS unsigned char* kr = B + CS_KH + (16 * mt + r16) * 144 + 8 * g4; const LAS unsigned char* rr = B + CS_RH + (16 * mt + r16) * 144 + 8 * g4; \
                const bf16x8 k0 = cat8(*(const LAS v2u*)(kr), *(const LAS v2u*)(kr + 32)), k1 = cat8(*(const LAS v2u*)(kr + 64), *(const LAS v2u*)(kr + 96)); \
                const bf16x8 q0 = cat8(*(const LAS v2u*)(rr), *(const LAS v2u*)(rr + 32)), q1 = cat8(*(const LAS v2u*)(rr + 64), *(const LAS v2u*)(rr + 96)); \
                f32x4v x = f32x4v{0.f, 0.f, 0.f, 0.f}; x = __builtin_amdgcn_mfma_f32_16x16x32_bf16(k0, sB0, x, 0, 0, 0); x = __builtin_amdgcn_mfma_f32_16x16x32_bf16(k1, sB1, x, 0, 0, 0); \
                X[mt] = __builtin_amdgcn_mfma_f32_16x16x32_bf16(mt ? fB1 : fB0, vB, x, 0, 0, 0); \
                f32x4v y = f32x4v{0.f, 0.f, 0.f, 0.f}; y = __builtin_amdgcn_mfma_f32_16x16x32_bf16(q0, sB0, y, 0, 0, 0); y = __builtin_amdgcn_mfma_f32_16x16x32_bf16(q1, sB1, y, 0, 0, 0); \
                Y[mt] = __builtin_amdgcn_mfma_f32_16x16x32_bf16(mt ? fRK1 : fRK0, vB, y, 0, 0, 0); } \
            const bf16x8 xB = pack8(X[0], X[1]); \
            const f32x4v z = f32x4v{0.f, 0.f, 0.f, 0.f}; \
            const f32x4v U0 = -__builtin_amdgcn_mfma_f32_16x16x32_bf16(fT0, xB, z, 0, 0, 0), U1 = -__builtin_amdgcn_mfma_f32_16x16x32_bf16(fT1, xB, z, 0, 0, 0); \
            const bf16x8 uB = pack8(U0, U1); \
            Y[0] = __builtin_amdgcn_mfma_f32_16x16x32_bf16(fRA0, uB, Y[0], 0, 0, 0); Y[1] = __builtin_amdgcn_mfma_f32_16x16x32_bf16(fRA1, uB, Y[1], 0, 0, 0); \
            _Pragma("unroll") \
            for (int kt = 0; kt < 4; ++kt) { const LAS unsigned char* ar = B + CS_AT + (16 * kt + r16) * 80 + 8 * g4; const bf16x8 af = cat8(*(const LAS v2u*)(ar), *(const LAS v2u*)(ar + 32)); \
                const bf16x8 kf = *(const LAS bf16x8*)(B + CS_KT + (16 * kt + r16) * 80 + 16 * g4); const f32x4v wc = *(const LAS f32x4v*)(B + CS_WC + (16 * kt + 4 * g4) * 4); \
                f32x4v acc = __builtin_amdgcn_mfma_f32_16x16x32_bf16(af, uB, S[kt], 0, 0, 0); acc = __builtin_amdgcn_mfma_f32_16x16x32_bf16(kf, vB, acc, 0, 0, 0); S[kt] = acc * wc; } \
            LAS float* yr = (LAS float*)(L + ((c) & 1) * CS_BUF + CS_YR); \
            _Pragma("unroll") \
            for (int mt = 0; mt < 2; ++mt) \
            _Pragma("unroll") \
                for (int rg_ = 0; rg_ < 4; ++rg_) yr[(16 * mt + 4 * g4 + rg_) * 16 + r16] = Y[mt][rg_]; \
        LDS_BARRIER(); \
    } while (0)
#pragma unroll 1
        for (int c2 = 0; c2 < 64; c2 += 2) { CS_CONS(c2, a); CS_CONS(c2 + 1, a); }
#undef CS_CONS
#undef CS_GM
    } else if (w == 1) {
        LDS_BARRIER();
#pragma unroll 1
        for (int c = 0; c < 64; ++c) { if (c >= 1) CS_FLUSH(c - 1); LDS_BARRIER(); }
        CS_FLUSH(63);
    } else if (w == 2) {
        const int t8 = lane >> 3, c8 = (lane & 7) * 8; const GAS bf16* src = IKT + (rowbase + t8) * 512 + h * 64 + c8; v4u qa[4], qb[4];
#define CS_LOAD(CC, Q) do { const GAS bf16* p_ = src + (size_t)CS_CL(CC) * (32 * 512); _Pragma("unroll") for (int it_ = 0; it_ < 4; ++it_) q##Q[it_] = *(const GAS v4u*)(p_ + it_ * (8 * 512)); } while (0)
#define CS_PREP(CC, Q) do { LAS unsigned char* B_ = L + ((CC) & 1) * CS_BUF; _Pragma("unroll") for (int it_ = 0; it_ < 4; ++it_) CS_T16(B_ + CS_KT, q##Q[it_], c8, 8 * it_ + t8); } while (0)
#define CS_PROD(c, Q) do { if (!NOPROD) { CS_PREP((c) + 1, Q); CS_LOAD((c) + 3, Q); } LDS_BARRIER(); } while (0)
        CS_LOAD(0, a); CS_PREP(0, a); CS_LOAD(1, b); CS_LOAD(2, a);
        LDS_BARRIER();
#pragma unroll 1
        for (int c2 = 0; c2 < 64; c2 += 2) { CS_PROD(c2, b); CS_PROD(c2 + 1, a); }
#undef CS_LOAD
#undef CS_PREP
    } else if (w == 3) {
        const int t_ = lane >> 1, hf = (lane & 1) * 8, vcol = h * 64 + rg * 16 + hf; const GAS float* mu = inp(F, 10); float cB[8];
#pragma unroll
        for (int e = 0; e < 8; ++e) cB[e] = mu[1024 + vcol + e];
        const GAS bf16* src = PR + (rowbase + t_) * RW_COLS + 1024 + vcol; v4u qa[2], qb[2];
#define CS_LOAD(CC, Q) do { const GAS bf16* p_ = src + (size_t)CS_CL(CC) * (32 * RW_COLS); q##Q[0] = *(const GAS v4u*)(p_); q##Q[1] = *(const GAS v4u*)(p_ - ((CS_CL(CC) * 32 + t_ > 0) ? RW_COLS : 0)); } while (0)
#define CS_PREP(CC, Q) do { LAS unsigned char* B_ = L + ((CC) & 1) * CS_BUF; const bool first_ = ((CC) * 32 + t_ == 0); \
            _Pragma("unroll") for (int e = 0; e < 8; ++e) { const float vc_ = bfel(q##Q[0], e), vp_ = first_ ? 0.f : bfel(q##Q[1], e); *(LAS unsigned short*)(B_ + CS_VT + (hf + e) * 80 + t_ * 2) = (unsigned short)f2bf(vc_ + (vp_ - vc_) * cB[e]); } } while (0)
        CS_LOAD(0, a); CS_PREP(0, a); CS_LOAD(1, b); CS_LOAD(2, a);
        LDS_BARRIER();
#pragma unroll 1
        for (int c2 = 0; c2 < 64; c2 += 2) { CS_PROD(c2, b); CS_PROD(c2 + 1, a); }
#undef CS_LOAD
#undef CS_PREP
    } else {
        const int ptid = tid & 255, pt = ptid >> 3, c8 = (ptid & 7) * 8; const size_t o0 = (rowbase + pt) * 512 + h * 64 + c8; const GAS float* wsrc = WCg + (size_t)ch * 64 * 64 + (ptid & 63);
        v4u qa[3], qb[3]; float qwa, qwb;
#define CS_LOAD(CC, Q) do { const size_t o_ = o0 + (size_t)CS_CL(CC) * (32 * 512); q##Q[0] = *(const GAS v4u*)(IKH + o_); q##Q[1] = *(const GAS v4u*)(IRH + o_); q##Q[2] = *(const GAS v4u*)(IAH + o_); qw##Q = wsrc[CS_CL(CC) * 64]; } while (0)
#define CS_PREP(CC, Q) do { LAS unsigned char* B_ = L + ((CC) & 1) * CS_BUF; *(LAS v4u*)(B_ + CS_KH + pt * 144 + c8 * 2) = q##Q[0]; *(LAS v4u*)(B_ + CS_RH + pt * 144 + c8 * 2) = q##Q[1]; CS_T16(B_ + CS_AT, q##Q[2], c8, pt); \
            if (ptid < 64) *(LAS float*)(B_ + CS_WC + ptid * 4) = qw##Q; } while (0)
        CS_LOAD(0, a); CS_PREP(0, a); CS_LOAD(1, b); CS_LOAD(2, a);
        LDS_BARRIER();
#pragma unroll 1
        for (int c2 = 0; c2 < 64; c2 += 2) { CS_PROD(c2, b); CS_PROD(c2 + 1, a); }
#undef CS_LOAD
#undef CS_PREP
#undef CS_PROD
    }
#undef CS_FLUSH
#undef CS_T16
#undef CS_CL
}
template <bool DRY = false, bool NOPROD = false> __device__ __forceinline__ void rwkv_cscan_phase(Frame& F) {
    for (int u = F.vcu; u < 256; u += F.G) rwkv_cscan_unit<DRY, NOPROD>(F, u);
}
__device__ __forceinline__ void rwkv_post_phase(Frame& F) {
    const int gw = F.vcu * NWAVES + F.wave, NGW = F.G * NWAVES, lane = F.lane, c = lane * 8, hh = lane >> 3;
    const GAS bf16* PR = WSP(bf16, WS_PR); const GAS bf16* RA = OSP(bf16, OS_RA); const GAS bf16* YRAW = WSP(bf16, WS_YRAW); const GAS long long* RST = OSP(long long, OS_RST); GAS bf16* Y = WSP(bf16, WS_Y);
    const GAS float* mu = inp(F, 10); const GAS float* k_a = inp(F, 17); const GAS float* r_k = inp(F, 18); const GAS float* lnw = inp(F, 19); const GAS float* lnb = inp(F, 20);
    float mur[8], muk[8], muv[8], cka[8], crk[8], clw[8], clb[8];
#pragma unroll
    for (int e = 0; e < 8; ++e) { mur[e] = mu[c + e]; muk[e] = mu[512 + c + e]; muv[e] = mu[1024 + c + e]; cka[e] = k_a[c + e]; crk[e] = r_k[c + e]; clw[e] = lnw[c + e]; clb[e] = lnb[c + e]; }
    for (int m0 = gw; m0 < M; m0 += 2 * NGW) {
        v4u rc_[2], kc_[2], vc_[2], rp_[2], kp_[2], vp_[2], av_[2], gv_[2], yv_[2]; long long s1_[2], s2_[2];
#pragma unroll
        for (int k = 0; k < 2; ++k) { const int mk = m0 + k * NGW, m = mk < M ? mk : M - 1; const size_t row = (size_t)m, rowp = (m & (SEQ - 1)) != 0 ? row - 1 : row;
            rc_[k] = *(const GAS v4u*)(PR + row * RW_COLS + c); kc_[k] = *(const GAS v4u*)(PR + row * RW_COLS + 512 + c); vc_[k] = *(const GAS v4u*)(PR + row * RW_COLS + 1024 + c);
            rp_[k] = *(const GAS v4u*)(PR + rowp * RW_COLS + c); kp_[k] = *(const GAS v4u*)(PR + rowp * RW_COLS + 512 + c); vp_[k] = *(const GAS v4u*)(PR + rowp * RW_COLS + 1024 + c);
            av_[k] = *(const GAS v4u*)(RA + row * 512 + c); gv_[k] = *(const GAS v4u*)(Y + row * 1024 + c); yv_[k] = *(const GAS v4u*)(YRAW + row * 512 + c);
            s1_[k] = RST[(row * 8 + hh) * 2]; s2_[k] = RST[(row * 8 + hh) * 2 + 1]; }
#pragma unroll
        for (int k = 0; k < 2; ++k) { const int m = m0 + k * NGW; if (m < M) { const size_t row = (size_t)m; const bool hp = (m & (SEQ - 1)) != 0; const v4u z = v4u{0u, 0u, 0u, 0u};
            float rc[8], rp[8], kc[8], kp[8], vc[8], vp[8], aa[8], gg[8], yy[8]; unpack8(rc_[k], rc); unpack8(hp ? rp_[k] : z, rp); unpack8(kc_[k], kc); unpack8(hp ? kp_[k] : z, kp); unpack8(vc_[k], vc); unpack8(hp ? vp_[k] : z, vp); unpack8(av_[k], aa); unpack8(gv_[k], gg); unpack8(yv_[k], yy);
            float vs[8]; float bon = 0.f;
#pragma unroll
            for (int e = 0; e < 8; ++e) { const float r = rc[e] + (rp[e] - rc[e]) * mur[e], kx = kc[e] + (kp[e] - kc[e]) * muk[e]; vs[e] = vc[e] + (vp[e] - vc[e]) * muv[e]; bon += r * (kx * (1.0f + (aa[e] - 1.0f) * cka[e])) * crk[e]; }
            bon += __shfl_xor(bon, 1); bon += __shfl_xor(bon, 2); bon += __shfl_xor(bon, 4);
            const float s1 = unfx20(s1_[k]), s2 = unfx20(s2_[k]); const float mean = s1 * (1.0f / 64.0f), var = fmaxf(s2 * (1.0f / 64.0f) - mean * mean, 0.f), rs = __builtin_amdgcn_rsqf(var + 64e-5f);
            float o[8];
#pragma unroll
            for (int e = 0; e < 8; ++e) o[e] = ((yy[e] - mean) * rs * clw[e] + clb[e] + bon * vs[e]) * gg[e];
            *(GAS v4u*)(Y + row * 1024 + c) = v4u{pk2(o[0], o[1]), pk2(o[2], o[3]), pk2(o[4], o[5]), pk2(o[6], o[7])}; } }
    }
}
__device__ __forceinline__ void lora_kmean_phase(Frame& F) {
    for (int u = F.vcu; u < 256; u += F.G) rwkv_lora_unit(F, u);
}

__device__ __forceinline__ int crow(int r, int hi) { return (r & 3) + 8 * (r >> 2) + 4 * hi; }
constexpr int MO_ROWB = 144;
constexpr int MO_BUF = 2 * 64 * MO_ROWB;
constexpr int MO_KM = 40960;
static_assert(2 * MO_BUF <= MO_KM && MO_KM + 2048 <= RING_BYTES, "MoBA LDS");
__device__ __forceinline__ void moba_unit(Frame& F, int b, int h, int qb) {
    const int tid = F.tid, lane = F.lane, wid = F.wave, r32 = lane & 31, hi = lane >> 5;
    const GAS bf16* QB = WSP(bf16, WS_QB); const GAS bf16* KB = WSP(bf16, WS_KB); const GAS bf16* VB = WSP(bf16, WS_VB); GAS bf16* Y = WSP(bf16, WS_Y); const GAS float* km = WSP(float, WS_KMEAN);
    const size_t rowbase = (size_t)b * SEQ; const int qpos = qb * 256 + wid * 32 + r32; const float NEG = -INFINITY;
    bf16x8 qr[4]; { const GAS bf16* qp = QB + (rowbase + qpos) * 512 + h * 64 + hi * 8;
#pragma unroll
        for (int d0 = 0; d0 < 4; ++d0) qr[d0] = *(const GAS bf16x8*)(qp + d0 * 16); }
    unsigned sel = 0u;
    if (qb > 0) {
        LAS float* KM = (LAS float*)(F.lds + MO_KM);
        __syncthreads();
        KM[tid] = km[(size_t)(b * 8 + h) * 8 * 64 + tid];
        __syncthreads();
        float gate[7];
#pragma unroll
        for (int n = 0; n < 7; ++n) { float g = 0.f;
            if (n < qb) { const LAS float* kp = KM + n * 64 + hi * 8;
#pragma unroll
                for (int d0 = 0; d0 < 4; ++d0) { const f32x4v k0 = *(const LAS f32x4v*)(kp + d0 * 16), k1 = *(const LAS f32x4v*)(kp + d0 * 16 + 4);
#pragma unroll
                    for (int j = 0; j < 4; ++j) { g += bf2f((bf16)qr[d0][j]) * k0[j]; g += bf2f((bf16)qr[d0][4 + j]) * k1[j]; } }
                g += __shfl_xor(g, 32); }
            gate[n] = (n < qb) ? g : NEG; }
        const int nsel = qb < 3 ? qb : 3;
#pragma unroll
        for (int s = 0; s < 3; ++s) { int best = 0; float bv = NEG; bool have = false;
#pragma unroll
            for (int n = 0; n < 7; ++n) { const bool ok = (n < qb) && !((sel >> n) & 1u) && (!have || gate[n] > bv); if (ok) { best = n; bv = gate[n]; have = true; } }
            if (s < nsel) sel |= 1u << best; }
    }
    const float C2 = 0.125f * 1.4426950408889634f, sl2 = exp2f(-(float)(h + 1)) * 1.4426950408889634f;
    const int NT = 4 * (qb + 1);
    f32x16 abias[2];
#pragma unroll
    for (int kb = 0; kb < 2; ++kb)
#pragma unroll
        for (int r = 0; r < 16; ++r) abias[kb][r] = sl2 * (float)(32 * kb + crow(r, hi));
    const GAS bf16* kg = KB + (rowbase + (tid >> 3)) * 512 + h * 64 + (tid & 7) * 8; const GAS bf16* vg = VB + (rowbase + lane) * 512 + h * 64 + wid * 8;
    const int kdst = (tid >> 3) * MO_ROWB + (tid & 7) * 16, vdst = 64 * MO_ROWB + (wid * 8) * MO_ROWB + lane * 2;
    f32x16 o[2]; o[0] = f32x16{}; o[1] = f32x16{}; float mrun = NEG, lrun = 0.f;
    v4u kreg, vreg;
    { const int kb0 = (4 * qb) * 64; kreg = *(const GAS v4u*)(kg + (size_t)kb0 * 512); vreg = *(const GAS v4u*)(vg + (size_t)kb0 * 512); }
    __syncthreads();
    { LAS unsigned char* B0 = F.lds; *(LAS v4u*)(B0 + kdst) = kreg; const unsigned w[4] = {vreg.x, vreg.y, vreg.z, vreg.w};
#pragma unroll
        for (int e = 0; e < 8; ++e) *(LAS unsigned short*)(B0 + vdst + e * MO_ROWB) = (unsigned short)((e & 1) ? (w[e >> 1] >> 16) : (w[e >> 1] & 0xffffu)); }
    __syncthreads();
    for (int it = 0; it < NT; ++it) {
        const int tk = (it < 4) ? 4 * qb + it : it - 4, kb0 = tk * 64, nb = tk >> 2;
        if (it + 1 < NT) { const int tn = (it + 1 < 4) ? 4 * qb + it + 1 : it - 3; kreg = *(const GAS v4u*)(kg + (size_t)tn * 64 * 512); vreg = *(const GAS v4u*)(vg + (size_t)tn * 64 * 512); }
        LAS unsigned char* Kb = F.lds + (it & 1) * MO_BUF; LAS unsigned char* Vb = Kb + 64 * MO_ROWB;
        const bool dead = (nb == qb) && (kb0 > qb * 256 + wid * 32 + 31);
        if (!dead) {
        const bool row_ok = (nb == qb) || ((sel >> nb) & 1u);
        f32x16 p[2];
#pragma unroll
        for (int kb = 0; kb < 2; ++kb) { p[kb] = f32x16{};
#pragma unroll
            for (int d0 = 0; d0 < 4; ++d0) { const bf16x8 a = *(const LAS bf16x8*)(Kb + (32 * kb + r32) * MO_ROWB + (d0 * 16 + hi * 8) * 2); p[kb] = __builtin_amdgcn_mfma_f32_32x32x16_bf16(a, qr[d0], p[kb], 0, 0, 0); } }
        float rmax = NEG; const float off = row_ok ? sl2 * (float)(kb0 - qpos) : NEG;
        p[0] = p[0] * C2 + (abias[0] + off); p[1] = p[1] * C2 + (abias[1] + off);
        if (nb == qb) {
#pragma unroll
            for (int kb = 0; kb < 2; ++kb)
#pragma unroll
                for (int r = 0; r < 16; ++r) { const int kpos = kb0 + 32 * kb + crow(r, hi); if (kpos > qpos) p[kb][r] = NEG; }
        }
#pragma unroll
        for (int kb = 0; kb < 2; ++kb)
#pragma unroll
            for (int r = 0; r < 16; r += 2) rmax = fmaxf(fmaxf(rmax, p[kb][r]), p[kb][r + 1]);
        rmax = fmaxf(rmax, __shfl_xor(rmax, 32));
        const float mnew = fmaxf(mrun, rmax), alpha = __builtin_amdgcn_exp2f(mrun - mnew); mrun = mnew; lrun *= alpha;
        if (__any(alpha != 1.0f)) {
#pragma unroll
            for (int r = 0; r < 16; ++r) { o[0][r] *= alpha; o[1][r] *= alpha; } }
        {   const v2f nm = v2f{-mnew, -mnew}; v2f ps0 = v2f{0.f, 0.f}, ps1 = ps0;
#pragma unroll
            for (int kb = 0; kb < 2; ++kb)
#pragma unroll
                for (int r = 0; r < 16; r += 2) { v2f x = v2f{p[kb][r], p[kb][r + 1]} + nm; x = v2f{__builtin_amdgcn_exp2f(x.x), __builtin_amdgcn_exp2f(x.y)}; if (kb == 0) ps0 += x; else ps1 += x; p[kb][r] = x.x; p[kb][r + 1] = x.y; }
            ps0 += ps1; lrun += ps0.x + ps0.y; }
#pragma unroll
        for (int kb = 0; kb < 2; ++kb)
#pragma unroll
            for (int s2 = 0; s2 < 2; ++s2) { v4u pw; pw.x = pg8::cvt_pk_bf16(p[kb][8 * s2 + 0], p[kb][8 * s2 + 1]); pw.y = pg8::cvt_pk_bf16(p[kb][8 * s2 + 2], p[kb][8 * s2 + 3]);
                pw.z = pg8::cvt_pk_bf16(p[kb][8 * s2 + 4], p[kb][8 * s2 + 5]); pw.w = pg8::cvt_pk_bf16(p[kb][8 * s2 + 6], p[kb][8 * s2 + 7]);
                const bf16x8 pb = __builtin_bit_cast(bf16x8, pw); const int k0 = 32 * kb + 16 * s2 + 4 * hi;
#pragma unroll
                for (int db = 0; db < 2; ++db) { const LAS unsigned char* vp = Vb + (32 * db + r32) * MO_ROWB + k0 * 2;
                    const v2u lo = *(const LAS v2u*)vp, hi8 = *(const LAS v2u*)(vp + 16); const v4u av = {lo.x, lo.y, hi8.x, hi8.y};
                    o[db] = __builtin_amdgcn_mfma_f32_32x32x16_bf16(__builtin_bit_cast(bf16x8, av), pb, o[db], 0, 0, 0); } }
        }
        if (it + 1 < NT) { LAS unsigned char* B1 = F.lds + ((it + 1) & 1) * MO_BUF; *(LAS v4u*)(B1 + kdst) = kreg; const unsigned w[4] = {vreg.x, vreg.y, vreg.z, vreg.w};
#pragma unroll
            for (int e = 0; e < 8; ++e) *(LAS unsigned short*)(B1 + vdst + e * MO_ROWB) = (unsigned short)((e & 1) ? (w[e >> 1] >> 16) : (w[e >> 1] & 0xffffu)); }
        __syncthreads();
    }
    lrun += __shfl_xor(lrun, 32); const float inv = 1.0f / lrun;
    GAS bf16* yp = Y + (rowbase + qpos) * 1024 + 512 + h * 64 + 4 * hi;
#pragma unroll
    for (int db = 0; db < 2; ++db)
#pragma unroll
        for (int g = 0; g < 4; ++g) *(GAS v2u*)(yp + 32 * db + 8 * g) = v2u{pk2(o[db][4 * g] * inv, o[db][4 * g + 1] * inv), pk2(o[db][4 * g + 2] * inv, o[db][4 * g + 3] * inv)};
}
__device__ __forceinline__ void moba_phase(Frame& F) {
    for (int u = F.vcu; u < 256; u += F.G) { const int bh = u >> 2, pr = u & 3; moba_unit(F, bh >> 3, bh & 7, pr); moba_unit(F, bh >> 3, bh & 7, 7 - pr); }
}

constexpr int HG_PQ = 272, HG_PS = 144;
constexpr int HG_QT = 0, HG_KT = HG_QT + 64 * HG_PQ, HG_KTT = HG_KT + 64 * HG_PQ, HG_IT = HG_KTT + 128 * HG_PS, HG_ST = HG_IT + 32 * HG_PS, HG_AS = HG_ST + 32 * HG_PQ, HG_TOT = HG_AS + 64 * HG_PS, HG_END = HG_TOT + 8 * 128 * 4;
constexpr int HG_OB = 81920, HG_POB = 80;
static_assert(HG_END <= HG_OB && HG_OB + 512 * HG_POB <= RING_BYTES, "HGRN2 LDS");
static_assert(HG_END <= RING_BYTES, "hgrn LDS");
__device__ __forceinline__ void hgrn_prep_phase(Frame& F) {
    const int tid = F.tid; LAS unsigned char* L = F.lds; LAS float* TOT = (LAS float*)(L + HG_TOT);
    GAS bf16* HQ = WSP(bf16, WS_HQ); GAS bf16* HF = WSP(bf16, WS_HF); GAS bf16* KT2 = OSP(bf16, OS_KT2); GAS float* RB = WSP(float, WS_RB);
    const GAS float* lbl = inp(F, 24); const int kp = tid & 63, tq = tid >> 6, crow_ = tid >> 4, cpc = tid & 15;
    v4u fn[2], qn[2];
#define HP_LOAD(U) do { const int u_ = (U); const size_t rb_ = (size_t)(u_ >> 8) * SEQ + (u_ & 31) * 64; \
        _Pragma("unroll") for (int j = 0; j < 2; ++j) { const size_t o_ = (rb_ + crow_ + 32 * j) * 1024 + ((u_ >> 5) & 7) * 128 + cpc * 8; fn[j] = *(const GAS v4u*)(HF + o_); qn[j] = *(const GAS v4u*)(HQ + o_); } } while (0)
    if (F.vcu < 2048) HP_LOAD(F.vcu);
    for (int u = F.vcu; u < 2048; u += F.G) {
        const int h = (u >> 5) & 7, gc = h * 128 + 2 * kp; const size_t rowb = (size_t)(u >> 8) * SEQ + (u & 31) * 64;
        const float lb0 = __builtin_amdgcn_rcpf(1.0f + __expf(lbl[gc] - lbl[1024 + gc])), lb1 = __builtin_amdgcn_rcpf(1.0f + __expf(lbl[gc + 1] - lbl[1024 + gc + 1]));
        LDS_BARRIER();
#pragma unroll
        for (int j = 0; j < 2; ++j) { *(LAS v4u*)(L + HG_KT + (crow_ + 32 * j) * HG_PQ + cpc * 16) = fn[j]; *(LAS v4u*)(L + HG_QT + (crow_ + 32 * j) * HG_PQ + cpc * 16) = qn[j]; }
        LDS_BARRIER();
        if (u + F.G < 2048) HP_LOAD(u + F.G);
        float qv[8][2], kd[8][2], bl[8][2]; float run0 = 0.f, run1 = 0.f;
#pragma unroll
        for (int i = 0; i < 8; ++i) { const unsigned fr = *(const LAS unsigned*)(L + HG_KT + (8 * tq + i) * HG_PQ + 4 * kp), qr = *(const LAS unsigned*)(L + HG_QT + (8 * tq + i) * HG_PQ + 4 * kp);
            const float s0 = sigmf(bflo(fr)), s1 = sigmf(bfhi(fr));
            kd[i][0] = (1.0f - lb0) * (1.0f - s0); kd[i][1] = (1.0f - lb1) * (1.0f - s1); qv[i][0] = bflo(qr); qv[i][1] = bfhi(qr);
            run0 += __logf(lb0 + (1.0f - lb0) * s0); run1 += __logf(lb1 + (1.0f - lb1) * s1); bl[i][0] = run0; bl[i][1] = run1; }
        *(LAS v2f*)(TOT + tq * 128 + 2 * kp) = v2f{run0, run1};
        LDS_BARRIER();
        float off0 = 0.f, off1 = 0.f, rr0 = 0.f, rr1 = 0.f, bb0 = 0.f, bb1 = 0.f;
#pragma unroll
        for (int q = 0; q < 8; ++q) { const v2f tv = *(const LAS v2f*)(TOT + q * 128 + 2 * kp); if (q < tq) { off0 += tv[0]; off1 += tv[1]; } if (q < 4) { rr0 += tv[0]; rr1 += tv[1]; } bb0 += tv[0]; bb1 += tv[1]; }
        unsigned kw0[4], kw1[4];
#pragma unroll
        for (int i = 0; i < 8; ++i) { const float e0 = __expf(bl[i][0] + off0 - rr0), e1 = __expf(bl[i][1] + off1 - rr1);
            *(LAS unsigned*)(L + HG_QT + (8 * tq + i) * HG_PQ + 4 * kp) = pk2(qv[i][0] * e0, qv[i][1] * e1);
            const unsigned kk = pk2(kd[i][0] * __builtin_amdgcn_rcpf(e0), kd[i][1] * __builtin_amdgcn_rcpf(e1)); *(LAS unsigned*)(L + HG_KT + (8 * tq + i) * HG_PQ + 4 * kp) = kk;
            if (i & 1) { kw0[i >> 1] |= kk << 16; kw1[i >> 1] |= kk & 0xffff0000u; } else { kw0[i >> 1] = kk & 0xffffu; kw1[i >> 1] = kk >> 16; } }
        GAS bf16* kt = KT2 + ((size_t)u * 128 + 2 * kp) * 64 + 8 * tq; *(GAS v4u*)kt = v4u{kw0[0], kw0[1], kw0[2], kw0[3]}; *(GAS v4u*)(kt + 64) = v4u{kw1[0], kw1[1], kw1[2], kw1[3]};
        if (tq == 0) { *(GAS v2f*)(RB + (size_t)u * 256 + 2 * kp) = v2f{rr0, rr1}; *(GAS v2f*)(RB + (size_t)u * 256 + 128 + 2 * kp) = v2f{bb0, bb1}; }
        LDS_BARRIER();
#pragma unroll
        for (int j = 0; j < 2; ++j) { const size_t o_ = (rowb + crow_ + 32 * j) * 1024 + h * 128 + cpc * 8;
            *(GAS v4u*)(HQ + o_) = *(const LAS v4u*)(L + HG_QT + (crow_ + 32 * j) * HG_PQ + cpc * 16); *(GAS v4u*)(HF + o_) = *(const LAS v4u*)(L + HG_KT + (crow_ + 32 * j) * HG_PQ + cpc * 16); }
    }
#undef HP_LOAD
}
template <bool DRY> __device__ __forceinline__ void hgrn_unit(Frame& F, int b, int h, int vq) {
    const int tid = F.tid, lane = F.lane, w = F.wave, r16 = lane & 15, g4 = lane >> 4;
    LAS unsigned char* L = F.lds;
    const GAS bf16* HQ = WSP(bf16, WS_HQ); const GAS bf16* HF = WSP(bf16, WS_HF); GAS bf16* HI = WSP(bf16, WS_HI); GAS long long* HSS = OSP(long long, OS_HSS); const GAS bf16* KT2 = OSP(bf16, OS_KT2); const GAS float* RB = WSP(float, WS_RB);
    const size_t rowbase = (size_t)b * SEQ; const int ubase = (b * 8 + h) * 32;
    f32x4v S[2]; S[0] = f32x4v{0.f, 0.f, 0.f, 0.f}; S[1] = S[0];
    __syncthreads();
    for (int i = tid; i < 64 * HG_PS / 4; i += NTHREADS) ((LAS unsigned*)(L + HG_AS))[i] = 0u;
    const int tr = w >> 1, vc = w & 1;
    v4u q0A, q1A, k0A, k1A, t0A, t1A, q0B, q1B, k0B, k1B, t0B, t1B, rbA, rbB; v2u iiA, iiB;
#define HS_LOAD(C, q0_, q1_, k0_, k1_, t0_, t1_, ii_, rb_) do { const size_t row_ = rowbase + (size_t)(C) * 64 + (tid >> 3); const GAS bf16* qp_ = HQ + row_ * 1024 + h * 128 + (tid & 7) * 16; const GAS bf16* kp_ = HF + row_ * 1024 + h * 128 + (tid & 7) * 16; \
        q0_ = *(const GAS v4u*)qp_; q1_ = *(const GAS v4u*)(qp_ + 8); k0_ = *(const GAS v4u*)kp_; k1_ = *(const GAS v4u*)(kp_ + 8); \
        const GAS bf16* tp_ = KT2 + ((size_t)(ubase + (C)) * 128 + (tid >> 2)) * 64 + (tid & 3) * 16; t0_ = *(const GAS v4u*)tp_; t1_ = *(const GAS v4u*)(tp_ + 8); \
        ii_ = *(const GAS v2u*)(HI + row_ * 1024 + h * 128 + vq * 32 + (tid & 7) * 4); \
        rb_ = *(const GAS v4u*)(RB + (size_t)(ubase + (C)) * 256 + (tid & 63) * 4); } while (0)
#define HS_CHUNK(CC, q0_, q1_, k0_, k1_, t0_, t1_, ii_, rb_, rbn_) do { \
        LDS_BARRIER(); \
        const f32x4v rv_ = *(const LAS f32x4v*)(L + HG_TOT + ((CC) & 1) * 1024 + (16 * w + 4 * g4) * 4), bv_ = *(const LAS f32x4v*)(L + HG_TOT + ((CC) & 1) * 1024 + 512 + (16 * w + 4 * g4) * 4); \
        {   LAS unsigned char* qd = L + HG_QT + (tid >> 3) * HG_PQ + (tid & 7) * 32; *(LAS v4u*)qd = q0_; *(LAS v4u*)(qd + 16) = q1_; \
            LAS unsigned char* kd_ = L + HG_KT + (tid >> 3) * HG_PQ + (tid & 7) * 32; *(LAS v4u*)kd_ = k0_; *(LAS v4u*)(kd_ + 16) = k1_; \
            LAS unsigned char* td = L + HG_KTT + (tid >> 2) * HG_PS + (tid & 3) * 32; *(LAS v4u*)td = t0_; *(LAS v4u*)(td + 16) = t1_; \
            LAS unsigned char* id = L + HG_IT + ((tid & 7) * 4) * HG_PS + (tid >> 3) * 2; \
            *(LAS unsigned short*)(id) = (unsigned short)(ii_.x & 0xffffu); *(LAS unsigned short*)(id + HG_PS) = (unsigned short)(ii_.x >> 16); *(LAS unsigned short*)(id + 2 * HG_PS) = (unsigned short)(ii_.y & 0xffffu); *(LAS unsigned short*)(id + 3 * HG_PS) = (unsigned short)(ii_.y >> 16); } \
        HS_LOAD(((CC) + 2 < 32 ? (CC) + 2 : 31), q0_, q1_, k0_, k1_, t0_, t1_, ii_, rb_);         \
        float e63[4], e63r[4]; \
        {   float er[4]; \
_Pragma("unroll") \
            for (int rg = 0; rg < 4; ++rg) { er[rg] = __expf(rv_[rg]); e63[rg] = __expf(bv_[rg]); e63r[rg] = __expf(bv_[rg] - rv_[rg]); } \
_Pragma("unroll") \
            for (int cc = 0; cc < 2; ++cc) *(LAS v2u*)(L + HG_ST + (16 * cc + r16) * HG_PQ + (16 * w + 4 * g4) * 2) = v2u{pk2(S[cc][0] * er[0], S[cc][1] * er[1]), pk2(S[cc][2] * er[2], S[cc][3] * er[3])}; } \
        LDS_BARRIER(); \
        f32x4v oacc = f32x4v{0.f, 0.f, 0.f, 0.f}; \
        {   bf16x8 qa[4]; \
_Pragma("unroll") \
            for (int kk = 0; kk < 4; ++kk) qa[kk] = *(const LAS bf16x8*)(L + HG_QT + (16 * tr + r16) * HG_PQ + (32 * kk + 8 * g4) * 2); \
_Pragma("unroll") \
            for (int cc = 0; cc < 2; ++cc) { const int tc = 2 * vc + cc; \
                if (tc <= tr) { f32x4v acc = f32x4v{0.f, 0.f, 0.f, 0.f}; \
_Pragma("unroll") \
                    for (int kk = 0; kk < 4; ++kk) { const bf16x8 kb = *(const LAS bf16x8*)(L + HG_KT + (16 * tc + r16) * HG_PQ + (32 * kk + 8 * g4) * 2); acc = __builtin_amdgcn_mfma_f32_16x16x32_bf16(qa[kk], kb, acc, 0, 0, 0); } \
_Pragma("unroll") \
                    for (int rg = 0; rg < 4; ++rg) { const int t = 16 * tr + 4 * g4 + rg, s_ = 16 * tc + r16; *(LAS unsigned short*)(L + HG_AS + t * HG_PS + s_ * 2) = (unsigned short)f2bf(s_ <= t ? acc[rg] : 0.f); } } } \
_Pragma("unroll") \
            for (int kk = 0; kk < 4; ++kk) { const bf16x8 sb = *(const LAS bf16x8*)(L + HG_ST + (16 * vc + r16) * HG_PQ + (32 * kk + 8 * g4) * 2); oacc = __builtin_amdgcn_mfma_f32_16x16x32_bf16(qa[kk], sb, oacc, 0, 0, 0); } \
        } \
        f32x4v dS[2]; \
_Pragma("unroll") \
        for (int cc = 0; cc < 2; ++cc) { dS[cc] = f32x4v{0.f, 0.f, 0.f, 0.f}; \
_Pragma("unroll") \
            for (int kk = 0; kk < 2; ++kk) { const bf16x8 ka = *(const LAS bf16x8*)(L + HG_KTT + (16 * w + r16) * HG_PS + (32 * kk + 8 * g4) * 2); const bf16x8 ib = *(const LAS bf16x8*)(L + HG_IT + (16 * cc + r16) * HG_PS + (32 * kk + 8 * g4) * 2); \
                dS[cc] = __builtin_amdgcn_mfma_f32_16x16x32_bf16(ka, ib, dS[cc], 0, 0, 0); } } \
_Pragma("unroll") \
        for (int cc = 0; cc < 2; ++cc) \
_Pragma("unroll") \
            for (int rg = 0; rg < 4; ++rg) S[cc][rg] = e63[rg] * S[cc][rg] + e63r[rg] * dS[cc][rg]; \
        LDS_BARRIER(); \
        if (tid < 64) *(LAS v4u*)(L + HG_TOT + (((CC) + 1) & 1) * 1024 + tid * 16) = rbn_;                    \
_Pragma("unroll") \
        for (int kk = 0; kk < 2; ++kk) { const bf16x8 aa = *(const LAS bf16x8*)(L + HG_AS + (16 * tr + r16) * HG_PS + (32 * kk + 8 * g4) * 2); const bf16x8 ib = *(const LAS bf16x8*)(L + HG_IT + (16 * vc + r16) * HG_PS + (32 * kk + 8 * g4) * 2); \
            oacc = __builtin_amdgcn_mfma_f32_16x16x32_bf16(aa, ib, oacc, 0, 0, 0); } \
_Pragma("unroll") \
        for (int rg = 0; rg < 4; ++rg) *(LAS unsigned short*)(L + HG_OB + (((CC) & 7) * 64 + 16 * tr + 4 * g4 + rg) * HG_POB + (16 * vc + r16) * 2) = (unsigned short)f2bf(oacc[rg]); \
    } while (0)
    HS_LOAD(0, q0A, q1A, k0A, k1A, t0A, t1A, iiA, rbA);
    HS_LOAD(1, q0B, q1B, k0B, k1B, t0B, t1B, iiB, rbB);
    if (tid < 64) *(LAS v4u*)(L + HG_TOT + tid * 16) = rbA;
#pragma unroll
    for (int blk = 0; blk < 4; ++blk) {
#pragma unroll 1
        for (int c = 8 * blk; c < 8 * blk + 8; c += 2) {
            HS_CHUNK(c, q0A, q1A, k0A, k1A, t0A, t1A, iiA, rbA, rbB);
            HS_CHUNK(c + 1, q0B, q1B, k0B, k1B, t0B, t1B, iiB, rbB, rbA);
        }
        LDS_BARRIER();
        {
            const size_t row = rowbase + (size_t)blk * 512 + tid; const LAS unsigned char* op = L + HG_OB + tid * HG_POB; float ss = 0.f;
            GAS bf16* dst = (DRY ? WSP(bf16, WS_DRY) : HI) + (DRY ? (row & 2047) : row) * 1024 + h * 128 + vq * 32;
#pragma unroll
            for (int q = 0; q < 4; ++q) { const v4u v = *(const LAS v4u*)(op + 16 * q); *(GAS v4u*)(dst + 8 * q) = v;
#pragma unroll
                for (int e = 0; e < 8; ++e) { const float x = bfel(v, e); ss += x * x; } }
            if (!DRY) __hip_atomic_fetch_add(HSS + row * 8 + h, fx20(ss), __ATOMIC_RELAXED, __HIP_MEMORY_SCOPE_AGENT);
            __builtin_amdgcn_s_waitcnt(0x0F70);
        }
    }
#undef HS_CHUNK
#undef HS_LOAD
}
template <bool DRY> __device__ __forceinline__ void hgrn_phase(Frame& F) {
    for (int u = F.vcu; u < 256; u += F.G) hgrn_unit<DRY>(F, u >> 5, (u >> 2) & 7, u & 3);
}
__device__ __forceinline__ void hgrn_post_phase(Frame& F) {
    const int gw = F.vcu * NWAVES + F.wave, NGW = F.G * NWAVES, c0 = F.lane * 8; GAS bf16* HI = WSP(bf16, WS_HI); const GAS bf16* HG = WSP(bf16, WS_HG); const GAS long long* HSS = OSP(long long, OS_HSS); const GAS float* nw = inp(F, 23);
    float nwv[2][8];
#pragma unroll
    for (int j = 0; j < 2; ++j)
#pragma unroll
        for (int e = 0; e < 8; ++e) nwv[j][e] = nw[c0 + 512 * j + e];
    for (int m0 = gw; m0 < M; m0 += 4 * NGW) { v4u ov[4][2], gv[4][2]; long long hs[4][2];
#pragma unroll
        for (int k = 0; k < 4; ++k) { const int mk = m0 + k * NGW, m = mk < M ? mk : M - 1;
#pragma unroll
            for (int j = 0; j < 2; ++j) { const int c = c0 + 512 * j; hs[k][j] = HSS[(size_t)m * 8 + (c >> 7)]; ov[k][j] = *(const GAS v4u*)(HI + (size_t)m * 1024 + c); gv[k][j] = *(const GAS v4u*)(HG + (size_t)m * 1024 + c); } }
#pragma unroll
        for (int k = 0; k < 4; ++k) { const int m = m0 + k * NGW; if (m < M) {
#pragma unroll
            for (int j = 0; j < 2; ++j) { const int c = c0 + 512 * j; const float rs = __builtin_amdgcn_rsqf(unfx20(hs[k][j]) * (1.0f / 128.0f) + 1e-6f);
                const unsigned ow[4] = {ov[k][j].x, ov[k][j].y, ov[k][j].z, ov[k][j].w}, gw4[4] = {gv[k][j].x, gv[k][j].y, gv[k][j].z, gv[k][j].w}; unsigned rw[4];
#pragma unroll
                for (int e = 0; e < 4; ++e) { const float o0 = __builtin_bit_cast(float, ow[e] << 16), o1 = __builtin_bit_cast(float, ow[e] & 0xffff0000u), g0 = __builtin_bit_cast(float, gw4[e] << 16), g1 = __builtin_bit_cast(float, gw4[e] & 0xffff0000u);
                    rw[e] = pk2(o0 * rs * nwv[j][2 * e] * sigmf(g0), o1 * rs * nwv[j][2 * e + 1] * sigmf(g1)); }
                *(GAS v4u*)(HI + (size_t)m * 1024 + c) = v4u{rw[0], rw[1], rw[2], rw[3]}; } } }
    }
}

__device__ __forceinline__ void final_phase(Frame& F) {
    const int gw = F.vcu * NWAVES + F.wave, NGW = F.G * NWAVES, c0 = F.lane * 8; const GAS float* fg = inp(F, 25); const GAS pg8::ssq_t* ssq = SSQ_SLOT(6); const GAS bf16* XB = WSP(bf16, WS_XB);
    f32x4 g[2][2];
#pragma unroll
    for (int j = 0; j < 2; ++j) { g[j][0] = *(const GAS f32x4*)(fg + c0 + 512 * j); g[j][1] = *(const GAS f32x4*)(fg + c0 + 512 * j + 4); }
    for (int m0 = gw; m0 < M; m0 += 4 * NGW) { v4u xr[4][2]; pg8::ssq_t sq[4];
#pragma unroll
        for (int k = 0; k < 4; ++k) { const int mk = m0 + k * NGW, m = mk < M ? mk : M - 1; sq[k] = ssq[m];
#pragma unroll
            for (int j = 0; j < 2; ++j) xr[k][j] = *(const GAS v4u*)(XB + (size_t)m * D + c0 + 512 * j); }
#pragma unroll
        for (int k = 0; k < 4; ++k) { const int m = m0 + k * NGW; if (m < M) { const float rs = pg8::ssq_to_rstd(sq[k]);
#pragma unroll
            for (int j = 0; j < 2; ++j) { float xv[8]; unpack8(xr[k][j], xv); GAS f32x4* o = (GAS f32x4*)(F.out + (size_t)m * D + c0 + 512 * j);
                o[0] = (f32x4){xv[0] * rs * g[j][0][0], xv[1] * rs * g[j][0][1], xv[2] * rs * g[j][0][2], xv[3] * rs * g[j][0][3]}; o[1] = (f32x4){xv[4] * rs * g[j][1][0], xv[5] * rs * g[j][1][1], xv[6] * rs * g[j][1][2], xv[7] * rs * g[j][1][3]}; } } }
    }
}

#ifndef PROBE_DBL
#define PROBE_DBL 0
#endif
#ifndef MK_N_LAUNCHES
#define MK_N_LAUNCHES 1
#endif
constexpr int NPHASE = 17;
__global__ void __launch_bounds__(NTHREADS, 2) hyb_fwd(Args args) {
    extern __shared__ __attribute__((aligned(16))) unsigned char lds[];
    Frame F0;
    F0.lds = (LAS unsigned char*)lds; F0.MISC = (volatile LAS unsigned*)(F0.lds + MISC_OFF);
    F0.tid = threadIdx.x; F0.lane = F0.tid & 63; F0.wave = __builtin_amdgcn_readfirstlane(F0.tid >> 6);
    F0.G = gridDim.x; { const int bx = blockIdx.x; F0.vcu = (F0.G % 8 == 0) ? (bx % 8) * (F0.G / 8) + bx / 8 : bx; }
    F0.out = (GAS float*)args.out; F0.ws = (GAS unsigned char*)args.ws; F0.ctl = (gu32*)(args.ws + WS_CTL);
    for (int u = F0.tid; u < (LDS_BYTES - LDSCTL_OFF) / 4; u += NTHREADS) ((LAS unsigned*)(F0.lds + LDSCTL_OFF))[u] = 0u;
    __syncthreads();
    if (F0.tid == 0) {
#pragma unroll
        for (int i = 0; i < N_IN; ++i) ((LAS unsigned long long*)(F0.lds + PTAB_OFF))[i] = (unsigned long long)args.in[i]; }
    __syncthreads();
    XcdBarrier bar; bar.bar = (unsigned*)(F0.ctl + CW_BAR); bar.x = 0; bar.st = nullptr;
    if (MK_N_LAUNCHES == 1) bar = xcd_barrier_post((unsigned*)(F0.ctl + CW_BAR), F0.MISC + 8);
    const int lo = args.ph_lo, hi = args.ph_hi;
#define IN(k) (MK_N_LAUNCHES == 1 || in_range((k), lo, hi))
#define GBAR() do { asm volatile("" : "+s"(bar.bar), "+s"(bar.x)); xcd_barrier(bar); } while (0)
#define SEAM(k) do { if (MK_N_LAUNCHES == 1) GBAR(); } while (0)
    if (IN(0)) { if (PROBE_DBL & 1) { { PHASE_FRAME(F); prologue_phase(F); } GBAR(); } PHASE_FRAME(F); prologue_phase(F); SEAM(0); }
#pragma unroll
    for (int f = 0; f < 4; ++f) {
        const int pu = (f == 0) ? 1 : (f == 1) ? 7 : (f == 2) ? 9 : 14;
        if (IN(pu)) { PHASE_FRAME(F);
            pg8::Gemm g{(const bf16*)WSP(bf16, WS_XB), (const bf16*)WSP(bf16, WS_WUP + f * W_UP_BYTES), M, 2 * FF, D}; pg8::StaticOrder S; S.init(M, 2 * FF, F.G, (int)blockIdx.x);
            pg8::EpiSwiglu E{WSP(bf16, WS_H), FF, SSQ_SLOT((f == 0) ? 0 : (f == 1) ? 2 : (f == 2) ? 3 : 5)};
            if (PROBE_DBL & (2 | 128)) { pg8::gemm_phase<pg8::EpiSwiglu, pg8::StaticOrder, true, true>(F.lds, g, S, E); GBAR(); }
            pg8::gemm_phase<pg8::EpiSwiglu, pg8::StaticOrder, true, true>(F.lds, g, S, E);
            {
                constexpr int UP_IDLE0 = (M / 256) * (2 * FF / 256) % 256; static_assert(UP_IDLE0 == 128, "idle tail of the up GEMM");
                if ((int)blockIdx.x >= UP_IDLE0 && F.G == 256) { const int rk = ((int)blockIdx.x - UP_IDLE0) * NWAVES + F.wave, nr = (256 - UP_IDLE0) * NWAVES;
                    if (f == 0) convert_items(F, CV_G1, CV_G2, rk, nr); else if (f == 1) convert_items(F, CV_G3, CV_G4, rk, nr); else if (f == 2) convert_items(F, CV_G4, CV_G5, rk, nr); else convert_items(F, CV_G5, CV_END, rk, nr); }
                else if (F.G != 256) { const int gw_ = (int)blockIdx.x * NWAVES + F.wave, nr_ = F.G * NWAVES;
                    if (f == 0) convert_items(F, CV_G1, CV_G2, gw_, nr_); else if (f == 1) convert_items(F, CV_G3, CV_G4, gw_, nr_); else if (f == 2) convert_items(F, CV_G4, CV_G5, gw_, nr_); else convert_items(F, CV_G5, CV_END, gw_, nr_); } }
            SEAM(pu);
        }
        if (IN(pu + 1)) { PHASE_FRAME(F);
            pg8::Gemm g{(const bf16*)WSP(bf16, WS_H), (const bf16*)WSP(bf16, WS_WDN + f * W_DN_BYTES), M, D, FF}; pg8::StaticOrder S; S.init(M, D, F.G, (int)blockIdx.x);
            pg8::EpiResid E{WSP(bf16, WS_XB), SSQ_SLOT((f == 0) ? 1 : (f == 1) ? 3 : (f == 2) ? 4 : 6), 0.5f};
            if (PROBE_DBL & (2 | 256)) { pg8::EpiResid E0 = E; E0.alpha = 0.f; pg8::gemm_phase<pg8::EpiResid, pg8::StaticOrder, true, true>(F.lds, g, S, E0); GBAR(); }
            pg8::gemm_phase<pg8::EpiResid, pg8::StaticOrder, true, true>(F.lds, g, S, E);
            SEAM(pu + 1);
        }
        if (f == 0) {
            if (IN(3)) { PHASE_FRAME(F);
                pg8::Gemm g{(const bf16*)WSP(bf16, WS_XB), (const bf16*)WSP(bf16, WS_WEVIN), M, EV_IN, D}; pg8::StaticOrder S; S.init(M, EV_IN, F.G, (int)blockIdx.x);
                pg8::EpiProj E{WSP(bf16, WS_PR), RW_COLS, RW_COLS / 256, WSP(bf16, WS_QB), 512, 2, (size_t)M * 512, SSQ_SLOT(1), WSP(float, WS_KMEAN), RW_COLS / 256 + 2};
                if (PROBE_DBL & (2 | 512)) { pg8::EpiProj E0 = E; E0.kmean = nullptr; pg8::gemm_phase<pg8::EpiProj, pg8::StaticOrder, true, true>(F.lds, g, S, E0); GBAR(); }
                pg8::gemm_phase<pg8::EpiProj, pg8::StaticOrder, true, true>(F.lds, g, S, E);
                {
                    if ((int)blockIdx.x >= 64 && F.G == 256) convert_items(F, CV_G2, CV_G3, ((int)blockIdx.x - 64) * NWAVES + F.wave, 192 * NWAVES);
                    else if (F.G != 256) convert_items(F, CV_G2, CV_G3, (int)blockIdx.x * NWAVES + F.wave, F.G * NWAVES); }
                SEAM(3);
            }
                        if (IN(5)) { if (PROBE_DBL & 4) { { PHASE_FRAME(F); lora_kmean_phase(F); } GBAR(); } { PHASE_FRAME(F); lora_kmean_phase(F); } if (PROBE_DBL & 8) { { PHASE_FRAME(F); moba_phase(F); } GBAR(); } { PHASE_FRAME(F); moba_phase(F); } if (MK_N_LAUNCHES == 1) GBAR(); if (PROBE_DBL & 4096) { { PHASE_FRAME(F); rwkv_gram_phase(F); } GBAR(); } { PHASE_FRAME(F); rwkv_gram_phase(F); } GBAR(); if (PROBE_DBL & 16) { { PHASE_FRAME(F); rwkv_cscan_phase<true, false>(F); } GBAR(); } if (PROBE_DBL & 8192) { { PHASE_FRAME(F); rwkv_cscan_phase<true, true>(F); } GBAR(); } { PHASE_FRAME(F); rwkv_cscan_phase(F); } if (MK_N_LAUNCHES == 1) GBAR(); { PHASE_FRAME(F); rwkv_post_phase(F); } SEAM(5); }
            if (IN(6)) { PHASE_FRAME(F);
                pg8::Gemm g{(const bf16*)WSP(bf16, WS_Y), (const bf16*)WSP(bf16, WS_WEVOUT), M, D, D}; pg8::StaticOrder S; S.init(M, D, F.G, (int)blockIdx.x);
                pg8::EpiResid E{WSP(bf16, WS_XB), SSQ_SLOT(2), 1.0f};
                if (PROBE_DBL & (2 | 256)) { pg8::EpiResid E0 = E; E0.alpha = 0.f; pg8::gemm_phase<pg8::EpiResid, pg8::StaticOrder, true, true>(F.lds, g, S, E0); GBAR(); }
                pg8::gemm_phase<pg8::EpiResid, pg8::StaticOrder, true, true>(F.lds, g, S, E);
                SEAM(6);
            }
        }
        if (f == 2) {
            if (IN(11)) { PHASE_FRAME(F);
                pg8::Gemm g{(const bf16*)WSP(bf16, WS_XB), (const bf16*)WSP(bf16, WS_WODIN), M, OD_IN, D}; pg8::StaticOrder S; S.init(M, OD_IN, F.G, (int)blockIdx.x);
                pg8::EpiProj E{nullptr, 0, 0, WSP(bf16, WS_HQ), 1024, 4, (size_t)M * 1024, SSQ_SLOT(4), nullptr, 0};
                if (PROBE_DBL & (2 | 512)) { pg8::EpiProj E0 = E; E0.kmean = nullptr; pg8::gemm_phase<pg8::EpiProj, pg8::StaticOrder, true, true>(F.lds, g, S, E0); GBAR(); }
                pg8::gemm_phase<pg8::EpiProj, pg8::StaticOrder, true, true>(F.lds, g, S, E);
                SEAM(11);
            }
            if (IN(12)) { { PHASE_FRAME(F); hgrn_prep_phase(F); } GBAR(); if (PROBE_DBL & 32) { { PHASE_FRAME(F); hgrn_phase<true>(F); } GBAR(); } { PHASE_FRAME(F); hgrn_phase<false>(F); } if (MK_N_LAUNCHES == 1) GBAR(); { PHASE_FRAME(F); hgrn_post_phase(F); } SEAM(12); }
            if (IN(13)) { PHASE_FRAME(F);
                pg8::Gemm g{(const bf16*)WSP(bf16, WS_HI), (const bf16*)WSP(bf16, WS_WODOUT), M, D, D}; pg8::StaticOrder S; S.init(M, D, F.G, (int)blockIdx.x);
                pg8::EpiResid E{WSP(bf16, WS_XB), SSQ_SLOT(5), 1.0f};
                if (PROBE_DBL & (2 | 256)) { pg8::EpiResid E0 = E; E0.alpha = 0.f; pg8::gemm_phase<pg8::EpiResid, pg8::StaticOrder, true, true>(F.lds, g, S, E0); GBAR(); }
                pg8::gemm_phase<pg8::EpiResid, pg8::StaticOrder, true, true>(F.lds, g, S, E);
                SEAM(13);
            }
        }
    }
    if (PROBE_DBL & 64) { for (int i_ = 0; i_ < 20; ++i_) GBAR(); }
    if (IN(16)) { PHASE_FRAME(F); final_phase(F); }
#undef IN
#undef SEAM
}

extern "C" void kernel_launch(void* const* d_in, const int* in_sizes, int n_in, void* d_out, int out_size, void* d_ws, size_t ws_size, hipStream_t stream) {
    static int grid = 0;
    if (grid == 0) {
        if (n_in != N_IN || in_sizes[0] != M * D || out_size != M * D || ws_size < WS_END) { fprintf(stderr, "kernel_launch: unexpected shapes (n_in %d in0 %d out %d ws %zu); nothing launched\n", n_in, n_in > 0 ? in_sizes[0] : -1, out_size, ws_size); grid = -1; return; }
        int dev = 0, cus = 0, per_cu = 0;
        if (hipGetDevice(&dev) != hipSuccess || hipDeviceGetAttribute(&cus, hipDeviceAttributeMultiprocessorCount, dev) != hipSuccess) { grid = -1; return; }
        if (hipFuncSetAttribute((const void*)hyb_fwd, hipFuncAttributeMaxDynamicSharedMemorySize, LDS_BYTES) != hipSuccess) { fprintf(stderr, "kernel_launch: hipFuncSetAttribute failed\n"); grid = -1; return; }
        if (hipOccupancyMaxActiveBlocksPerMultiprocessor(&per_cu, (const void*)hyb_fwd, NTHREADS, LDS_BYTES) != hipSuccess || per_cu < 1) { fprintf(stderr, "kernel_launch: occupancy query says %d\n", per_cu); }
        (void)hipGetLastError();
        grid = cus;
    }
    if (grid < 0) return;
    if (hipMemsetAsync((char*)d_ws + WS_CTL, 0, CTL_ZERO_BYTES, stream) != hipSuccess) return;
    Args a{};
    for (int i = 0; i < N_IN; ++i) a.in[i] = (const float*)d_in[i];
    a.out = (float*)d_out; a.ws = (unsigned char*)d_ws;
    if (MK_N_LAUNCHES == 1) { a.ph_lo = 0; a.ph_hi = NPHASE; a.li = 0; hipLaunchKernelGGL(hyb_fwd, dim3(grid), dim3(NTHREADS), LDS_BYTES, stream, a); }
    else for (int li = 0; li < NPHASE; ++li) { a.ph_lo = li; a.ph_hi = li + 1; a.li = 0; hipLaunchKernelGGL(hyb_fwd, dim3(grid), dim3(NTHREADS), LDS_BYTES, stream, a); }
}
```
